# Optimizing an MI355X kernel written in HIP

```python
import math
import jax, jax.numpy as jnp
from jax import lax
import numpy as np

D_MODEL = 1024
BATCH = 8
SEQ = 4096
DEPTH = 2
DEC_BATCH = 16
DEC_SEQ = 4096
PAST_LEN = 128

HEAD_DIM = 64
MIX_WIDTH = D_MODEL
H_A = 4
H_B = 4
H_B_KV = 2
H_C = 4
H_D = 4
DILATED_PATTERNS = ((128, 1), (512, 4), (2048, 16))
T5_BUCKETS = 32
T5_MAX_DIST = 1024
GRID_W = 64
NA_ROWS = 8
NA_COLS = 16
D_Q_LORA = 256
D_KV_LORA = 128
D_NOPE = 64
D_ROPE = 32
D_V = 64
ROPE_THETA = 10000.0
QBLOCK = 128
D_FF = -(-8 * D_MODEL // (3 * 256)) * 256
IN_SIZES = (H_A * HEAD_DIM, H_A * HEAD_DIM, H_A * HEAD_DIM,
            H_B * HEAD_DIM, H_B_KV * HEAD_DIM, H_B_KV * HEAD_DIM,
            H_C * HEAD_DIM, H_C * HEAD_DIM, H_C * HEAD_DIM,
            D_Q_LORA, D_KV_LORA, D_ROPE)
D_IN = sum(IN_SIZES)
N_GROUPS = 4
GROUP_WIDTH = MIX_WIDTH // N_GROUPS
RMS_EPS = 1e-6
NEG_INF = -1e30

kernel_name = "hybrid_parallel_head_group_encoder"


def rms_norm(x, g):
    xf = x.astype(jnp.float32)
    y = xf * lax.rsqrt(jnp.mean(xf * xf, axis=-1, keepdims=True) + RMS_EPS)
    return (y * g.astype(jnp.float32)).astype(x.dtype)


def rope_angles(pos, dim):
    inv = 1.0 / (ROPE_THETA ** (jnp.arange(0, dim, 2, dtype=jnp.float32) / dim))
    return pos.astype(jnp.float32)[:, None] * inv[None, :]


def apply_rope(x, ang):
    x1, x2 = jnp.split(x, 2, axis=-1)
    cos = jnp.cos(ang)[:, None, :].astype(x.dtype)
    sin = jnp.sin(ang)[:, None, :].astype(x.dtype)
    return jnp.concatenate([x1 * cos - x2 * sin, x1 * sin + x2 * cos], axis=-1)


def t5_bucket(rel):
    nb = T5_BUCKETS // 2
    max_exact = nb // 2
    n = jnp.abs(rel)
    n_f = jnp.maximum(n, max_exact).astype(jnp.float32)
    large = max_exact + (jnp.log(n_f / max_exact) / math.log(T5_MAX_DIST / max_exact)
                         * (nb - max_exact)).astype(jnp.int32)
    large = jnp.minimum(large, nb - 1)
    return jnp.where(rel > 0, nb, 0) + jnp.where(n < max_exact, n, large)


def dilated_window_attention(q, k, v, t5_bias):
    B, S, H, Dh = q.shape
    nblk = S // QBLOCK
    scale = Dh ** -0.5
    outs, lses = [], []
    for window, dil in DILATED_PATTERNS:
        half = window // (2 * dil)
        off = jnp.arange(-half, half + 1, dtype=jnp.int32) * dil
        bias = t5_bias[t5_bucket(off)].T.astype(jnp.float32)

        def block(i, off=off, bias=bias):
            qpos = i * QBLOCK + jnp.arange(QBLOCK, dtype=jnp.int32)
            kidx = qpos[:, None] + off[None, :]
            valid = (kidx >= 0) & (kidx < S)
            kidx = jnp.clip(kidx, 0, S - 1)
            qb = lax.dynamic_slice_in_dim(q, i * QBLOCK, QBLOCK, axis=1)
            kg = k[:, kidx]
            vg = v[:, kidx]
            s = jnp.einsum('bqhd,bqkhd->bhqk', qb, kg).astype(jnp.float32) * scale + bias[:, None, :]
            s = jnp.where(valid[None, None], s, NEG_INF)
            m = jnp.max(s, axis=-1, keepdims=True)
            e = jnp.exp(s - m)
            l = jnp.sum(e, axis=-1, keepdims=True)
            o = jnp.einsum('bhqk,bqkhd->bqhd', e.astype(v.dtype), vg).astype(jnp.float32)
            o = o / jnp.transpose(l, (0, 2, 1, 3))
            lse = (m + jnp.log(l))[..., 0]
            return o, lse

        o, lse = lax.map(block, jnp.arange(nblk))
        outs.append(jnp.moveaxis(o, 0, 1).reshape(B, S, H, Dh))
        lses.append(jnp.transpose(lse, (1, 2, 0, 3)).reshape(B, H, S))
    w = jax.nn.softmax(jnp.stack(lses, axis=0), axis=0)
    w = jnp.transpose(w, (0, 1, 3, 2))[..., None]
    return jnp.sum(w * jnp.stack(outs, axis=0), axis=0)


def dense_block_attention(q, k, v):
    B, S, G, R, Dq = q.shape
    Dv = v.shape[-1]
    scale = Dq ** -0.5

    def block(i):
        qb = lax.dynamic_slice_in_dim(q, i * QBLOCK, QBLOCK, axis=1)
        s = jnp.einsum('bqgrd,bkgd->bgrqk', qb, k).astype(jnp.float32) * scale
        p = jax.nn.softmax(s, axis=-1).astype(v.dtype)
        return jnp.einsum('bgrqk,bkgd->bqgrd', p, v)

    o = lax.map(block, jnp.arange(S // QBLOCK))
    return jnp.moveaxis(o, 0, 1).reshape(B, S, G * R, Dv)


def neighborhood_attention(q, k, v, rpb):
    B, S, H, Dh = q.shape
    rows = S // GRID_W
    kr = min(NA_ROWS, rows)
    scale = Dh ** -0.5
    qg = q.reshape(B, rows, GRID_W, H, Dh)
    kg = k.reshape(B, rows, GRID_W, H, Dh)
    vg = v.reshape(B, rows, GRID_W, H, Dh)
    cols = jnp.arange(GRID_W, dtype=jnp.int32)
    cs = jnp.clip(cols - NA_COLS // 2, 0, GRID_W - NA_COLS)
    cidx = cs[:, None] + jnp.arange(NA_COLS, dtype=jnp.int32)[None, :]
    dc = cidx - cols[:, None]

    def row_block(r):
        rs = jnp.clip(r - kr // 2, 0, rows - kr)
        k_rows = lax.dynamic_slice_in_dim(kg, rs, kr, axis=1)
        v_rows = lax.dynamic_slice_in_dim(vg, rs, kr, axis=1)
        k_n = k_rows[:, :, cidx]
        v_n = v_rows[:, :, cidx]
        q_r = lax.dynamic_index_in_dim(qg, r, axis=1, keepdims=False)
        dr = rs + jnp.arange(kr, dtype=jnp.int32) - r
        bias = rpb[:, dr[None, :, None] + NA_ROWS - 1, dc[:, None, :] + NA_COLS - 1]
        s = jnp.einsum('bchd,brckhd->bhcrk', q_r, k_n).astype(jnp.float32) * scale
        s = s + bias.astype(jnp.float32)[None]
        p = jax.nn.softmax(s.reshape(B, H, GRID_W, kr * NA_COLS), axis=-1)
        p = p.reshape(B, H, GRID_W, kr, NA_COLS).astype(v.dtype)
        return jnp.einsum('bhcrk,brckhd->bchd', p, v_n)

    o = lax.map(row_block, jnp.arange(rows))
    return jnp.moveaxis(o, 0, 1).reshape(B, S, H, Dh)


def mixing_layer(h, t5_bias, w_in, b_q_gain, b_k_gain, c_rpb, d_q_gain, d_w_uq,
                 d_kv_gain, d_w_ukv, out_gain, w_out):
    B, S, _ = h.shape
    proj = h @ w_in
    splits = [int(c) for c in np.cumsum(IN_SIZES)[:-1]]
    aq, ak, av, bq, bk, bv, cq, ck, cv, dq, dkv, dkr = jnp.split(proj, splits, axis=-1)

    def heads(t, n):
        return t.reshape(B, S, n, t.shape[-1] // n)

    t = jnp.arange(S, dtype=jnp.int32)

    o_a = dilated_window_attention(heads(aq, H_A), heads(ak, H_A), heads(av, H_A), t5_bias)

    qb = rms_norm(heads(bq, H_B), b_q_gain)
    kb = rms_norm(heads(bk, H_B_KV), b_k_gain)
    ang_r = rope_angles(t // GRID_W, HEAD_DIM // 2)
    ang_c = rope_angles(t % GRID_W, HEAD_DIM // 2)
    hd2 = HEAD_DIM // 2
    qb = jnp.concatenate([apply_rope(qb[..., :hd2], ang_r), apply_rope(qb[..., hd2:], ang_c)], axis=-1)
    kb = jnp.concatenate([apply_rope(kb[..., :hd2], ang_r), apply_rope(kb[..., hd2:], ang_c)], axis=-1)
    qb = qb.reshape(B, S, H_B_KV, H_B // H_B_KV, HEAD_DIM)
    o_b = dense_block_attention(qb, kb, heads(bv, H_B_KV))

    o_c = neighborhood_attention(heads(cq, H_C), heads(ck, H_C), heads(cv, H_C), c_rpb)

    ang_t = rope_angles(t, D_ROPE)
    q_d = (rms_norm(dq, d_q_gain) @ d_w_uq).reshape(B, S, H_D, D_NOPE + D_ROPE)
    q_d = jnp.concatenate([q_d[..., :D_NOPE], apply_rope(q_d[..., D_NOPE:], ang_t)], axis=-1)
    kv_d = (rms_norm(dkv, d_kv_gain) @ d_w_ukv).reshape(B, S, H_D, D_NOPE + D_V)
    k_rope = jnp.broadcast_to(apply_rope(dkr[:, :, None, :], ang_t), (B, S, H_D, D_ROPE))
    k_d = jnp.concatenate([kv_d[..., :D_NOPE], k_rope], axis=-1)
    o_d = dense_block_attention(q_d[:, :, :, None, :], k_d, kv_d[..., D_NOPE:])

    o = jnp.stack([o_a.astype(h.dtype).reshape(B, S, GROUP_WIDTH),
                   o_b.reshape(B, S, GROUP_WIDTH),
                   o_c.reshape(B, S, GROUP_WIDTH),
                   o_d.reshape(B, S, GROUP_WIDTH)], axis=-2)
    o = rms_norm(o, out_gain.reshape(N_GROUPS, GROUP_WIDTH))
    return o.reshape(B, S, MIX_WIDTH) @ w_out


def swiglu(h, w_gate, w_up, w_down):
    return (jax.nn.silu(h @ w_gate) * (h @ w_up)) @ w_down


def trunk(x, t5_bias, norm_mix, w_in, b_q_gain, b_k_gain, c_rpb, d_q_gain, d_w_uq,
          d_kv_gain, d_w_ukv, out_gain, w_out, norm_ffn, w_gate, w_up, w_down, final_norm):
    for l in range(DEPTH):
        h = rms_norm(x, norm_mix[l])
        x = x + mixing_layer(h, t5_bias, w_in[l], b_q_gain[l], b_k_gain[l], c_rpb[l],
                             d_q_gain[l], d_w_uq[l], d_kv_gain[l], d_w_ukv[l],
                             out_gain[l], w_out[l])
        h = rms_norm(x, norm_ffn[l])
        x = x + swiglu(h, w_gate[l], w_up[l], w_down[l])
    return rms_norm(x, final_norm)


def setup_inputs(seed: int = 0) -> dict:
    key = jax.random.key(seed)
    ks = jax.random.split(key, 20)
    f32 = jnp.float32

    def nrm(k, shape, scale):
        return jax.random.normal(k, shape, f32) * scale

    def gain(k, shape):
        return 1.0 + 0.05 * jax.random.normal(k, shape, f32)

    return {
        "x_prompt": nrm(ks[0], (BATCH, SEQ, D_MODEL), 1.0),
        "x_sample": nrm(ks[1], (DEC_BATCH, DEC_SEQ, D_MODEL), 1.0),
        "t5_bias": nrm(ks[2], (T5_BUCKETS, H_A), 0.5),
        "norm_mix": gain(ks[3], (DEPTH, D_MODEL)),
        "w_in": nrm(ks[4], (DEPTH, D_MODEL, D_IN), D_MODEL ** -0.5),
        "b_q_gain": gain(ks[5], (DEPTH, HEAD_DIM)),
        "b_k_gain": gain(ks[6], (DEPTH, HEAD_DIM)),
        "c_rpb": nrm(ks[7], (DEPTH, H_C, 2 * NA_ROWS - 1, 2 * NA_COLS - 1), 0.5),
        "d_q_gain": gain(ks[8], (DEPTH, D_Q_LORA)),
        "d_w_uq": nrm(ks[9], (DEPTH, D_Q_LORA, H_D * (D_NOPE + D_ROPE)), D_Q_LORA ** -0.5),
        "d_kv_gain": gain(ks[10], (DEPTH, D_KV_LORA)),
        "d_w_ukv": nrm(ks[11], (DEPTH, D_KV_LORA, H_D * (D_NOPE + D_V)), D_KV_LORA ** -0.5),
        "out_gain": gain(ks[12], (DEPTH, MIX_WIDTH)),
        "w_out": nrm(ks[13], (DEPTH, MIX_WIDTH, D_MODEL), MIX_WIDTH ** -0.5),
        "norm_ffn": gain(ks[14], (DEPTH, D_MODEL)),
        "w_gate": nrm(ks[15], (DEPTH, D_MODEL, D_FF), D_MODEL ** -0.5),
        "w_up": nrm(ks[16], (DEPTH, D_MODEL, D_FF), D_MODEL ** -0.5),
        "w_down": nrm(ks[17], (DEPTH, D_FF, D_MODEL), D_FF ** -0.5),
        "final_norm": gain(ks[18], (D_MODEL,)),
    }


def reference(x_prompt, x_sample, t5_bias, norm_mix, w_in, b_q_gain, b_k_gain, c_rpb,
              d_q_gain, d_w_uq, d_kv_gain, d_w_ukv, out_gain, w_out, norm_ffn,
              w_gate, w_up, w_down, final_norm):
    y_prompt = trunk(x_prompt, t5_bias, norm_mix, w_in, b_q_gain, b_k_gain, c_rpb, d_q_gain,
                     d_w_uq, d_kv_gain, d_w_ukv, out_gain, w_out, norm_ffn, w_gate, w_up,
                     w_down, final_norm)
    y_sample = trunk(x_sample, t5_bias, norm_mix, w_in, b_q_gain, b_k_gain, c_rpb, d_q_gain,
                     d_w_uq, d_kv_gain, d_w_ukv, out_gain, w_out, norm_ffn, w_gate, w_up,
                     w_down, final_norm)
    return (y_prompt, y_sample)
```

```cpp
#include <hip/hip_runtime.h>
#include <hip/hip_cooperative_groups.h>
#include <cstdio>
#include <cstdint>
namespace cg = cooperative_groups;

#ifndef ONE_LAUNCH
#define ONE_LAUNCH 1
#endif

#define DI __device__ __forceinline__
typedef short bf16x8 __attribute__((ext_vector_type(8)));
typedef short s16x4 __attribute__((ext_vector_type(4)));
typedef float f32x16 __attribute__((ext_vector_type(16)));
typedef float f32x4 __attribute__((ext_vector_type(4)));
typedef float f32x2 __attribute__((ext_vector_type(2)));
typedef unsigned u32x4 __attribute__((ext_vector_type(4)));
typedef unsigned u32x2 __attribute__((ext_vector_type(2)));
typedef __bf16 bf16v2 __attribute__((ext_vector_type(2)));
typedef unsigned short u16;

constexpr int T_TOK = 98304, SEQ = 4096, DM = 1024, DIN = 2464, DINP = 2560, DFF = 2816;
constexpr int NPROMPT = 8 * 4096;
constexpr int NTHR = 512;
constexpr float LOG2E = 1.4426950408889634f;
constexpr float QSCALE64 = 0.125f * LOG2E;
constexpr float QSCALE96 = 0.10206207261596575f * LOG2E;
constexpr float NEGBIG = -1e30f;
constexpr float EPS = 1e-6f;

constexpr size_t al256(size_t x) { return (x + 255) & ~(size_t)255; }
constexpr size_t WT_IN = 0;
constexpr size_t WT_UQ = WT_IN + (size_t)DINP * 1024;
constexpr size_t WT_UKV = WT_UQ + 512 * 256;
constexpr size_t WT_OUT = WT_UKV + 512 * 128;
constexpr size_t WT_GU = WT_OUT + 1024 * 1024;
constexpr size_t WT_DN = WT_GU + (size_t)5632 * 1024;
constexpr size_t WT_LAYER = WT_DN + (size_t)1024 * 2816;
constexpr size_t OFF_WT = 0;
constexpr size_t OFF_TBLA = al256(OFF_WT + 2 * WT_LAYER * 2);
constexpr size_t OFF_ROPE = al256(OFF_TBLA + 4 * 2560 * 4);
constexpr size_t OFF_ACTB = al256(OFF_ROPE + 4096 * 16 * 8);
constexpr size_t OFF_PROJ = al256(OFF_ACTB + (size_t)T_TOK * 1024 * 2);
constexpr size_t OFF_QD = al256(OFF_PROJ + (size_t)T_TOK * DIN * 2);
constexpr size_t OFF_KD = al256(OFF_QD + (size_t)T_TOK * 384 * 2);
constexpr size_t OFF_VD = al256(OFF_KD + (size_t)T_TOK * 384 * 2);
constexpr size_t OFF_SSQ = al256(OFF_VD + (size_t)T_TOK * 256 * 2);
constexpr size_t WS_NEED = al256(OFF_SSQ + (size_t)T_TOK * 16 * 4);
constexpr size_t OFF_ACT = OFF_PROJ;
static_assert(OFF_ACT + (size_t)T_TOK * DFF * 2 <= OFF_KD, "act alias overflow");

struct Params {
  const float *x_prompt, *x_sample, *t5_bias, *norm_mix, *w_in, *b_q_gain, *b_k_gain, *c_rpb, *d_q_gain, *d_w_uq,
      *d_kv_gain, *d_w_ukv, *out_gain, *w_out, *norm_ffn, *w_gate, *w_up, *w_down, *final_norm;
  float* out;
  char* ws;
};

constexpr int SMEM_BYTES = 2 * (256 + 256) * 72 * 2 + 1024;

DI unsigned pack2(float a, float b) { f32x2 v = {a, b}; bf16v2 r = __builtin_convertvector(v, bf16v2); return __builtin_bit_cast(unsigned, r); }
DI float bflo(unsigned w) { return __uint_as_float(w << 16); }
DI float bfhi(unsigned w) { return __uint_as_float(w & 0xffff0000u); }
DI f32x16 mfma(bf16x8 a, bf16x8 b, f32x16 c) { return __builtin_amdgcn_mfma_f32_32x32x16_bf16(a, b, c, 0, 0, 0); }
DI float hmax(float v) {
  auto rr = __builtin_amdgcn_permlane32_swap(__float_as_uint(v), __float_as_uint(v), false, false);
  return __builtin_fmaxf(__uint_as_float(rr[0]), __uint_as_float(rr[1]));
}
DI float hsum(float v) {
  auto rr = __builtin_amdgcn_permlane32_swap(__float_as_uint(v), __float_as_uint(v), false, false);
  return __uint_as_float(rr[0]) + __uint_as_float(rr[1]);
}
DI float fexp2(float x) { return __builtin_amdgcn_exp2f(x); }
DI int crow(int i, int h) { return (i & 3) + 8 * (i >> 2) + 4 * h; }
typedef short v4i16_t __attribute__((ext_vector_type(4)));
DI s16x4 tr_read(const u16* p) {
  return __builtin_bit_cast(s16x4, __builtin_amdgcn_ds_read_tr16_b64_v4i16((__attribute__((address_space(3))) v4i16_t*)p));
}
constexpr double inv_rev_c(int i) {
  constexpr double b[4] = {1.0, 0.5623413251903491, 0.31622776601683794, 0.1778279410038923};
  double v = b[i & 3];
  for (int k = 0; k < (i >> 2); ++k) v *= 0.1;
  return v * 0.15915494309189535;
}
DI void rope_tab_build(char* ws, int idx) {
  const int pos = idx >> 4, i = idx & 15;
  double invrev = inv_rev_c(0);
#pragma unroll
  for (int k = 1; k < 16; ++k) if (i == k) invrev = inv_rev_c(k);
  double rev = (double)pos * invrev;
  float f = (float)(rev - (double)(int)rev);
  f32x2 cs = {__builtin_amdgcn_cosf(f), __builtin_amdgcn_sinf(f)};
  ((f32x2*)(ws + OFF_ROPE))[idx] = cs;
}
#define ROPE16(ws_, pos_, A_, B_)                                                              \
  {                                                                                            \
    const f32x4* rt_ = (const f32x4*)((ws_) + OFF_ROPE) + (size_t)(pos_) * 8;                  \
    _Pragma("unroll") for (int i2_ = 0; i2_ < 8; ++i2_) {                                      \
      const f32x4 cs_ = rt_[i2_];                                                              \
      float a_ = A_[2 * i2_], b_ = B_[2 * i2_];                                                \
      A_[2 * i2_] = a_ * cs_[0] - b_ * cs_[1]; B_[2 * i2_] = a_ * cs_[1] + b_ * cs_[0];        \
      a_ = A_[2 * i2_ + 1]; b_ = B_[2 * i2_ + 1];                                              \
      A_[2 * i2_ + 1] = a_ * cs_[2] - b_ * cs_[3]; B_[2 * i2_ + 1] = a_ * cs_[3] + b_ * cs_[2]; \
    }                                                                                          \
  }
DI const float* xrow(const Params& p, int layer, size_t tok) {
  if (layer == 0) return tok < (size_t)NPROMPT ? p.x_prompt + tok * DM : p.x_sample + (tok - NPROMPT) * DM;
  return p.out + tok * DM;
}

DI int opaque_tid() { int t = threadIdx.x; asm volatile("" : "+v"(t)); return t; }
DI void wt_tile(const float* __restrict__ W, int K, int N, const float* __restrict__ g, u16* __restrict__ Wt, int k0, int n0, int mapmode, float* tile) {
  const int tid = opaque_tid();
  for (int i = tid; i < 4096; i += NTHR) {
    int kk = i >> 6, nn = i & 63, n = n0 + nn;
    float v = 0.f;
    if (n < N) { v = W[(size_t)(k0 + kk) * N + n]; if (g) v *= g[k0 + kk]; }
    tile[kk * 65 + nn] = v;
  }
  __syncthreads();
  for (int i = tid; i < 2048; i += NTHR) {
    int nn = i >> 5, kp = i & 31, n = n0 + nn;
    float cs = 1.f; int drow = n;
    if (mapmode == 1) { if (n < 256 || (n >= 1280 && n < 1536)) cs = QSCALE64; }
    else if (mapmode == 2) cs = QSCALE96;
    else if (mapmode == 3) drow = 32 * (n >> 4) + (n & 15);
    else if (mapmode == 4) drow = 32 * (n >> 4) + 16 + (n & 15);
    unsigned w = pack2(tile[(2 * kp) * 65 + nn] * cs, tile[(2 * kp + 1) * 65 + nn] * cs);
    *(unsigned*)(Wt + (size_t)drow * K + k0 + 2 * kp) = w;
  }
  __syncthreads();
}

constexpr int WJ_IN = 640, WJ_UQ = 32, WJ_UKV = 16, WJ_OUT = 256, WJ_G = 704, WJ_U = 704, WJ_D = 704;
constexpr int WJ_LAYER = WJ_IN + WJ_UQ + WJ_UKV + WJ_OUT + WJ_G + WJ_U + WJ_D;
constexpr int WJ_TOTAL = 2 * WJ_LAYER + 20;

DI void wprep_job(const Params& p, int job, char* smem) {
  float* tile = (float*)smem;
  u16* wtb = (u16*)(p.ws + OFF_WT);
  if (job >= 2 * WJ_LAYER) {
    int idx = (job - 2 * WJ_LAYER) * NTHR + opaque_tid();
    int head = idx / 2560, e = idx % 2560, d = e - 1280, n = d < 0 ? -d : d;
    int mult = (n <= 64 ? 1 : 0) + (((n & 3) == 0 && n <= 256) ? 1 : 0) + (((n & 15) == 0 && n <= 1024) ? 1 : 0);
    float v = NEGBIG;
    if (mult > 0) {
      int bk;
      if (n < 8) bk = n;
      else { float nf = (float)n; int lg = 8 + (int)(__logf(nf * 0.125f) / 4.852030263919617f * 8.0f); bk = lg < 15 ? lg : 15; }
      if (d > 0) bk += 16;
      v = (p.t5_bias[bk * 4 + head] + __logf((float)mult)) * LOG2E;
    }
    ((float*)(p.ws + OFF_TBLA))[idx] = v;
    return;
  }
  int layer = job / WJ_LAYER, j = job % WJ_LAYER;
  u16* wl = wtb + (size_t)layer * WT_LAYER;
  if (j < WJ_IN) { int kt = j & 15, nt = j >> 4; wt_tile(p.w_in + (size_t)layer * 1024 * DIN, 1024, DIN, p.norm_mix + layer * 1024, wl + WT_IN, kt * 64, nt * 64, 1, tile); return; }
  j -= WJ_IN;
  if (j < WJ_UQ) { int kt = j & 3, nt = j >> 2; wt_tile(p.d_w_uq + (size_t)layer * 256 * 384, 256, 384, p.d_q_gain + layer * 256, wl + WT_UQ, kt * 64, nt * 64, 2, tile); return; }
  j -= WJ_UQ;
  if (j < WJ_UKV) { int kt = j & 1, nt = j >> 1; wt_tile(p.d_w_ukv + (size_t)layer * 128 * 512, 128, 512, p.d_kv_gain + layer * 128, wl + WT_UKV, kt * 64, nt * 64, 0, tile); return; }
  j -= WJ_UKV;
  if (j < WJ_OUT) { int kt = j & 15, nt = j >> 4; wt_tile(p.w_out + (size_t)layer * 1024 * 1024, 1024, 1024, p.out_gain + layer * 1024, wl + WT_OUT, kt * 64, nt * 64, 0, tile); return; }
  j -= WJ_OUT;
  if (j < WJ_G) { int kt = j & 15, nt = j >> 4; wt_tile(p.w_gate + (size_t)layer * 1024 * DFF, 1024, DFF, p.norm_ffn + layer * 1024, wl + WT_GU, kt * 64, nt * 64, 3, tile); return; }
  j -= WJ_G;
  if (j < WJ_U) { int kt = j & 15, nt = j >> 4; wt_tile(p.w_up + (size_t)layer * 1024 * DFF, 1024, DFF, p.norm_ffn + layer * 1024, wl + WT_GU, kt * 64, nt * 64, 4, tile); return; }
  j -= WJ_U;
  { int kt = j % 44, nt = j / 44; wt_tile(p.w_down + (size_t)layer * DFF * 1024, DFF, 1024, nullptr, wl + WT_DN, kt * 64, nt * 64, 0, tile); }
}

DI void norm_rows(const Params& p, int layer, int rb, int mode) {
  const int tid = opaque_tid();
  const int lane = tid & 63, wave = tid >> 6;
  const size_t row = (size_t)rb * 8 + wave;
  const float* src = xrow(p, layer, row);
  f32x4 v[4];
  float ss = 0.f;
#pragma unroll
  for (int i = 0; i < 4; ++i) { v[i] = *(const f32x4*)(src + lane * 4 + 256 * i); ss += v[i][0] * v[i][0] + v[i][1] * v[i][1] + v[i][2] * v[i][2] + v[i][3] * v[i][3]; }
#pragma unroll
  for (int o = 1; o < 64; o <<= 1) ss += __shfl_xor(ss, o);
  const float rstd = rsqrtf(ss * (1.f / 1024.f) + EPS);
  if (mode == 0) {
    u16* dst = (u16*)(p.ws + OFF_ACTB) + row * DM;
#pragma unroll
    for (int i = 0; i < 4; ++i) { u32x2 w = {pack2(v[i][0] * rstd, v[i][1] * rstd), pack2(v[i][2] * rstd, v[i][3] * rstd)}; *(u32x2*)(dst + lane * 4 + 256 * i) = w; }
  } else {
    float* dst = p.out + row * DM;
#pragma unroll
    for (int i = 0; i < 4; ++i) { f32x4 g = *(const f32x4*)(p.final_norm + lane * 4 + 256 * i); f32x4 o = {v[i][0] * rstd * g[0], v[i][1] * rstd * g[1], v[i][2] * rstd * g[2], v[i][3] * rstd * g[3]}; *(f32x4*)(dst + lane * 4 + 256 * i) = o; }
  }
}

enum { EPI_PROJ = 0, EPI_UQ = 1, EPI_UKV = 2, EPI_RES = 3, EPI_SWIGLU = 4 };
constexpr int GS = 72;
constexpr int BM = 256;
constexpr int TMW = 4;

template <int EPI, bool ASCALE, bool ROWNORM>
DI void gemm_tile(const Params& p, int layer, const u16* __restrict__ A, int lda, const u16* __restrict__ Wt, int K, int m0, int n0, char* smem) {
  u16* As = (u16*)smem;
  u16* Bs = As + 2 * BM * GS;
  float* rowscale = (float*)(Bs + 2 * 256 * GS);
  const int tid = opaque_tid(), lane = tid & 63, wave = tid >> 6, r = lane & 31, h = lane >> 5;
  const int wm = wave >> 2, wn = wave & 3;
  const int lrow = tid >> 3, kc = tid & 7;
  const u16* At = A + (size_t)m0 * lda;
  const u16* Bt = Wt + (size_t)n0 * K;
  const unsigned aoff = (unsigned)lrow * lda + kc * 8, boff = (unsigned)lrow * K + kc * 8;
  const float* ssq = (const float*)(p.ws + OFF_SSQ);

  if (ROWNORM) {
    const int rr = tid >> 1, half = tid & 1;
    const u16* src = A + (size_t)(m0 + rr) * lda + half * (K / 2);
    float ss = 0.f;
    for (int i = 0; i < K / 16; ++i) {
      u32x4 w = *(const u32x4*)(src + i * 8);
#pragma unroll
      for (int e = 0; e < 4; ++e) { float a = bflo(w[e]), b = bfhi(w[e]); ss += a * a + b * b; }
    }
    ss += __shfl_xor(ss, 1);
    if (half == 0) rowscale[rr] = rsqrtf(ss / (float)K + EPS);
  }

  f32x16 acc[TMW][2];
#pragma unroll
  for (int a = 0; a < TMW; ++a)
#pragma unroll
    for (int b = 0; b < 2; ++b)
#pragma unroll
      for (int i = 0; i < 16; ++i) acc[a][b][i] = 0.f;

  u32x4 ra[4], rb[4];
  float sc[4] = {1.f, 1.f, 1.f, 1.f};
  const int KT = K / 64;
  auto gload = [&](int kt) {
#pragma unroll
    for (int pp = 0; pp < 4; ++pp) ra[pp] = *(const u32x4*)(At + (size_t)(64 * pp) * lda + (aoff + (unsigned)kt * 64));
#pragma unroll
    for (int pp = 0; pp < 4; ++pp) rb[pp] = *(const u32x4*)(Bt + (size_t)(64 * pp) * K + (boff + (unsigned)kt * 64));
  };
  auto lstore = [&](int buf, int kt) {
    if (ASCALE) {
      if ((kt & 3) == 0) {
        const int g = kt >> 2;
#pragma unroll
        for (int pp = 0; pp < 4; ++pp) {
          f32x4 s4 = *(const f32x4*)(ssq + (size_t)(m0 + lrow + 64 * pp) * 16 + 4 * g);
          sc[pp] = rsqrtf((s4[0] + s4[1] + s4[2] + s4[3]) * (1.f / 256.f) + EPS);
        }
      }
#pragma unroll
      for (int pp = 0; pp < 4; ++pp)
#pragma unroll
        for (int e = 0; e < 4; ++e) ra[pp][e] = pack2(bflo(ra[pp][e]) * sc[pp], bfhi(ra[pp][e]) * sc[pp]);
    }
#pragma unroll
    for (int pp = 0; pp < 4; ++pp) *(u32x4*)(As + (buf * BM + lrow + 64 * pp) * GS + kc * 8) = ra[pp];
#pragma unroll
    for (int pp = 0; pp < 4; ++pp) *(u32x4*)(Bs + (buf * 256 + lrow + 64 * pp) * GS + kc * 8) = rb[pp];
  };
  auto compute = [&](int buf) {
    const u16* Ab = As + (buf * BM + wm * 128 + r) * GS + 8 * h;
    const u16* Bb = Bs + (buf * 256 + wn * 64 + r) * GS + 8 * h;
#pragma unroll
    for (int ks = 0; ks < 4; ++ks) {
      bf16x8 b0 = *(const bf16x8*)(Bb + ks * 16);
      bf16x8 b1 = *(const bf16x8*)(Bb + 32 * GS + ks * 16);
#pragma unroll
      for (int tm = 0; tm < TMW; ++tm) {
        bf16x8 a = *(const bf16x8*)(Ab + tm * 32 * GS + ks * 16);
        acc[tm][0] = mfma(a, b0, acc[tm][0]);
        acc[tm][1] = mfma(a, b1, acc[tm][1]);
      }
    }
  };
  gload(0);
  lstore(0, 0);
  if (KT > 1) gload(1);
  __syncthreads();
  for (int kt = 0; kt < KT; ++kt) {
    compute(kt & 1);
    if (kt + 1 < KT) lstore((kt + 1) & 1, kt + 1);
    if (kt + 2 < KT) gload(kt + 2);
    __syncthreads();
  }

  const int wms = __builtin_amdgcn_readfirstlane(wm), wns = __builtin_amdgcn_readfirstlane(wn);
  const int mrow0 = m0 + wms * 128;
  const int nwb = n0 + wns * 64;
  if (ROWNORM) {
#pragma unroll
    for (int tm = 0; tm < TMW; ++tm) {
#pragma unroll
      for (int i = 0; i < 16; ++i) {
        const float rs = rowscale[wms * 128 + 4 * h + 32 * tm + (i & 3) + 8 * (i >> 2)];
        acc[tm][0][i] *= rs; acc[tm][1][i] *= rs;
      }
    }
  }
  if (EPI == EPI_SWIGLU) {
    u16* dw = (u16*)(p.ws + OFF_ACT) + (size_t)mrow0 * DFF + (nwb >> 1);
    const unsigned lo = (unsigned)(4 * h) * DFF + r;
#pragma unroll
    for (int tm = 0; tm < TMW; ++tm) {
#pragma unroll
      for (int i = 0; i < 16; ++i) {
        const float g = acc[tm][0][i], u = acc[tm][1][i];
        const float a = g * __builtin_amdgcn_rcpf(1.f + fexp2(-g * LOG2E)) * u;
        dw[lo + (unsigned)((32 * tm + (i & 3) + 8 * (i >> 2)) * DFF)] = (u16)(pack2(a, 0.f) & 0xffff);
      }
      __builtin_amdgcn_sched_barrier(0);
    }
  } else {
#pragma unroll
    for (int tn = 0; tn < 2; ++tn) {
      const int nb0 = nwb + 32 * tn;
      if (EPI == EPI_RES) {
        const float* xw = (layer == 0 ? (m0 < NPROMPT ? p.x_prompt + (size_t)mrow0 * DM : p.x_sample + (size_t)(mrow0 - NPROMPT) * DM) : p.out + (size_t)mrow0 * DM) + nb0;
        float* ow = p.out + (size_t)mrow0 * DM + nb0;
        const unsigned lo = (unsigned)(4 * h) * DM + r;
#pragma unroll
        for (int tm = 0; tm < TMW; ++tm) {
#pragma unroll
          for (int g4 = 0; g4 < 4; ++g4) {
            float xv[4];
#pragma unroll
            for (int e = 0; e < 4; ++e) xv[e] = xw[lo + (unsigned)((32 * tm + 8 * g4 + e) * DM)];
#pragma unroll
            for (int e = 0; e < 4; ++e) ow[lo + (unsigned)((32 * tm + 8 * g4 + e) * DM)] = xv[e] + acc[tm][tn][4 * g4 + e];
          }
          __builtin_amdgcn_sched_barrier(0);
        }
      } else {
        u16* dw; int ld; bool ok = true;
        if (EPI == EPI_PROJ) { dw = (u16*)(p.ws + OFF_PROJ) + (size_t)mrow0 * DIN + nb0; ld = DIN; ok = (nb0 + r) < DIN; }
        else if (EPI == EPI_UQ) { dw = (u16*)(p.ws + OFF_QD) + (size_t)mrow0 * 384 + nb0; ld = 384; ok = nb0 < 384; }
        else {
          const int head = nb0 >> 7, w = nb0 & 127;
          if (w < 64) { dw = (u16*)(p.ws + OFF_KD) + (size_t)mrow0 * 384 + head * 96 + w; ld = 384; }
          else { dw = (u16*)(p.ws + OFF_VD) + (size_t)mrow0 * 256 + head * 64 + (w - 64); ld = 256; }
        }
        const unsigned lo = (unsigned)(4 * h) * ld + r;
        if (ok) {
#pragma unroll
          for (int tm = 0; tm < TMW; ++tm) {
#pragma unroll
            for (int i = 0; i < 16; ++i) dw[lo + (unsigned)((32 * tm + (i & 3) + 8 * (i >> 2)) * ld)] = (u16)(pack2(acc[tm][tn][i], 0.f) & 0xffff);
            __builtin_amdgcn_sched_barrier(0);
          }
        }
      }
    }
  }
  if (ROWNORM) __syncthreads();
}


typedef float f32x4v __attribute__((ext_vector_type(4)));
constexpr int G8_HT = 128 * 64;
DI int lds_byte8(int r, int c) { const int st = (r >> 4) * 2 + (c >> 5), ob = (r & 15) * 64 + (c & 31) * 2; return st * 1024 + (ob ^ (((ob >> 9) & 1) << 5)); }
DI void stage_rc8(int b, int& R, int& C) { const int st = b >> 10, sb = b & 1023, swz = sb ^ (((sb >> 9) & 1) << 5); R = (st >> 1) * 16 + (swz >> 6); C = (st & 1) * 32 + ((swz & 63) >> 1); }

DI void gemm8_prestage(const u16* __restrict__ A, const u16* __restrict__ Bt, int K, int brow, int bcol, char* smem) {
  u16* shm = (u16*)smem;
  const int tid = opaque_tid();
  int sr0, sc0, sr1, sc1;
  stage_rc8(tid * 16, sr0, sc0);
  stage_rc8(tid * 16 + 8192, sr1, sc1);
  const unsigned go0 = (unsigned)sr0 * K + sc0, go1 = (unsigned)sr1 * K + sc1;
#define G8P_STAGE(P, BASE, br) do { const u16* g_ = (BASE) + (size_t)(br) * K; \
    __builtin_amdgcn_global_load_lds((const unsigned*)(g_ + go0), (__attribute__((address_space(3))) unsigned*)((char*)(P) + tid * 16), 16, 0, 0); \
    __builtin_amdgcn_global_load_lds((const unsigned*)(g_ + go1), (__attribute__((address_space(3))) unsigned*)((char*)(P) + tid * 16 + 8192), 16, 0, 0); } while (0)
  G8P_STAGE(shm + 4 * G8_HT, Bt, bcol); G8P_STAGE(shm, A, brow);
  G8P_STAGE(shm + 5 * G8_HT, Bt, bcol + 128); G8P_STAGE(shm + G8_HT, A, brow + 128);
#undef G8P_STAGE
}

template <int EPI, bool GSCALE = false>
DI void gemm8_tile(const Params& p, int layer, const u16* __restrict__ A, const u16* __restrict__ Bt, int K, int brow, int bcol, char* smem,
                   bool next_valid, int next_brow, int next_bcol) {
  u16* shm = (u16*)smem;
  const int tid = opaque_tid();
  float* gfac = (float*)(smem + 8 * G8_HT * 2);
  if (GSCALE) {
    if (tid < 256) {
      const float* sq = (const float*)(p.ws + OFF_SSQ) + (size_t)(brow + tid) * 16;
      float rs[4];
#pragma unroll
      for (int g = 0; g < 4; ++g) { const f32x4 s4 = *(const f32x4*)(sq + 4 * g); rs[g] = rsqrtf((s4[0] + s4[1] + s4[2] + s4[3]) * (1.f / 256.f) + EPS); }
      gfac[tid] = rs[0] / rs[1]; gfac[256 + tid] = rs[1] / rs[2]; gfac[512 + tid] = rs[2] / rs[3]; gfac[768 + tid] = rs[3];
    }
  }
  const int wid = tid >> 6, lane = tid & 63, wr = wid >> 2, wc = wid & 3, fr = lane & 15, fq = lane >> 4;
  int sr0, sc0, sr1, sc1;
  stage_rc8(tid * 16, sr0, sc0);
  stage_rc8(tid * 16 + 8192, sr1, sc1);
  const unsigned go0 = (unsigned)sr0 * K + sc0, go1 = (unsigned)sr1 * K + sc1;
#define G8_SA(b, hh) (shm + ((b) * 2 + (hh)) * G8_HT)
#define G8_SB(b, hh) (shm + (4 + (b) * 2 + (hh)) * G8_HT)
#define G8_STAGE(P, BASE, br, kt) do { const u16* g_ = (BASE) + (size_t)(br) * K + (size_t)(kt) * 64; \
    __builtin_amdgcn_global_load_lds((const unsigned*)(g_ + go0), (__attribute__((address_space(3))) unsigned*)((char*)(P) + tid * 16), 16, 0, 0); \
    __builtin_amdgcn_global_load_lds((const unsigned*)(g_ + go1), (__attribute__((address_space(3))) unsigned*)((char*)(P) + tid * 16 + 8192), 16, 0, 0); } while (0)
#define G8_LDA(dst, b, hh) _Pragma("unroll") for (int m = 0; m < 4; ++m) _Pragma("unroll") for (int k = 0; k < 2; ++k) \
    dst[m][k] = *reinterpret_cast<const bf16x8*>((char*)G8_SA(b, hh) + lds_byte8(wr * 64 + m * 16 + fr, k * 32 + fq * 8))
#define G8_LDB(dst, b, hh) _Pragma("unroll") for (int n = 0; n < 2; ++n) _Pragma("unroll") for (int k = 0; k < 2; ++k) \
    dst[n][k] = *reinterpret_cast<const bf16x8*>((char*)G8_SB(b, hh) + lds_byte8(wc * 32 + n * 16 + fr, k * 32 + fq * 8))
#define G8_MMA(ai, bj, At_, Bt_) do { __builtin_amdgcn_s_setprio(1); \
    _Pragma("unroll") for (int m = 0; m < 4; ++m) _Pragma("unroll") for (int n = 0; n < 2; ++n) _Pragma("unroll") for (int k = 0; k < 2; ++k) \
      acc[ai][bj][m][n] = __builtin_amdgcn_mfma_f32_16x16x32_bf16(At_[m][k], Bt_[n][k], acc[ai][bj][m][n], 0, 0, 0); \
    __builtin_amdgcn_s_setprio(0); } while (0)
#define G8_WAIT_V(n) asm volatile("s_waitcnt vmcnt(" #n ")" ::: "memory")
#define G8_WAIT_L(n) asm volatile("s_waitcnt lgkmcnt(" #n ")" ::: "memory")
#define G8_BAR __builtin_amdgcn_s_barrier()
#define G8_SCHED __builtin_amdgcn_sched_barrier(0)
  f32x4v acc[2][2][4][2];
#pragma unroll
  for (int a = 0; a < 2; ++a)
#pragma unroll
    for (int b = 0; b < 2; ++b)
#pragma unroll
      for (int m = 0; m < 4; ++m)
#pragma unroll
        for (int n = 0; n < 2; ++n) acc[a][b][m][n] = (f32x4v){0.f, 0.f, 0.f, 0.f};
  bf16x8 At[4][2], B0[2][2], B1[2][2];
  const int nt = K / 64;
  if (wr == 1) G8_BAR;
  G8_WAIT_V(4); G8_BAR;
  G8_STAGE(G8_SB(1, 0), Bt, bcol, 1); G8_STAGE(G8_SA(1, 0), A, brow, 1); G8_STAGE(G8_SB(1, 1), Bt, bcol + 128, 1);
  G8_WAIT_V(6); G8_BAR;
  for (int t = 0; t < nt - 2; t += 2) {
    G8_LDB(B0, 0, 0); G8_SCHED; G8_LDA(At, 0, 0); G8_STAGE(G8_SA(1, 1), A, brow + 128, t + 1);
    G8_WAIT_L(8); G8_BAR; G8_WAIT_L(0); G8_MMA(0, 0, At, B0); G8_BAR; G8_SCHED;
    G8_LDB(B1, 0, 1); G8_STAGE(G8_SB(0, 0), Bt, bcol, t + 2);
    G8_BAR; G8_WAIT_L(0); G8_MMA(0, 1, At, B1); G8_BAR;
    G8_LDA(At, 0, 1); G8_STAGE(G8_SA(0, 0), A, brow, t + 2);
    G8_BAR; G8_WAIT_L(0); G8_MMA(1, 0, At, B0); G8_BAR; G8_SCHED;
    G8_STAGE(G8_SB(0, 1), Bt, bcol + 128, t + 2);
    G8_WAIT_V(6); G8_BAR; G8_MMA(1, 1, At, B1); G8_BAR;
    G8_LDB(B0, 1, 0); G8_SCHED; G8_LDA(At, 1, 0); G8_STAGE(G8_SA(0, 1), A, brow + 128, t + 2);
    G8_WAIT_L(8); G8_BAR; G8_WAIT_L(0); G8_MMA(0, 0, At, B0); G8_BAR; G8_SCHED;
    G8_LDB(B1, 1, 1); G8_STAGE(G8_SB(1, 0), Bt, bcol, t + 3);
    G8_BAR; G8_WAIT_L(0); G8_MMA(0, 1, At, B1); G8_BAR;
    G8_LDA(At, 1, 1); G8_STAGE(G8_SA(1, 0), A, brow, t + 3);
    G8_BAR; G8_WAIT_L(0); G8_MMA(1, 0, At, B0); G8_BAR; G8_SCHED;
    G8_STAGE(G8_SB(1, 1), Bt, bcol + 128, t + 3);
    G8_WAIT_V(6); G8_BAR; G8_MMA(1, 1, At, B1); G8_BAR;
    if (GSCALE && (t & 3) == 2) {
      const float* gf = gfac + (t >> 2) * 256 + wr * 64 + fq * 4;
#pragma unroll
      for (int ai = 0; ai < 2; ++ai)
#pragma unroll
        for (int m = 0; m < 4; ++m) {
          const f32x4 f4 = *(const f32x4*)(gf + ai * 128 + m * 16);
#pragma unroll
          for (int bj = 0; bj < 2; ++bj)
#pragma unroll
            for (int n = 0; n < 2; ++n)
#pragma unroll
              for (int j = 0; j < 4; ++j) acc[ai][bj][m][n][j] *= f4[j];
        }
    }
  }
  { G8_LDB(B0, 0, 0); G8_LDA(At, 0, 0); G8_STAGE(G8_SA(1, 1), A, brow + 128, nt - 1);
    G8_BAR; G8_WAIT_L(0); G8_MMA(0, 0, At, B0); G8_BAR;
    G8_LDB(B1, 0, 1); G8_BAR; G8_WAIT_L(0); G8_MMA(0, 1, At, B1); G8_BAR;
    G8_LDA(At, 0, 1); G8_WAIT_V(4); G8_BAR; G8_WAIT_L(0); G8_MMA(1, 0, At, B0); G8_MMA(1, 1, At, B1); G8_BAR; }
  { G8_LDB(B0, 1, 0); G8_LDA(At, 1, 0); G8_WAIT_V(2); G8_BAR; G8_WAIT_L(0); G8_MMA(0, 0, At, B0); G8_BAR;
    G8_LDB(B1, 1, 1); G8_WAIT_V(0); G8_BAR; G8_WAIT_L(0); G8_MMA(0, 1, At, B1); G8_BAR;
    G8_LDA(At, 1, 1); G8_BAR; G8_WAIT_L(0); G8_MMA(1, 0, At, B0); G8_MMA(1, 1, At, B1); G8_BAR; }
  if (wr == 0) G8_BAR;
  if (GSCALE) {
    const float* gf = gfac + 768 + wr * 64 + fq * 4;
#pragma unroll
    for (int ai = 0; ai < 2; ++ai)
#pragma unroll
      for (int m = 0; m < 4; ++m) {
        const f32x4 f4 = *(const f32x4*)(gf + ai * 128 + m * 16);
#pragma unroll
        for (int bj = 0; bj < 2; ++bj)
#pragma unroll
          for (int n = 0; n < 2; ++n)
#pragma unroll
            for (int j = 0; j < 4; ++j) acc[ai][bj][m][n][j] *= f4[j];
      }
  }
  if (next_valid) gemm8_prestage(A, Bt, K, next_brow, next_bcol, smem);
  const int wrs = __builtin_amdgcn_readfirstlane(wr), wcs = __builtin_amdgcn_readfirstlane(wc);
#pragma unroll
  for (int ai = 0; ai < 2; ++ai) {
    const int mrow0 = brow + ai * 128 + wrs * 64;
#pragma unroll
    for (int bj = 0; bj < 2; ++bj) {
      const int ncol0 = bcol + bj * 128 + wcs * 32;
      if (EPI == EPI_SWIGLU) {
        u16* dw = (u16*)(p.ws + OFF_ACT) + (size_t)mrow0 * DFF + (ncol0 >> 1);
        const unsigned lo = (unsigned)(fq * 4) * DFF + fr;
#pragma unroll
        for (int m = 0; m < 4; ++m) {
#pragma unroll
          for (int j = 0; j < 4; ++j) {
            const float g = acc[ai][bj][m][0][j], u = acc[ai][bj][m][1][j];
            const float a = g * __builtin_amdgcn_rcpf(1.f + fexp2(-g * LOG2E)) * u;
            dw[lo + (unsigned)((m * 16 + j) * DFF)] = (u16)(pack2(a, 0.f) & 0xffff);
          }
        }
        __builtin_amdgcn_sched_barrier(0);
      } else if (EPI == EPI_RES) {
#pragma unroll
        for (int n = 0; n < 2; ++n) {
          const float* xw = (layer == 0 ? (brow < NPROMPT ? p.x_prompt + (size_t)mrow0 * DM : p.x_sample + (size_t)(mrow0 - NPROMPT) * DM) : p.out + (size_t)mrow0 * DM) + ncol0 + n * 16;
          float* ow = p.out + (size_t)mrow0 * DM + ncol0 + n * 16;
          const unsigned lo = (unsigned)(fq * 4) * DM + fr;
#pragma unroll
          for (int m = 0; m < 4; ++m) {
            float xv[4];
#pragma unroll
            for (int j = 0; j < 4; ++j) xv[j] = xw[lo + (unsigned)((m * 16 + j) * DM)];
#pragma unroll
            for (int j = 0; j < 4; ++j) ow[lo + (unsigned)((m * 16 + j) * DM)] = xv[j] + acc[ai][bj][m][n][j];
          }
          __builtin_amdgcn_sched_barrier(0);
        }
      } else {
#pragma unroll
        for (int n = 0; n < 2; ++n) {
          const int nb0 = ncol0 + n * 16;
          if (nb0 < DIN) {
            u16* dw = (u16*)(p.ws + OFF_PROJ) + (size_t)mrow0 * DIN + nb0;
            const unsigned lo = (unsigned)(fq * 4) * DIN + fr;
#pragma unroll
            for (int m = 0; m < 4; ++m)
#pragma unroll
              for (int j = 0; j < 4; ++j) dw[lo + (unsigned)((m * 16 + j) * DIN)] = (u16)(pack2(acc[ai][bj][m][n][j], 0.f) & 0xffff);
          }
          __builtin_amdgcn_sched_barrier(0);
        }
      }
    }
  }
  G8_WAIT_V(0);
  __syncthreads();
}

DI void e1_chunk(const Params& p, int layer, int chunk) {
  const int tid = opaque_tid();
  const int l8 = tid & 7, hv = (tid >> 3) & 7;
  const size_t tok = (size_t)chunk * 8 + (tid >> 6);
  u16* proj = (u16*)(p.ws + OFF_PROJ);
  const int t = (int)(tok & 4095);
  const bool isq = hv < 4, isb = hv < 6, isd = hv == 6;
  const bool act = isb || (isd && l8 < 4);
  const u16* src = proj + tok * DIN + (isq ? 768 + 64 * hv : (isb ? 1024 + 64 * (hv - 4) : 2432)) + (act ? l8 * 8 : 0);
  float x[8];
  {
    u32x4 w = *(const u32x4*)src;
#pragma unroll
    for (int e = 0; e < 4; ++e) { x[2 * e] = bflo(w[e]); x[2 * e + 1] = bfhi(w[e]); }
  }
  float post = 1.f;
  if (isb) {
    float ss = 0.f;
#pragma unroll
    for (int e = 0; e < 8; ++e) ss += x[e] * x[e];
    ss += __shfl_xor(ss, 1); ss += __shfl_xor(ss, 2); ss += __shfl_xor(ss, 4);
    const float rstd = rsqrtf(ss * (1.f / 64.f) + EPS);
    const float* gain = (isq ? p.b_q_gain : p.b_k_gain) + layer * 64 + l8 * 8;
#pragma unroll
    for (int e = 0; e < 8; ++e) x[e] = x[e] * rstd * gain[e];
    if (isq) post = QSCALE64;
  }
  const int pos = isd ? t : ((l8 < 4) ? (t >> 6) : (t & 63));
  const f32x4* rt = (const f32x4*)(p.ws + OFF_ROPE) + (size_t)pos * 8 + (l8 & 1) * 4;
  const float sgn = (l8 & 2) ? 1.f : -1.f;
#pragma unroll
  for (int e2 = 0; e2 < 4; ++e2) {
    const f32x4 cs4 = rt[e2];
#pragma unroll
    for (int q = 0; q < 2; ++q) {
      const int e = 2 * e2 + q;
      const float other = __shfl_xor(x[e], 2);
      x[e] = (x[e] * cs4[2 * q] + sgn * other * cs4[2 * q + 1]) * post;
    }
  }
  u32x4 w;
#pragma unroll
  for (int e = 0; e < 4; ++e) w[e] = pack2(x[2 * e], x[2 * e + 1]);
  if (isb) *(u32x4*)(proj + tok * DIN + (isq ? 768 + 64 * hv : 1024 + 64 * (hv - 4)) + l8 * 8) = w;
  else if (isd && l8 < 4) {
    u16* kd = (u16*)(p.ws + OFF_KD) + tok * 384 + 64 + l8 * 8;
#pragma unroll
    for (int hh = 0; hh < 4; ++hh) *(u32x4*)(kd + hh * 96) = w;
  }
}

template <int MODE>
DI void attn_tile(const Params& p, int layer, int tile, char* smem) {
  constexpr int DQK = (MODE == 3) ? 96 : 64;
  constexpr int NKQ = DQK / 16;
  constexpr int KROW = DQK + 8;
  constexpr int VROW = 72;
  constexpr int KCH = DQK / 8;
  constexpr int KLD = (64 * KCH + NTHR - 1) / NTHR;
  u16* Ks = (u16*)smem;
  u16* Vs = (u16*)(smem + 26624);
  float* tbl = (float*)(smem + 26624 + 18432);

  const int tid = opaque_tid(), lane = tid & 63, wave = tid >> 6, r = lane & 31, h = lane >> 5;
  const int qb = tile & 15, head = (tile >> 4) & 3, seq = tile >> 6;
  const size_t tok0 = (size_t)seq * SEQ;
  const u16* proj = (const u16*)(p.ws + OFF_PROJ);
  const u16 *Qp, *Kp, *Vp;
  int ldq, ldk, ldv;
  if (MODE == 0) { Qp = proj + 64 * head; Kp = proj + 256 + 64 * head; Vp = proj + 512 + 64 * head; ldq = ldk = ldv = DIN; }
  else if (MODE == 1) { Qp = proj + 768 + 64 * head; Kp = proj + 1024 + 64 * (head >> 1); Vp = proj + 1152 + 64 * (head >> 1); ldq = ldk = ldv = DIN; }
  else if (MODE == 2) { Qp = proj + 1280 + 64 * head; Kp = proj + 1536 + 64 * head; Vp = proj + 1792 + 64 * head; ldq = ldk = ldv = DIN; }
  else { Qp = (const u16*)(p.ws + OFF_QD) + 96 * head; Kp = (const u16*)(p.ws + OFF_KD) + 96 * head; Vp = (const u16*)(p.ws + OFF_VD) + 64 * head; ldq = ldk = 384; ldv = 256; }

  int kt0 = 0, kt1 = 64;
  if (MODE == 0) { kt0 = 4 * qb - 16; if (kt0 < 0) kt0 = 0; kt1 = 4 * qb + 20; if (kt1 > 64) kt1 = 64; }
  if (MODE == 2) { int r0 = 4 * qb - 4; r0 = r0 < 0 ? 0 : (r0 > 56 ? 56 : r0); int r1 = 4 * qb + 3 - 4; r1 = r1 < 0 ? 0 : (r1 > 56 ? 56 : r1); kt0 = r0; kt1 = r1 + 8; }

  if (MODE == 0) { const float* src = (const float*)(p.ws + OFF_TBLA) + head * 2560; for (int i = tid; i < 2560; i += NTHR) tbl[i] = src[i]; }
  if (MODE == 2) { const float* src = p.c_rpb + (size_t)(layer * 4 + head) * 465; for (int i = tid; i < 465; i += NTHR) tbl[i] = src[i] * LOG2E; }

  const int qpos = qb * 256 + wave * 32 + r;
  bf16x8 qf[NKQ];
  {
    const u16* qrow = Qp + (tok0 + qpos) * ldq + 8 * h;
#pragma unroll
    for (int d0 = 0; d0 < NKQ; ++d0) qf[d0] = *(const bf16x8*)(qrow + d0 * 16);
  }
  if (MODE == 3) {
    bf16x8 x1 = qf[NKQ - 2], x2 = qf[NKQ - 1];
    const f32x4* rt = (const f32x4*)(p.ws + OFF_ROPE) + (size_t)qpos * 8 + 4 * h;
#pragma unroll
    for (int j2 = 0; j2 < 4; ++j2) {
      const f32x4 cs4 = rt[j2];
#pragma unroll
      for (int e = 0; e < 2; ++e) {
        const int j = 2 * j2 + e;
        const float c = cs4[2 * e], sn = cs4[2 * e + 1];
        float a = __uint_as_float(((unsigned)(u16)x1[j]) << 16), b = __uint_as_float(((unsigned)(u16)x2[j]) << 16);
        unsigned w = pack2(a * c - b * sn, a * sn + b * c);
        x1[j] = (short)(w & 0xffff); x2[j] = (short)(w >> 16);
      }
    }
    qf[NKQ - 2] = x1; qf[NKQ - 1] = x2;
  }

  u32x4 rk0[KLD], rv0, rk1[KLD], rv1;
  const u16* Kt = Kp + tok0 * ldk;
  const u16* Vt = Vp + tok0 * ldv;
  unsigned koff[KLD];
#pragma unroll
  for (int pp = 0; pp < KLD; ++pp) { int c = tid + NTHR * pp; if (c >= 64 * KCH) c = tid; const int row = c / KCH, col = c % KCH; koff[pp] = (unsigned)row * ldk + col * 8; }
  const unsigned voff = (unsigned)(tid >> 3) * ldv + (tid & 7) * 8;
  const int ktl = kt1 - 1;
  auto gload = [&](u32x4 (&rk)[KLD], u32x4& rv, int kt) {
    kt = kt < ktl ? kt : ktl;
#pragma unroll
    for (int pp = 0; pp < KLD; ++pp) rk[pp] = *(const u32x4*)(Kt + (koff[pp] + (unsigned)(kt * 64) * ldk));
    rv = *(const u32x4*)(Vt + (voff + (unsigned)(kt * 64) * ldv));
  };
  auto lstore = [&](u32x4 (&rk)[KLD], u32x4& rv, int buf) {
#pragma unroll
    for (int pp = 0; pp < KLD; ++pp) { const int c = tid + NTHR * pp; if (c < 64 * KCH) { const int row = c / KCH, col = c % KCH; *(u32x4*)(Ks + (buf * 64 + row) * KROW + col * 8) = rk[pp]; } }
    *(u32x4*)(Vs + (buf * 64 + (tid >> 3)) * VROW + (tid & 7) * 8) = rv;
  };

  f32x16 o0, o1, negm;
#pragma unroll
  for (int i = 0; i < 16; ++i) { o0[i] = 0.f; o1[i] = 0.f; negm[i] = 0.f; }
  float mref = 0.f, lsum = 0.f;
  bool started = false;
  int qr = 0, qc = 0, cs = 0, rs = 0;
  if (MODE == 2) { qr = qpos >> 6; qc = qpos & 63; cs = qc - 8; cs = cs < 0 ? 0 : (cs > 48 ? 48 : cs); rs = qr - 4; rs = rs < 0 ? 0 : (rs > 56 ? 56 : rs); }
  const int i16 = lane & 15, qq = i16 >> 2, pp4 = i16 & 3, g16 = (lane >> 4) & 1;

  auto compute = [&](int buf, int kt) {
    bool active = true;
    if (MODE == 2) active = (kt >= rs) && (kt < rs + 8);
    if (active) {
      const u16* Kb = Ks + buf * 64 * KROW + r * KROW + 8 * h;
      const u16* Vb = Vs + buf * 64 * VROW;
      f32x16 s0 = negm, s1 = negm;
#pragma unroll
      for (int d0 = 0; d0 < NKQ; ++d0) {
        bf16x8 k0 = *(const bf16x8*)(Kb + d0 * 16);
        bf16x8 k1 = *(const bf16x8*)(Kb + 32 * KROW + d0 * 16);
        s0 = mfma(k0, qf[d0], s0);
        s1 = mfma(k1, qf[d0], s1);
      }
      if (MODE == 0) {
        const float* tb = tbl + (kt * 64 + 4 * h - qpos + 1280);
#pragma unroll
        for (int i = 0; i < 16; ++i) { s0[i] += tb[(i & 3) + 8 * (i >> 2)]; s1[i] += tb[32 + (i & 3) + 8 * (i >> 2)]; }
      }
      if (MODE == 2) {
        const float* tb = tbl + (kt - qr + 7) * 31 + (15 - qc);
#pragma unroll
        for (int i = 0; i < 16; ++i) {
          const int kc0 = 4 * h + (i & 3) + 8 * (i >> 2), kc1 = kc0 + 32;
          const bool v0 = (kc0 >= cs) && (kc0 < cs + 16), v1 = (kc1 >= cs) && (kc1 < cs + 16);
          const float b0 = tb[v0 ? kc0 : qc], b1 = tb[v1 ? kc1 : qc];
          s0[i] = v0 ? s0[i] + b0 : NEGBIG;
          s1[i] = v1 ? s1[i] + b1 : NEGBIG;
        }
      }
      float ma = __builtin_fmaxf(__builtin_fmaxf(s0[0], s0[1]), s0[2]), mb = __builtin_fmaxf(__builtin_fmaxf(s1[0], s1[1]), s1[2]);
#pragma unroll
      for (int i = 3; i < 15; i += 2) { ma = __builtin_fmaxf(__builtin_fmaxf(ma, s0[i]), s0[i + 1]); mb = __builtin_fmaxf(__builtin_fmaxf(mb, s1[i]), s1[i + 1]); }
      float mt = __builtin_fmaxf(__builtin_fmaxf(ma, s0[15]), s1[15]);
      mt = hmax(__builtin_fmaxf(mt, mb));
      const bool fresh = !started && (mt > -1e29f);
      if (__any(fresh || (started && mt > 8.f))) {
        float delta = 0.f, al = 1.f;
        if (fresh) { delta = mt; started = true; }
        else if (started) { delta = __builtin_fmaxf(mt, 0.f); al = fexp2(-delta); }
        mref += delta;
        lsum *= al;
#pragma unroll
        for (int i = 0; i < 16; ++i) { o0[i] *= al; o1[i] *= al; s0[i] -= delta; s1[i] -= delta; negm[i] = -mref; }
      }
      float ps = 0.f;
#pragma unroll
      for (int i = 0; i < 16; ++i) { s0[i] = fexp2(s0[i]); s1[i] = fexp2(s1[i]); ps += s0[i] + s1[i]; }
      lsum += ps;
#pragma unroll
      for (int c = 0; c < 2; ++c) {
#pragma unroll
        for (int s = 0; s < 2; ++s) {
          u32x4 pw;
          if (c == 0) pw = (u32x4){pack2(s0[8 * s], s0[8 * s + 1]), pack2(s0[8 * s + 2], s0[8 * s + 3]), pack2(s0[8 * s + 4], s0[8 * s + 5]), pack2(s0[8 * s + 6], s0[8 * s + 7])};
          else pw = (u32x4){pack2(s1[8 * s], s1[8 * s + 1]), pack2(s1[8 * s + 2], s1[8 * s + 3]), pack2(s1[8 * s + 4], s1[8 * s + 5]), pack2(s1[8 * s + 6], s1[8 * s + 7])};
          const bf16x8 pf = __builtin_bit_cast(bf16x8, pw);
          const u16* vp = Vb + (32 * c + 16 * s + 4 * h + qq) * VROW + 16 * g16 + 4 * pp4;
          {
            s16x4 lo = tr_read(vp), hi = tr_read(vp + 8 * VROW);
            bf16x8 vf = __builtin_shufflevector(lo, hi, 0, 1, 2, 3, 4, 5, 6, 7);
            o0 = mfma(vf, pf, o0);
          }
          {
            s16x4 lo = tr_read(vp + 32), hi = tr_read(vp + 8 * VROW + 32);
            bf16x8 vf = __builtin_shufflevector(lo, hi, 0, 1, 2, 3, 4, 5, 6, 7);
            o1 = mfma(vf, pf, o1);
          }
        }
      }
    }
  };

  const int ntile = kt1 - kt0;
  gload(rk0, rv0, kt0);
  lstore(rk0, rv0, 0);
  gload(rk0, rv0, kt0 + 1);
  gload(rk1, rv1, kt0 + 2);
  __syncthreads();
  for (int j = 0; j < ntile; j += 2) {
    compute(0, kt0 + j);
    lstore(rk0, rv0, 1);
    gload(rk0, rv0, kt0 + j + 3);
    __syncthreads();
    if (j + 1 >= ntile) break;
    compute(1, kt0 + j + 1);
    lstore(rk1, rv1, 0);
    gload(rk1, rv1, kt0 + j + 4);
    __syncthreads();
  }
  lsum = hsum(lsum);
  const float inv = 1.f / lsum;
  float sq = 0.f;
#pragma unroll
  for (int i = 0; i < 16; ++i) { o0[i] *= inv; o1[i] *= inv; sq += o0[i] * o0[i] + o1[i] * o1[i]; }
  sq = hsum(sq);
  if (h == 0) ((float*)(p.ws + OFF_SSQ))[(tok0 + qpos) * 16 + MODE * 4 + head] = sq;
  u16* op = (u16*)(p.ws + OFF_ACTB) + (tok0 + qpos) * DM + MODE * 256 + head * 64 + 4 * h;
#pragma unroll
  for (int g4 = 0; g4 < 4; ++g4) {
    u32x2 w0 = {pack2(o0[4 * g4], o0[4 * g4 + 1]), pack2(o0[4 * g4 + 2], o0[4 * g4 + 3])};
    u32x2 w1 = {pack2(o1[4 * g4], o1[4 * g4 + 1]), pack2(o1[4 * g4 + 2], o1[4 * g4 + 3])};
    *(u32x2*)(op + 8 * g4) = w0;
    *(u32x2*)(op + 32 + 8 * g4) = w1;
  }
}


DI bool sb_tile(int bid, int nb, int it, int NT, int& mt, int& nt) {
  const int G = nb >> 3, x = bid & 7, l = bid >> 3;
  const int s = l + it * G;
  const int sb = (s >> 5) * 8 + x, w = s & 31;
  const int NG = NT >> 1;
  if (sb >= 24 * NG) return false;
  const int mg = sb / NG, ng = sb - mg * NG;
  mt = mg * 16 + (w >> 1); nt = ng * 2 + (w & 1);
  return true;
}

DI bool att_tile_index(int bid, int nb, int it, int& tile) {
  if (nb != 256) { tile = bid + it * nb; return tile < 1536; }
  const int x = bid & 7, l = bid >> 3;
  const int pair = 2 * (it * 8 + x) + (l >> 4);
  tile = pair * 16 + ((l + 3 * it) & 15);
  return pair < 96;
}

template <int EPI, bool GSCALE = false>
DI void gemm8_phase(const Params& p, int layer, const u16* A, const u16* Bt, int K, int NT, char* smem) {
  const int bid = blockIdx.x, nb = gridDim.x;
  int mt, nt;
  bool have = sb_tile(bid, nb, 0, NT, mt, nt);
  if (have) gemm8_prestage(A, Bt, K, mt * 256, nt * 256, smem);
  for (int it = 0; have; ++it) {
    int mt2 = 0, nt2 = 0;
    const bool have2 = sb_tile(bid, nb, it + 1, NT, mt2, nt2);
    gemm8_tile<EPI, GSCALE>(p, layer, A, Bt, K, mt * 256, nt * 256, smem, have2, mt2 * 256, nt2 * 256);
    have = have2; mt = mt2; nt = nt2;
  }
}

constexpr int NPHASE = 17;
constexpr int MT = T_TOK / 256;

DI void run_phase(const Params& p, int ph, char* smem) {
  const int bid = blockIdx.x, nb = gridDim.x;
  u16* wtb = (u16*)(p.ws + OFF_WT);
  const u16* actb = (const u16*)(p.ws + OFF_ACTB);
  if (ph == 0) {
    for (int j = bid; j < 128; j += nb) rope_tab_build(p.ws, j * NTHR + opaque_tid());
    for (int j = bid; j < WJ_TOTAL; j += nb) wprep_job(p, j, smem);
    for (int rb = bid; rb < T_TOK / 8; rb += nb) norm_rows(p, 0, rb, 0);
    return;
  }
  if (ph == 16) { for (int rb = bid; rb < T_TOK / 8; rb += nb) norm_rows(p, 1, rb, 1); return; }
  const int layer = (ph - 1) >> 3, sub = (ph - 1) & 7;
  const u16* wl = wtb + (size_t)layer * WT_LAYER;
  switch (sub) {
    case 0:
      gemm8_phase<EPI_PROJ>(p, layer, actb, wl + WT_IN, 1024, 10, smem);
      break;
    case 1:
      for (int c = bid; c < T_TOK / 8; c += nb) e1_chunk(p, layer, c);
      for (int t = bid; t < MT * 2; t += nb) { const int nt = t & 1, mt = t >> 1; gemm_tile<EPI_UQ, false, true>(p, layer, (const u16*)(p.ws + OFF_PROJ) + 2048, DIN, wl + WT_UQ, 256, mt * 256, nt * 256, smem); }
      for (int t = bid; t < MT * 2; t += nb) { const int nt = t & 1, mt = t >> 1; gemm_tile<EPI_UKV, false, true>(p, layer, (const u16*)(p.ws + OFF_PROJ) + 2304, DIN, wl + WT_UKV, 128, mt * 256, nt * 256, smem); }
      break;
    case 2:
      for (int it = 0, t; att_tile_index(bid, nb, it, t); ++it) attn_tile<3>(p, layer, t, smem);
      for (int it = 0, t; att_tile_index(bid, nb, it, t); ++it) attn_tile<1>(p, layer, t, smem);
      for (int it = 0, t; att_tile_index(bid, nb, it, t); ++it) attn_tile<0>(p, layer, t, smem);
      for (int it = 0, t; att_tile_index(bid, nb, it, t); ++it) attn_tile<2>(p, layer, t, smem);
      break;
    case 3:
      gemm8_phase<EPI_RES, true>(p, layer, actb, wl + WT_OUT, 1024, 4, smem);
      break;
    case 4:
      for (int rb = bid; rb < T_TOK / 8; rb += nb) norm_rows(p, 1, rb, 0);
      break;
    case 5:
      gemm8_phase<EPI_SWIGLU>(p, layer, actb, wl + WT_GU, 1024, 22, smem);
      break;
    case 6:
      gemm8_phase<EPI_RES>(p, 1, (const u16*)(p.ws + OFF_ACT), wl + WT_DN, DFF, 4, smem);
      break;
    case 7:
      for (int rb = bid; rb < T_TOK / 8; rb += nb) norm_rows(p, 1, rb, 0);
      break;
  }
}

__global__ void __launch_bounds__(NTHR, 2) mega(Params p, int ph_lo, int ph_hi) {
  __shared__ __attribute__((aligned(16))) char smem[SMEM_BYTES];
  cg::grid_group grid = cg::this_grid();
  for (int ph = ph_lo; ph < ph_hi; ++ph) {
    if (ph > ph_lo) grid.sync();
    run_phase(p, ph, smem);
#ifdef DUPMASK
    if (ph >= 1 && ph < 16 && ((DUPMASK >> ((ph - 1) & 7)) & 1)) { grid.sync(); run_phase(p, ph, smem); }
#endif
  }
}

extern "C" void kernel_launch(void* const* d_in, const int* in_sizes, int n_in, void* d_out, int out_size, void* d_ws, size_t ws_size, hipStream_t stream) {
  Params p{};
  p.x_prompt = (const float*)d_in[0]; p.x_sample = (const float*)d_in[1]; p.t5_bias = (const float*)d_in[2]; p.norm_mix = (const float*)d_in[3];
  p.w_in = (const float*)d_in[4]; p.b_q_gain = (const float*)d_in[5]; p.b_k_gain = (const float*)d_in[6]; p.c_rpb = (const float*)d_in[7];
  p.d_q_gain = (const float*)d_in[8]; p.d_w_uq = (const float*)d_in[9]; p.d_kv_gain = (const float*)d_in[10]; p.d_w_ukv = (const float*)d_in[11];
  p.out_gain = (const float*)d_in[12]; p.w_out = (const float*)d_in[13]; p.norm_ffn = (const float*)d_in[14]; p.w_gate = (const float*)d_in[15];
  p.w_up = (const float*)d_in[16]; p.w_down = (const float*)d_in[17]; p.final_norm = (const float*)d_in[18];
  p.out = (float*)d_out; p.ws = (char*)d_ws;
  if (ws_size < WS_NEED) { fprintf(stderr, "workspace too small: %zu < %zu\n", ws_size, (size_t)WS_NEED); return; }
  static int grid_blocks = 0;
  if (!grid_blocks) {
    int dev = 0, cus = 0, per_cu = 0;
    hipGetDevice(&dev);
    hipDeviceGetAttribute(&cus, hipDeviceAttributeMultiprocessorCount, dev);
    hipOccupancyMaxActiveBlocksPerMultiprocessor(&per_cu, mega, NTHR, 0);
    if (per_cu < 1) per_cu = 1;
    if (per_cu > 1) per_cu = 1;
    grid_blocks = cus * per_cu;
  }
#if ONE_LAUNCH
  int lo = 0, hi = NPHASE;
  void* args[] = {&p, &lo, &hi};
  hipError_t e = hipLaunchCooperativeKernel((void*)mega, dim3(grid_blocks), dim3(NTHR), args, 0, stream);
  if (e != hipSuccess) fprintf(stderr, "cooperative launch failed: %s (grid %d)\n", hipGetErrorString(e), grid_blocks);
#else
  for (int ph = 0; ph < NPHASE; ++ph) hipLaunchKernelGGL(mega, dim3(grid_blocks), dim3(NTHR), 0, stream, p, ph, ph + 1);
#endif
}
```

```cpp
#include <hip/hip_runtime.h>
#include <hip/hip_cooperative_groups.h>
#include <cstdio>
#include <cstdint>
namespace cg = cooperative_groups;

#ifndef ONE_LAUNCH
#define ONE_LAUNCH 1
#endif

#define DI __device__ __forceinline__
typedef short bf16x8 __attribute__((ext_vector_type(8)));
typedef short s16x4 __attribute__((ext_vector_type(4)));
typedef float f32x16 __attribute__((ext_vector_type(16)));
typedef float f32x4 __attribute__((ext_vector_type(4)));
typedef float f32x2 __attribute__((ext_vector_type(2)));
typedef unsigned u32x4 __attribute__((ext_vector_type(4)));
typedef unsigned u32x2 __attribute__((ext_vector_type(2)));
typedef __bf16 bf16v2 __attribute__((ext_vector_type(2)));
typedef unsigned short u16;

constexpr int T_TOK = 98304, SEQ = 4096, DM = 1024, DIN = 2464, DINP = 2560, DFF = 2816;
constexpr int NPROMPT = 8 * 4096;
constexpr int NTHR = 512;
constexpr float LOG2E = 1.4426950408889634f;
constexpr float QSCALE64 = 0.125f * LOG2E;
constexpr float QSCALE96 = 0.10206207261596575f * LOG2E;
constexpr float NEGBIG = -1e30f;
constexpr float EPS = 1e-6f;

constexpr size_t al256(size_t x) { return (x + 255) & ~(size_t)255; }
constexpr size_t WT_IN = 0;
constexpr size_t WT_UQ = WT_IN + (size_t)DINP * 1024;
constexpr size_t WT_UKV = WT_UQ + 512 * 256;
constexpr size_t WT_OUT = WT_UKV + 512 * 128;
constexpr size_t WT_GU = WT_OUT + 1024 * 1024;
constexpr size_t WT_DN = WT_GU + (size_t)5632 * 1024;
constexpr size_t WT_LAYER = WT_DN + (size_t)1024 * 2816;
constexpr size_t OFF_WT = 0;
constexpr size_t OFF_TBLA = al256(OFF_WT + 2 * WT_LAYER * 2);
constexpr size_t OFF_ROPE = al256(OFF_TBLA + 4 * 2560 * 4);
constexpr size_t OFF_ACTB = al256(OFF_ROPE + 4096 * 16 * 8);
constexpr size_t OFF_PROJ = al256(OFF_ACTB + (size_t)T_TOK * 1024 * 2);
constexpr size_t OFF_QD = al256(OFF_PROJ + (size_t)T_TOK * DIN * 2);
constexpr size_t OFF_KD = al256(OFF_QD + (size_t)T_TOK * 384 * 2);
constexpr size_t OFF_VD = al256(OFF_KD + (size_t)T_TOK * 384 * 2);
constexpr size_t OFF_SSQ = al256(OFF_VD + (size_t)T_TOK * 256 * 2);
constexpr size_t WS_NEED = al256(OFF_SSQ + (size_t)T_TOK * 16 * 4);
constexpr size_t OFF_ACT = OFF_PROJ;
static_assert(OFF_ACT + (size_t)T_TOK * DFF * 2 <= OFF_KD, "act alias overflow");

struct Params {
  const float *x_prompt, *x_sample, *t5_bias, *norm_mix, *w_in, *b_q_gain, *b_k_gain, *c_rpb, *d_q_gain, *d_w_uq,
      *d_kv_gain, *d_w_ukv, *out_gain, *w_out, *norm_ffn, *w_gate, *w_up, *w_down, *final_norm;
  float* out;
  char* ws;
};

constexpr int SMEM_BYTES = 2 * (256 + 256) * 72 * 2 + 1024;

DI unsigned pack2(float a, float b) { f32x2 v = {a, b}; bf16v2 r = __builtin_convertvector(v, bf16v2); return __builtin_bit_cast(unsigned, r); }
DI float bflo(unsigned w) { return __uint_as_float(w << 16); }
DI float bfhi(unsigned w) { return __uint_as_float(w & 0xffff0000u); }
DI f32x16 mfma(bf16x8 a, bf16x8 b, f32x16 c) { return __builtin_amdgcn_mfma_f32_32x32x16_bf16(a, b, c, 0, 0, 0); }
DI float hmax(float v) {
  auto rr = __builtin_amdgcn_permlane32_swap(__float_as_uint(v), __float_as_uint(v), false, false);
  return __builtin_fmaxf(__uint_as_float(rr[0]), __uint_as_float(rr[1]));
}
DI float hsum(float v) {
  auto rr = __builtin_amdgcn_permlane32_swap(__float_as_uint(v), __float_as_uint(v), false, false);
  return __uint_as_float(rr[0]) + __uint_as_float(rr[1]);
}
DI float fexp2(float x) { return __builtin_amdgcn_exp2f(x); }
DI int crow(int i, int h) { return (i & 3) + 8 * (i >> 2) + 4 * h; }
typedef short v4i16_t __attribute__((ext_vector_type(4)));
DI s16x4 tr_read(const u16* p) {
  return __builtin_bit_cast(s16x4, __builtin_amdgcn_ds_read_tr16_b64_v4i16((__attribute__((address_space(3))) v4i16_t*)p));
}
constexpr double inv_rev_c(int i) {
  constexpr double b[4] = {1.0, 0.5623413251903491, 0.31622776601683794, 0.1778279410038923};
  double v = b[i & 3];
  for (int k = 0; k < (i >> 2); ++k) v *= 0.1;
  return v * 0.15915494309189535;
}
DI void rope_tab_build(char* ws, int idx) {
  const int pos = idx >> 4, i = idx & 15;
  double invrev = inv_rev_c(0);
#pragma unroll
  for (int k = 1; k < 16; ++k) if (i == k) invrev = inv_rev_c(k);
  double rev = (double)pos * invrev;
  float f = (float)(rev - (double)(int)rev);
  f32x2 cs = {__builtin_amdgcn_cosf(f), __builtin_amdgcn_sinf(f)};
  ((f32x2*)(ws + OFF_ROPE))[idx] = cs;
}
#define ROPE16(ws_, pos_, A_, B_)                                                              \
  {                                                                                            \
    const f32x4* rt_ = (const f32x4*)((ws_) + OFF_ROPE) + (size_t)(pos_) * 8;                  \
    _Pragma("unroll") for (int i2_ = 0; i2_ < 8; ++i2_) {                                      \
      const f32x4 cs_ = rt_[i2_];                                                              \
      float a_ = A_[2 * i2_], b_ = B_[2 * i2_];                                                \
      A_[2 * i2_] = a_ * cs_[0] - b_ * cs_[1]; B_[2 * i2_] = a_ * cs_[1] + b_ * cs_[0];        \
      a_ = A_[2 * i2_ + 1]; b_ = B_[2 * i2_ + 1];                                              \
      A_[2 * i2_ + 1] = a_ * cs_[2] - b_ * cs_[3]; B_[2 * i2_ + 1] = a_ * cs_[3] + b_ * cs_[2]; \
    }                                                                                          \
  }
DI const float* xrow(const Params& p, int layer, size_t tok) {
  if (layer == 0) return tok < (size_t)NPROMPT ? p.x_prompt + tok * DM : p.x_sample + (tok - NPROMPT) * DM;
  return p.out + tok * DM;
}

DI int opaque_tid() { int t = threadIdx.x; asm volatile("" : "+v"(t)); return t; }
DI void wt_tile(const float* __restrict__ W, int K, int N, const float* __restrict__ g, u16* __restrict__ Wt, int k0, int n0, int mapmode, float* tile) {
  const int tid = opaque_tid();
  for (int i = tid; i < 4096; i += NTHR) {
    int kk = i >> 6, nn = i & 63, n = n0 + nn;
    float v = 0.f;
    if (n < N) { v = W[(size_t)(k0 + kk) * N + n]; if (g) v *= g[k0 + kk]; }
    tile[kk * 65 + nn] = v;
  }
  __syncthreads();
  for (int i = tid; i < 2048; i += NTHR) {
    int nn = i >> 5, kp = i & 31, n = n0 + nn;
    float cs = 1.f; int drow = n;
    if (mapmode == 1) { if (n < 256 || (n >= 1280 && n < 1536)) cs = QSCALE64; }
    else if (mapmode == 2) cs = QSCALE96;
    else if (mapmode == 3) drow = 32 * (n >> 4) + (n & 15);
    else if (mapmode == 4) drow = 32 * (n >> 4) + 16 + (n & 15);
    unsigned w = pack2(tile[(2 * kp) * 65 + nn] * cs, tile[(2 * kp + 1) * 65 + nn] * cs);
    *(unsigned*)(Wt + (size_t)drow * K + k0 + 2 * kp) = w;
  }
  __syncthreads();
}

constexpr int WJ_IN = 640, WJ_UQ = 32, WJ_UKV = 16, WJ_OUT = 256, WJ_G = 704, WJ_U = 704, WJ_D = 704;
constexpr int WJ_LAYER = WJ_IN + WJ_UQ + WJ_UKV + WJ_OUT + WJ_G + WJ_U + WJ_D;
constexpr int WJ_TOTAL = 2 * WJ_LAYER + 20;

DI void wprep_job(const Params& p, int job, char* smem) {
  float* tile = (float*)smem;
  u16* wtb = (u16*)(p.ws + OFF_WT);
  if (job >= 2 * WJ_LAYER) {
    int idx = (job - 2 * WJ_LAYER) * NTHR + opaque_tid();
    int head = idx / 2560, e = idx % 2560, d = e - 1280, n = d < 0 ? -d : d;
    int mult = (n <= 64 ? 1 : 0) + (((n & 3) == 0 && n <= 256) ? 1 : 0) + (((n & 15) == 0 && n <= 1024) ? 1 : 0);
    float v = NEGBIG;
    if (mult > 0) {
      int bk;
      if (n < 8) bk = n;
      else { float nf = (float)n; int lg = 8 + (int)(__logf(nf * 0.125f) / 4.852030263919617f * 8.0f); bk = lg < 15 ? lg : 15; }
      if (d > 0) bk += 16;
      v = (p.t5_bias[bk * 4 + head] + __logf((float)mult)) * LOG2E;
    }
    ((float*)(p.ws + OFF_TBLA))[idx] = v;
    return;
  }
  int layer = job / WJ_LAYER, j = job % WJ_LAYER;
  u16* wl = wtb + (size_t)layer * WT_LAYER;
  if (j < WJ_IN) { int kt = j & 15, nt = j >> 4; wt_tile(p.w_in + (size_t)layer * 1024 * DIN, 1024, DIN, p.norm_mix + layer * 1024, wl + WT_IN, kt * 64, nt * 64, 1, tile); return; }
  j -= WJ_IN;
  if (j < WJ_UQ) { int kt = j & 3, nt = j >> 2; wt_tile(p.d_w_uq + (size_t)layer * 256 * 384, 256, 384, p.d_q_gain + layer * 256, wl + WT_UQ, kt * 64, nt * 64, 2, tile); return; }
  j -= WJ_UQ;
  if (j < WJ_UKV) { int kt = j & 1, nt = j >> 1; wt_tile(p.d_w_ukv + (size_t)layer * 128 * 512, 128, 512, p.d_kv_gain + layer * 128, wl + WT_UKV, kt * 64, nt * 64, 0, tile); return; }
  j -= WJ_UKV;
  if (j < WJ_OUT) { int kt = j & 15, nt = j >> 4; wt_tile(p.w_out + (size_t)layer * 1024 * 1024, 1024, 1024, p.out_gain + layer * 1024, wl + WT_OUT, kt * 64, nt * 64, 0, tile); return; }
  j -= WJ_OUT;
  if (j < WJ_G) { int kt = j & 15, nt = j >> 4; wt_tile(p.w_gate + (size_t)layer * 1024 * DFF, 1024, DFF, p.norm_ffn + layer * 1024, wl + WT_GU, kt * 64, nt * 64, 3, tile); return; }
  j -= WJ_G;
  if (j < WJ_U) { int kt = j & 15, nt = j >> 4; wt_tile(p.w_up + (size_t)layer * 1024 * DFF, 1024, DFF, p.norm_ffn + layer * 1024, wl + WT_GU, kt * 64, nt * 64, 4, tile); return; }
  j -= WJ_U;
  { int kt = j % 44, nt = j / 44; wt_tile(p.w_down + (size_t)layer * DFF * 1024, DFF, 1024, nullptr, wl + WT_DN, kt * 64, nt * 64, 0, tile); }
}

DI void norm_rows(const Params& p, int layer, int rb, int mode) {
  const int tid = opaque_tid();
  const int lane = tid & 63, wave = tid >> 6;
  const size_t row = (size_t)rb * 8 + wave;
  const float* src = xrow(p, layer, row);
  f32x4 v[4];
  float ss = 0.f;
#pragma unroll
  for (int i = 0; i < 4; ++i) { v[i] = *(const f32x4*)(src + lane * 4 + 256 * i); ss += v[i][0] * v[i][0] + v[i][1] * v[i][1] + v[i][2] * v[i][2] + v[i][3] * v[i][3]; }
#pragma unroll
  for (int o = 1; o < 64; o <<= 1) ss += __shfl_xor(ss, o);
  const float rstd = rsqrtf(ss * (1.f / 1024.f) + EPS);
  if (mode == 0) {
    u16* dst = (u16*)(p.ws + OFF_ACTB) + row * DM;
#pragma unroll
    for (int i = 0; i < 4; ++i) { u32x2 w = {pack2(v[i][0] * rstd, v[i][1] * rstd), pack2(v[i][2] * rstd, v[i][3] * rstd)}; *(u32x2*)(dst + lane * 4 + 256 * i) = w; }
  } else {
    float* dst = p.out + row * DM;
#pragma unroll
    for (int i = 0; i < 4; ++i) { f32x4 g = *(const f32x4*)(p.final_norm + lane * 4 + 256 * i); f32x4 o = {v[i][0] * rstd * g[0], v[i][1] * rstd * g[1], v[i][2] * rstd * g[2], v[i][3] * rstd * g[3]}; *(f32x4*)(dst + lane * 4 + 256 * i) = o; }
  }
}

enum { EPI_PROJ = 0, EPI_UQ = 1, EPI_UKV = 2, EPI_RES = 3, EPI_SWIGLU = 4 };
constexpr int GS = 72;
constexpr int BM = 256;
constexpr int TMW = 4;

template <int EPI, bool ASCALE, bool ROWNORM>
DI void gemm_tile(const Params& p, int layer, const u16* __restrict__ A, int lda, const u16* __restrict__ Wt, int K, int m0, int n0, char* smem) {
  u16* As = (u16*)smem;
  u16* Bs = As + 2 * BM * GS;
  float* rowscale = (float*)(Bs + 2 * 256 * GS);
  const int tid = opaque_tid(), lane = tid & 63, wave = tid >> 6, r = lane & 31, h = lane >> 5;
  const int wm = wave >> 2, wn = wave & 3;
  const int lrow = tid >> 3, kc = tid & 7;
  const u16* At = A + (size_t)m0 * lda;
  const u16* Bt = Wt + (size_t)n0 * K;
  const unsigned aoff = (unsigned)lrow * lda + kc * 8, boff = (unsigned)lrow * K + kc * 8;
  const float* ssq = (const float*)(p.ws + OFF_SSQ);

  if (ROWNORM) {
    const int rr = tid >> 1, half = tid & 1;
    const u16* src = A + (size_t)(m0 + rr) * lda + half * (K / 2);
    float ss = 0.f;
    for (int i = 0; i < K / 16; ++i) {
      u32x4 w = *(const u32x4*)(src + i * 8);
#pragma unroll
      for (int e = 0; e < 4; ++e) { float a = bflo(w[e]), b = bfhi(w[e]); ss += a * a + b * b; }
    }
    ss += __shfl_xor(ss, 1);
    if (half == 0) rowscale[rr] = rsqrtf(ss / (float)K + EPS);
  }

  f32x16 acc[TMW][2];
#pragma unroll
  for (int a = 0; a < TMW; ++a)
#pragma unroll
    for (int b = 0; b < 2; ++b)
#pragma unroll
      for (int i = 0; i < 16; ++i) acc[a][b][i] = 0.f;

  u32x4 ra[4], rb[4];
  float sc[4] = {1.f, 1.f, 1.f, 1.f};
  const int KT = K / 64;
  auto gload = [&](int kt) {
#pragma unroll
    for (int pp = 0; pp < 4; ++pp) ra[pp] = *(const u32x4*)(At + (size_t)(64 * pp) * lda + (aoff + (unsigned)kt * 64));
#pragma unroll
    for (int pp = 0; pp < 4; ++pp) rb[pp] = *(const u32x4*)(Bt + (size_t)(64 * pp) * K + (boff + (unsigned)kt * 64));
  };
  auto lstore = [&](int buf, int kt) {
    if (ASCALE) {
      if ((kt & 3) == 0) {
        const int g = kt >> 2;
#pragma unroll
        for (int pp = 0; pp < 4; ++pp) {
          f32x4 s4 = *(const f32x4*)(ssq + (size_t)(m0 + lrow + 64 * pp) * 16 + 4 * g);
          sc[pp] = rsqrtf((s4[0] + s4[1] + s4[2] + s4[3]) * (1.f / 256.f) + EPS);
        }
      }
#pragma unroll
      for (int pp = 0; pp < 4; ++pp)
#pragma unroll
        for (int e = 0; e < 4; ++e) ra[pp][e] = pack2(bflo(ra[pp][e]) * sc[pp], bfhi(ra[pp][e]) * sc[pp]);
    }
#pragma unroll
    for (int pp = 0; pp < 4; ++pp) *(u32x4*)(As + (buf * BM + lrow + 64 * pp) * GS + kc * 8) = ra[pp];
#pragma unroll
    for (int pp = 0; pp < 4; ++pp) *(u32x4*)(Bs + (buf * 256 + lrow + 64 * pp) * GS + kc * 8) = rb[pp];
  };
  auto compute = [&](int buf) {
    const u16* Ab = As + (buf * BM + wm * 128 + r) * GS + 8 * h;
    const u16* Bb = Bs + (buf * 256 + wn * 64 + r) * GS + 8 * h;
#pragma unroll
    for (int ks = 0; ks < 4; ++ks) {
      bf16x8 b0 = *(const bf16x8*)(Bb + ks * 16);
      bf16x8 b1 = *(const bf16x8*)(Bb + 32 * GS + ks * 16);
#pragma unroll
      for (int tm = 0; tm < TMW; ++tm) {
        bf16x8 a = *(const bf16x8*)(Ab + tm * 32 * GS + ks * 16);
        acc[tm][0] = mfma(a, b0, acc[tm][0]);
        acc[tm][1] = mfma(a, b1, acc[tm][1]);
      }
    }
  };
  gload(0);
  lstore(0, 0);
  if (KT > 1) gload(1);
  __syncthreads();
  for (int kt = 0; kt < KT; ++kt) {
    compute(kt & 1);
    if (kt + 1 < KT) lstore((kt + 1) & 1, kt + 1);
    if (kt + 2 < KT) gload(kt + 2);
    __syncthreads();
  }

  const int wms = __builtin_amdgcn_readfirstlane(wm), wns = __builtin_amdgcn_readfirstlane(wn);
  const int mrow0 = m0 + wms * 128;
  const int nwb = n0 + wns * 64;
  if (ROWNORM) {
#pragma unroll
    for (int tm = 0; tm < TMW; ++tm) {
#pragma unroll
      for (int i = 0; i < 16; ++i) {
        const float rs = rowscale[wms * 128 + 4 * h + 32 * tm + (i & 3) + 8 * (i >> 2)];
        acc[tm][0][i] *= rs; acc[tm][1][i] *= rs;
      }
    }
  }
  if (EPI == EPI_SWIGLU) {
    u16* dw = (u16*)(p.ws + OFF_ACT) + (size_t)mrow0 * DFF + (nwb >> 1);
    const unsigned lo = (unsigned)(4 * h) * DFF + r;
#pragma unroll
    for (int tm = 0; tm < TMW; ++tm) {
#pragma unroll
      for (int i = 0; i < 16; ++i) {
        const float g = acc[tm][0][i], u = acc[tm][1][i];
        const float a = g * __builtin_amdgcn_rcpf(1.f + fexp2(-g * LOG2E)) * u;
        dw[lo + (unsigned)((32 * tm + (i & 3) + 8 * (i >> 2)) * DFF)] = (u16)(pack2(a, 0.f) & 0xffff);
      }
      __builtin_amdgcn_sched_barrier(0);
    }
  } else {
#pragma unroll
    for (int tn = 0; tn < 2; ++tn) {
      const int nb0 = nwb + 32 * tn;
      if (EPI == EPI_RES) {
        const float* xw = (layer == 0 ? (m0 < NPROMPT ? p.x_prompt + (size_t)mrow0 * DM : p.x_sample + (size_t)(mrow0 - NPROMPT) * DM) : p.out + (size_t)mrow0 * DM) + nb0;
        float* ow = p.out + (size_t)mrow0 * DM + nb0;
        const unsigned lo = (unsigned)(4 * h) * DM + r;
#pragma unroll
        for (int tm = 0; tm < TMW; ++tm) {
#pragma unroll
          for (int g4 = 0; g4 < 4; ++g4) {
            float xv[4];
#pragma unroll
            for (int e = 0; e < 4; ++e) xv[e] = xw[lo + (unsigned)((32 * tm + 8 * g4 + e) * DM)];
#pragma unroll
            for (int e = 0; e < 4; ++e) ow[lo + (unsigned)((32 * tm + 8 * g4 + e) * DM)] = xv[e] + acc[tm][tn][4 * g4 + e];
          }
          __builtin_amdgcn_sched_barrier(0);
        }
      } else {
        u16* dw; int ld; bool ok = true;
        if (EPI == EPI_PROJ) { dw = (u16*)(p.ws + OFF_PROJ) + (size_t)mrow0 * DIN + nb0; ld = DIN; ok = (nb0 + r) < DIN; }
        else if (EPI == EPI_UQ) { dw = (u16*)(p.ws + OFF_QD) + (size_t)mrow0 * 384 + nb0; ld = 384; ok = nb0 < 384; }
        else {
          const int head = nb0 >> 7, w = nb0 & 127;
          if (w < 64) { dw = (u16*)(p.ws + OFF_KD) + (size_t)mrow0 * 384 + head * 96 + w; ld = 384; }
          else { dw = (u16*)(p.ws + OFF_VD) + (size_t)mrow0 * 256 + head * 64 + (w - 64); ld = 256; }
        }
        const unsigned lo = (unsigned)(4 * h) * ld + r;
        if (ok) {
#pragma unroll
          for (int tm = 0; tm < TMW; ++tm) {
#pragma unroll
            for (int i = 0; i < 16; ++i) dw[lo + (unsigned)((32 * tm + (i & 3) + 8 * (i >> 2)) * ld)] = (u16)(pack2(acc[tm][tn][i], 0.f) & 0xffff);
            __builtin_amdgcn_sched_barrier(0);
          }
        }
      }
    }
  }
  if (ROWNORM) __syncthreads();
}


typedef float f32x4v __attribute__((ext_vector_type(4)));
constexpr int G8_HT = 128 * 64;
DI int lds_byte8(int r, int c) { const int st = (r >> 4) * 2 + (c >> 5), ob = (r & 15) * 64 + (c & 31) * 2; return st * 1024 + (ob ^ (((ob >> 9) & 1) << 5)); }
DI void stage_rc8(int b, int& R, int& C) { const int st = b >> 10, sb = b & 1023, swz = sb ^ (((sb >> 9) & 1) << 5); R = (st >> 1) * 16 + (swz >> 6); C = (st & 1) * 32 + ((swz & 63) >> 1); }

DI void gemm8_prestage(const u16* __restrict__ A, const u16* __restrict__ Bt, int K, int brow, int bcol, char* smem) {
  u16* shm = (u16*)smem;
  const int tid = opaque_tid();
  int sr0, sc0, sr1, sc1;
  stage_rc8(tid * 16, sr0, sc0);
  stage_rc8(tid * 16 + 8192, sr1, sc1);
  const unsigned go0 = (unsigned)sr0 * K + sc0, go1 = (unsigned)sr1 * K + sc1;
#define G8P_STAGE(P, BASE, br) do { const u16* g_ = (BASE) + (size_t)(br) * K; \
    __builtin_amdgcn_global_load_lds((const unsigned*)(g_ + go0), (__attribute__((address_space(3))) unsigned*)((char*)(P) + tid * 16), 16, 0, 0); \
    __builtin_amdgcn_global_load_lds((const unsigned*)(g_ + go1), (__attribute__((address_space(3))) unsigned*)((char*)(P) + tid * 16 + 8192), 16, 0, 0); } while (0)
  G8P_STAGE(shm + 4 * G8_HT, Bt, bcol); G8P_STAGE(shm, A, brow);
  G8P_STAGE(shm + 5 * G8_HT, Bt, bcol + 128); G8P_STAGE(shm + G8_HT, A, brow + 128);
#undef G8P_STAGE
}

template <int EPI, bool GSCALE = false>
DI void gemm8_tile(const Params& p, int layer, const u16* __restrict__ A, const u16* __restrict__ Bt, int K, int brow, int bcol, char* smem,
                   bool next_valid, int next_brow, int next_bcol) {
  u16* shm = (u16*)smem;
  const int tid = opaque_tid();
  float* gfac = (float*)(smem + 8 * G8_HT * 2);
  if (GSCALE) {
    if (tid < 256) {
      const float* sq = (const float*)(p.ws + OFF_SSQ) + (size_t)(brow + tid) * 16;
      float rs[4];
#pragma unroll
      for (int g = 0; g < 4; ++g) { const f32x4 s4 = *(const f32x4*)(sq + 4 * g); rs[g] = rsqrtf((s4[0] + s4[1] + s4[2] + s4[3]) * (1.f / 256.f) + EPS); }
      gfac[tid] = rs[0] / rs[1]; gfac[256 + tid] = rs[1] / rs[2]; gfac[512 + tid] = rs[2] / rs[3]; gfac[768 + tid] = rs[3];
    }
  }
  const int wid = tid >> 6, lane = tid & 63, wr = wid >> 2, wc = wid & 3, fr = lane & 15, fq = lane >> 4;
  int sr0, sc0, sr1, sc1;
  stage_rc8(tid * 16, sr0, sc0);
  stage_rc8(tid * 16 + 8192, sr1, sc1);
  const unsigned go0 = (unsigned)sr0 * K + sc0, go1 = (unsigned)sr1 * K + sc1;
#define G8_SA(b, hh) (shm + ((b) * 2 + (hh)) * G8_HT)
#define G8_SB(b, hh) (shm + (4 + (b) * 2 + (hh)) * G8_HT)
#define G8_STAGE(P, BASE, br, kt) do { const u16* g_ = (BASE) + (size_t)(br) * K + (size_t)(kt) * 64; \
    __builtin_amdgcn_global_load_lds((const unsigned*)(g_ + go0), (__attribute__((address_space(3))) unsigned*)((char*)(P) + tid * 16), 16, 0, 0); \
    __builtin_amdgcn_global_load_lds((const unsigned*)(g_ + go1), (__attribute__((address_space(3))) unsigned*)((char*)(P) + tid * 16 + 8192), 16, 0, 0); } while (0)
#define G8_LDA(dst, b, hh) _Pragma("unroll") for (int m = 0; m < 4; ++m) _Pragma("unroll") for (int k = 0; k < 2; ++k) \
    dst[m][k] = *reinterpret_cast<const bf16x8*>((char*)G8_SA(b, hh) + lds_byte8(wr * 64 + m * 16 + fr, k * 32 + fq * 8))
#define G8_LDB(dst, b, hh) _Pragma("unroll") for (int n = 0; n < 2; ++n) _Pragma("unroll") for (int k = 0; k < 2; ++k) \
    dst[n][k] = *reinterpret_cast<const bf16x8*>((char*)G8_SB(b, hh) + lds_byte8(wc * 32 + n * 16 + fr, k * 32 + fq * 8))
#define G8_MMA(ai, bj, At_, Bt_) do { __builtin_amdgcn_s_setprio(1); \
    _Pragma("unroll") for (int m = 0; m < 4; ++m) _Pragma("unroll") for (int n = 0; n < 2; ++n) _Pragma("unroll") for (int k = 0; k < 2; ++k) \
      acc[ai][bj][m][n] = __builtin_amdgcn_mfma_f32_16x16x32_bf16(At_[m][k], Bt_[n][k], acc[ai][bj][m][n], 0, 0, 0); \
    __builtin_amdgcn_s_setprio(0); } while (0)
#define G8_WAIT_V(n) asm volatile("s_waitcnt vmcnt(" #n ")" ::: "memory")
#define G8_WAIT_L(n) asm volatile("s_waitcnt lgkmcnt(" #n ")" ::: "memory")
#define G8_BAR __builtin_amdgcn_s_barrier()
#define G8_SCHED __builtin_amdgcn_sched_barrier(0)
  f32x4v acc[2][2][4][2];
#pragma unroll
  for (int a = 0; a < 2; ++a)
#pragma unroll
    for (int b = 0; b < 2; ++b)
#pragma unroll
      for (int m = 0; m < 4; ++m)
#pragma unroll
        for (int n = 0; n < 2; ++n) acc[a][b][m][n] = (f32x4v){0.f, 0.f, 0.f, 0.f};
  bf16x8 At[4][2], B0[2][2], B1[2][2];
  const int nt = K / 64;
  if (wr == 1) G8_BAR;
  G8_WAIT_V(4); G8_BAR;
  G8_STAGE(G8_SB(1, 0), Bt, bcol, 1); G8_STAGE(G8_SA(1, 0), A, brow, 1); G8_STAGE(G8_SB(1, 1), Bt, bcol + 128, 1);
  G8_WAIT_V(6); G8_BAR;
  for (int t = 0; t < nt - 2; t += 2) {
    G8_LDB(B0, 0, 0); G8_SCHED; G8_LDA(At, 0, 0); G8_STAGE(G8_SA(1, 1), A, brow + 128, t + 1);
    G8_WAIT_L(8); G8_BAR; G8_WAIT_L(0); G8_MMA(0, 0, At, B0); G8_BAR; G8_SCHED;
    G8_LDB(B1, 0, 1); G8_STAGE(G8_SB(0, 0), Bt, bcol, t + 2);
    G8_BAR; G8_WAIT_L(0); G8_MMA(0, 1, At, B1); G8_BAR;
    G8_LDA(At, 0, 1); G8_STAGE(G8_SA(0, 0), A, brow, t + 2);
    G8_BAR; G8_WAIT_L(0); G8_MMA(1, 0, At, B0); G8_BAR; G8_SCHED;
    G8_STAGE(G8_SB(0, 1), Bt, bcol + 128, t + 2);
    G8_WAIT_V(6); G8_BAR; G8_MMA(1, 1, At, B1); G8_BAR;
    G8_LDB(B0, 1, 0); G8_SCHED; G8_LDA(At, 1, 0); G8_STAGE(G8_SA(0, 1), A, brow + 128, t + 2);
    G8_WAIT_L(8); G8_BAR; G8_WAIT_L(0); G8_MMA(0, 0, At, B0); G8_BAR; G8_SCHED;
    G8_LDB(B1, 1, 1); G8_STAGE(G8_SB(1, 0), Bt, bcol, t + 3);
    G8_BAR; G8_WAIT_L(0); G8_MMA(0, 1, At, B1); G8_BAR;
    G8_LDA(At, 1, 1); G8_STAGE(G8_SA(1, 0), A, brow, t + 3);
    G8_BAR; G8_WAIT_L(0); G8_MMA(1, 0, At, B0); G8_BAR; G8_SCHED;
    G8_STAGE(G8_SB(1, 1), Bt, bcol + 128, t + 3);
    G8_WAIT_V(6); G8_BAR; G8_MMA(1, 1, At, B1); G8_BAR;
    if (GSCALE && (t & 3) == 2) {
      const float* gf = gfac + (t >> 2) * 256 + wr * 64 + fq * 4;
#pragma unroll
      for (int ai = 0; ai < 2; ++ai)
#pragma unroll
        for (int m = 0; m < 4; ++m) {
          const f32x4 f4 = *(const f32x4*)(gf + ai * 128 + m * 16);
#pragma unroll
          for (int bj = 0; bj < 2; ++bj)
#pragma unroll
            for (int n = 0; n < 2; ++n)
#pragma unroll
              for (int j = 0; j < 4; ++j) acc[ai][bj][m][n][j] *= f4[j];
        }
    }
  }
  { G8_LDB(B0, 0, 0); G8_LDA(At, 0, 0); G8_STAGE(G8_SA(1, 1), A, brow + 128, nt - 1);
    G8_BAR; G8_WAIT_L(0); G8_MMA(0, 0, At, B0); G8_BAR;
    G8_LDB(B1, 0, 1); G8_BAR; G8_WAIT_L(0); G8_MMA(0, 1, At, B1); G8_BAR;
    G8_LDA(At, 0, 1); G8_WAIT_V(4); G8_BAR; G8_WAIT_L(0); G8_MMA(1, 0, At, B0); G8_MMA(1, 1, At, B1); G8_BAR; }
  { G8_LDB(B0, 1, 0); G8_LDA(At, 1, 0); G8_WAIT_V(2); G8_BAR; G8_WAIT_L(0); G8_MMA(0, 0, At, B0); G8_BAR;
    G8_LDB(B1, 1, 1); G8_WAIT_V(0); G8_BAR; G8_WAIT_L(0); G8_MMA(0, 1, At, B1); G8_BAR;
    G8_LDA(At, 1, 1); G8_BAR; G8_WAIT_L(0); G8_MMA(1, 0, At, B0); G8_MMA(1, 1, At, B1); G8_BAR; }
  if (wr == 0) G8_BAR;
  if (GSCALE) {
    const float* gf = gfac + 768 + wr * 64 + fq * 4;
#pragma unroll
    for (int ai = 0; ai < 2; ++ai)
#pragma unroll
      for (int m = 0; m < 4; ++m) {
        const f32x4 f4 = *(const f32x4*)(gf + ai * 128 + m * 16);
#pragma unroll
        for (int bj = 0; bj < 2; ++bj)
#pragma unroll
          for (int n = 0; n < 2; ++n)
#pragma unroll
            for (int j = 0; j < 4; ++j) acc[ai][bj][m][n][j] *= f4[j];
      }
  }
  if (next_valid) gemm8_prestage(A, Bt, K, next_brow, next_bcol, smem);
  const int wrs = __builtin_amdgcn_readfirstlane(wr), wcs = __builtin_amdgcn_readfirstlane(wc);
#pragma unroll
  for (int ai = 0; ai < 2; ++ai) {
    const int mrow0 = brow + ai * 128 + wrs * 64;
#pragma unroll
    for (int bj = 0; bj < 2; ++bj) {
      const int ncol0 = bcol + bj * 128 + wcs * 32;
      if (EPI == EPI_SWIGLU) {
        u16* dw = (u16*)(p.ws + OFF_ACT) + (size_t)mrow0 * DFF + (ncol0 >> 1);
        const unsigned lo = (unsigned)(fq * 4) * DFF + fr;
#pragma unroll
        for (int m = 0; m < 4; ++m) {
#pragma unroll
          for (int j = 0; j < 4; ++j) {
            const float g = acc[ai][bj][m][0][j], u = acc[ai][bj][m][1][j];
            const float a = g * __builtin_amdgcn_rcpf(1.f + fexp2(-g * LOG2E)) * u;
            dw[lo + (unsigned)((m * 16 + j) * DFF)] = (u16)(pack2(a, 0.f) & 0xffff);
          }
        }
        __builtin_amdgcn_sched_barrier(0);
      } else if (EPI == EPI_RES) {
#pragma unroll
        for (int n = 0; n < 2; ++n) {
          const float* xw = (layer == 0 ? (brow < NPROMPT ? p.x_prompt + (size_t)mrow0 * DM : p.x_sample + (size_t)(mrow0 - NPROMPT) * DM) : p.out + (size_t)mrow0 * DM) + ncol0 + n * 16;
          float* ow = p.out + (size_t)mrow0 * DM + ncol0 + n * 16;
          const unsigned lo = (unsigned)(fq * 4) * DM + fr;
#pragma unroll
          for (int m = 0; m < 4; ++m) {
            float xv[4];
#pragma unroll
            for (int j = 0; j < 4; ++j) xv[j] = xw[lo + (unsigned)((m * 16 + j) * DM)];
#pragma unroll
            for (int j = 0; j < 4; ++j) ow[lo + (unsigned)((m * 16 + j) * DM)] = xv[j] + acc[ai][bj][m][n][j];
          }
          __builtin_amdgcn_sched_barrier(0);
        }
      } else {
#pragma unroll
        for (int n = 0; n < 2; ++n) {
          const int nb0 = ncol0 + n * 16;
          if (nb0 < DIN) {
            u16* dw = (u16*)(p.ws + OFF_PROJ) + (size_t)mrow0 * DIN + nb0;
            const unsigned lo = (unsigned)(fq * 4) * DIN + fr;
#pragma unroll
            for (int m = 0; m < 4; ++m)
#pragma unroll
              for (int j = 0; j < 4; ++j) dw[lo + (unsigned)((m * 16 + j) * DIN)] = (u16)(pack2(acc[ai][bj][m][n][j], 0.f) & 0xffff);
          }
          __builtin_amdgcn_sched_barrier(0);
        }
      }
    }
  }
  G8_WAIT_V(0);
  __syncthreads();
}

DI void e1_chunk(const Params& p, int layer, int chunk) {
  const int j = chunk & 7;
  const size_t tok = (size_t)(chunk >> 3) * NTHR + opaque_tid();
  if (j == 7) return;
  u16* proj = (u16*)(p.ws + OFF_PROJ);
  const int t = (int)(tok & 4095);
  if (j < 6) {
    u16* ptr = proj + tok * DIN + (j < 4 ? 768 + 64 * j : 1024 + 64 * (j - 4));
    const float* gain = (j < 4 ? p.b_q_gain : p.b_k_gain) + layer * 64;
    const float post = j < 4 ? QSCALE64 : 1.f;
    float x[64];
    float ss = 0.f;
#pragma unroll
    for (int c = 0; c < 8; ++c) {
      u32x4 w = *(const u32x4*)(ptr + c * 8);
#pragma unroll
      for (int e = 0; e < 4; ++e) { x[c * 8 + 2 * e] = bflo(w[e]); x[c * 8 + 2 * e + 1] = bfhi(w[e]); }
    }
#pragma unroll
    for (int d = 0; d < 64; ++d) ss += x[d] * x[d];
    const float rstd = rsqrtf(ss * (1.f / 64.f) + EPS);
    __builtin_amdgcn_sched_barrier(0);
#pragma unroll
    for (int c = 0; c < 4; ++c) {
#pragma unroll
      for (int d = 0; d < 16; ++d) x[c * 16 + d] = x[c * 16 + d] * rstd * gain[c * 16 + d];
      __builtin_amdgcn_sched_barrier(0);
    }
    const int prow = t >> 6, pcol = t & 63;
    { float* xa = x; float* xb = x + 16; ROPE16(p.ws, prow, xa, xb); }
    __builtin_amdgcn_sched_barrier(0);
    { float* xa = x + 32; float* xb = x + 48; ROPE16(p.ws, pcol, xa, xb); }
    __builtin_amdgcn_sched_barrier(0);
#pragma unroll
    for (int c = 0; c < 8; ++c) {
      u32x4 w;
#pragma unroll
      for (int e = 0; e < 4; ++e) w[e] = pack2(x[c * 8 + 2 * e] * post, x[c * 8 + 2 * e + 1] * post);
      *(u32x4*)(ptr + c * 8) = w;
    }
  } else {
    const u16* src = proj + tok * DIN + 2432;
    float x[32];
#pragma unroll
    for (int c = 0; c < 4; ++c) {
      u32x4 w = *(const u32x4*)(src + c * 8);
#pragma unroll
      for (int e = 0; e < 4; ++e) { x[c * 8 + 2 * e] = bflo(w[e]); x[c * 8 + 2 * e + 1] = bfhi(w[e]); }
    }
    { float* xa = x; float* xb = x + 16; ROPE16(p.ws, t, xa, xb); }
    u16* kd = (u16*)(p.ws + OFF_KD) + tok * 384 + 64;
#pragma unroll
    for (int c = 0; c < 4; ++c) {
      u32x4 w;
#pragma unroll
      for (int e = 0; e < 4; ++e) w[e] = pack2(x[c * 8 + 2 * e], x[c * 8 + 2 * e + 1]);
#pragma unroll
      for (int hh = 0; hh < 4; ++hh) *(u32x4*)(kd + hh * 96 + c * 8) = w;
    }
  }
}

template <int MODE>
DI void attn_tile(const Params& p, int layer, int tile, char* smem) {
  constexpr int DQK = (MODE == 3) ? 96 : 64;
  constexpr int NKQ = DQK / 16;
  constexpr int KROW = DQK + 8;
  constexpr int VROW = 72;
  constexpr int KCH = DQK / 8;
  constexpr int KLD = (64 * KCH + NTHR - 1) / NTHR;
  u16* Ks = (u16*)smem;
  u16* Vs = (u16*)(smem + 26624);
  float* tbl = (float*)(smem + 26624 + 18432);

  const int tid = opaque_tid(), lane = tid & 63, wave = tid >> 6, r = lane & 31, h = lane >> 5;
  const int qb = tile & 15, head = (tile >> 4) & 3, seq = tile >> 6;
  const size_t tok0 = (size_t)seq * SEQ;
  const u16* proj = (const u16*)(p.ws + OFF_PROJ);
  const u16 *Qp, *Kp, *Vp;
  int ldq, ldk, ldv;
  if (MODE == 0) { Qp = proj + 64 * head; Kp = proj + 256 + 64 * head; Vp = proj + 512 + 64 * head; ldq = ldk = ldv = DIN; }
  else if (MODE == 1) { Qp = proj + 768 + 64 * head; Kp = proj + 1024 + 64 * (head >> 1); Vp = proj + 1152 + 64 * (head >> 1); ldq = ldk = ldv = DIN; }
  else if (MODE == 2) { Qp = proj + 1280 + 64 * head; Kp = proj + 1536 + 64 * head; Vp = proj + 1792 + 64 * head; ldq = ldk = ldv = DIN; }
  else { Qp = (const u16*)(p.ws + OFF_QD) + 96 * head; Kp = (const u16*)(p.ws + OFF_KD) + 96 * head; Vp = (const u16*)(p.ws + OFF_VD) + 64 * head; ldq = ldk = 384; ldv = 256; }

  int kt0 = 0, kt1 = 64;
  if (MODE == 0) { kt0 = 4 * qb - 16; if (kt0 < 0) kt0 = 0; kt1 = 4 * qb + 20; if (kt1 > 64) kt1 = 64; }
  if (MODE == 2) { int r0 = 4 * qb - 4; r0 = r0 < 0 ? 0 : (r0 > 56 ? 56 : r0); int r1 = 4 * qb + 3 - 4; r1 = r1 < 0 ? 0 : (r1 > 56 ? 56 : r1); kt0 = r0; kt1 = r1 + 8; }

  if (MODE == 0) { const float* src = (const float*)(p.ws + OFF_TBLA) + head * 2560; for (int i = tid; i < 2560; i += NTHR) tbl[i] = src[i]; }
  if (MODE == 2) { const float* src = p.c_rpb + (size_t)(layer * 4 + head) * 465; for (int i = tid; i < 465; i += NTHR) tbl[i] = src[i] * LOG2E; }

  const int qpos = qb * 256 + wave * 32 + r;
  bf16x8 qf[NKQ];
  {
    const u16* qrow = Qp + (tok0 + qpos) * ldq + 8 * h;
#pragma unroll
    for (int d0 = 0; d0 < NKQ; ++d0) qf[d0] = *(const bf16x8*)(qrow + d0 * 16);
  }
  if (MODE == 3) {
    bf16x8 x1 = qf[NKQ - 2], x2 = qf[NKQ - 1];
    const f32x4* rt = (const f32x4*)(p.ws + OFF_ROPE) + (size_t)qpos * 8 + 4 * h;
#pragma unroll
    for (int j2 = 0; j2 < 4; ++j2) {
      const f32x4 cs4 = rt[j2];
#pragma unroll
      for (int e = 0; e < 2; ++e) {
        const int j = 2 * j2 + e;
        const float c = cs4[2 * e], sn = cs4[2 * e + 1];
        float a = __uint_as_float(((unsigned)(u16)x1[j]) << 16), b = __uint_as_float(((unsigned)(u16)x2[j]) << 16);
        unsigned w = pack2(a * c - b * sn, a * sn + b * c);
        x1[j] = (short)(w & 0xffff); x2[j] = (short)(w >> 16);
      }
    }
    qf[NKQ - 2] = x1; qf[NKQ - 1] = x2;
  }

  u32x4 rk0[KLD], rv0, rk1[KLD], rv1;
  const u16* Kt = Kp + tok0 * ldk;
  const u16* Vt = Vp + tok0 * ldv;
  unsigned koff[KLD];
#pragma unroll
  for (int pp = 0; pp < KLD; ++pp) { int c = tid + NTHR * pp; if (c >= 64 * KCH) c = tid; const int row = c / KCH, col = c % KCH; koff[pp] = (unsigned)row * ldk + col * 8; }
  const unsigned voff = (unsigned)(tid >> 3) * ldv + (tid & 7) * 8;
  const int ktl = kt1 - 1;
  auto gload = [&](u32x4 (&rk)[KLD], u32x4& rv, int kt) {
    kt = kt < ktl ? kt : ktl;
#pragma unroll
    for (int pp = 0; pp < KLD; ++pp) rk[pp] = *(const u32x4*)(Kt + (koff[pp] + (unsigned)(kt * 64) * ldk));
    rv = *(const u32x4*)(Vt + (voff + (unsigned)(kt * 64) * ldv));
  };
  auto lstore = [&](u32x4 (&rk)[KLD], u32x4& rv, int buf) {
#pragma unroll
    for (int pp = 0; pp < KLD; ++pp) { const int c = tid + NTHR * pp; if (c < 64 * KCH) { const int row = c / KCH, col = c % KCH; *(u32x4*)(Ks + (buf * 64 + row) * KROW + col * 8) = rk[pp]; } }
    *(u32x4*)(Vs + (buf * 64 + (tid >> 3)) * VROW + (tid & 7) * 8) = rv;
  };

  f32x16 o0, o1, negm;
#pragma unroll
  for (int i = 0; i < 16; ++i) { o0[i] = 0.f; o1[i] = 0.f; negm[i] = 0.f; }
  float mref = 0.f, lsum = 0.f;
  bool started = false;
  int qr = 0, qc = 0, cs = 0, rs = 0;
  if (MODE == 2) { qr = qpos >> 6; qc = qpos & 63; cs = qc - 8; cs = cs < 0 ? 0 : (cs > 48 ? 48 : cs); rs = qr - 4; rs = rs < 0 ? 0 : (rs > 56 ? 56 : rs); }
  const int i16 = lane & 15, qq = i16 >> 2, pp4 = i16 & 3, g16 = (lane >> 4) & 1;

  auto compute = [&](int buf, int kt) {
    bool active = true;
    if (MODE == 2) active = (kt >= rs) && (kt < rs + 8);
    if (active) {
      const u16* Kb = Ks + buf * 64 * KROW + r * KROW + 8 * h;
      const u16* Vb = Vs + buf * 64 * VROW;
      bf16x8 vf[8];
#pragma unroll
      for (int cs2 = 0; cs2 < 4; ++cs2) {
        const u16* vp = Vb + (16 * cs2 + 4 * h + qq) * VROW + 16 * g16 + 4 * pp4;
        { s16x4 lo = tr_read(vp), hi = tr_read(vp + 8 * VROW); vf[2 * cs2] = __builtin_shufflevector(lo, hi, 0, 1, 2, 3, 4, 5, 6, 7); }
        { s16x4 lo = tr_read(vp + 32), hi = tr_read(vp + 8 * VROW + 32); vf[2 * cs2 + 1] = __builtin_shufflevector(lo, hi, 0, 1, 2, 3, 4, 5, 6, 7); }
      }
      f32x16 s0 = negm, s1 = negm;
#pragma unroll
      for (int d0 = 0; d0 < NKQ; ++d0) {
        bf16x8 k0 = *(const bf16x8*)(Kb + d0 * 16);
        bf16x8 k1 = *(const bf16x8*)(Kb + 32 * KROW + d0 * 16);
        s0 = mfma(k0, qf[d0], s0);
        s1 = mfma(k1, qf[d0], s1);
      }
      if (MODE == 0) {
        const float* tb = tbl + (kt * 64 + 4 * h - qpos + 1280);
#pragma unroll
        for (int i = 0; i < 16; ++i) { s0[i] += tb[(i & 3) + 8 * (i >> 2)]; s1[i] += tb[32 + (i & 3) + 8 * (i >> 2)]; }
      }
      if (MODE == 2) {
        const float* tb = tbl + (kt - qr + 7) * 31 + (15 - qc);
#pragma unroll
        for (int i = 0; i < 16; ++i) {
          const int kc0 = 4 * h + (i & 3) + 8 * (i >> 2), kc1 = kc0 + 32;
          const bool v0 = (kc0 >= cs) && (kc0 < cs + 16), v1 = (kc1 >= cs) && (kc1 < cs + 16);
          const float b0 = tb[v0 ? kc0 : qc], b1 = tb[v1 ? kc1 : qc];
          s0[i] = v0 ? s0[i] + b0 : NEGBIG;
          s1[i] = v1 ? s1[i] + b1 : NEGBIG;
        }
      }
      float ma = __builtin_fmaxf(__builtin_fmaxf(s0[0], s0[1]), s0[2]), mb = __builtin_fmaxf(__builtin_fmaxf(s1[0], s1[1]), s1[2]);
#pragma unroll
      for (int i = 3; i < 15; i += 2) { ma = __builtin_fmaxf(__builtin_fmaxf(ma, s0[i]), s0[i + 1]); mb = __builtin_fmaxf(__builtin_fmaxf(mb, s1[i]), s1[i + 1]); }
      float mt = __builtin_fmaxf(__builtin_fmaxf(ma, s0[15]), s1[15]);
      mt = hmax(__builtin_fmaxf(mt, mb));
      const bool fresh = !started && (mt > -1e29f);
      if (__any(fresh || (started && mt > 8.f))) {
        float delta = 0.f, al = 1.f;
        if (fresh) { delta = mt; started = true; }
        else if (started) { delta = __builtin_fmaxf(mt, 0.f); al = fexp2(-delta); }
        mref += delta;
        lsum *= al;
#pragma unroll
        for (int i = 0; i < 16; ++i) { o0[i] *= al; o1[i] *= al; s0[i] -= delta; s1[i] -= delta; negm[i] = -mref; }
      }
      float ps = 0.f;
#pragma unroll
      for (int i = 0; i < 16; ++i) { s0[i] = fexp2(s0[i]); s1[i] = fexp2(s1[i]); ps += s0[i] + s1[i]; }
      lsum += ps;
#pragma unroll
      for (int c = 0; c < 2; ++c) {
#pragma unroll
        for (int s = 0; s < 2; ++s) {
          u32x4 pw;
          if (c == 0) pw = (u32x4){pack2(s0[8 * s], s0[8 * s + 1]), pack2(s0[8 * s + 2], s0[8 * s + 3]), pack2(s0[8 * s + 4], s0[8 * s + 5]), pack2(s0[8 * s + 6], s0[8 * s + 7])};
          else pw = (u32x4){pack2(s1[8 * s], s1[8 * s + 1]), pack2(s1[8 * s + 2], s1[8 * s + 3]), pack2(s1[8 * s + 4], s1[8 * s + 5]), pack2(s1[8 * s + 6], s1[8 * s + 7])};
          const bf16x8 pf = __builtin_bit_cast(bf16x8, pw);
          o0 = mfma(vf[2 * (2 * c + s)], pf, o0);
          o1 = mfma(vf[2 * (2 * c + s) + 1], pf, o1);
        }
      }
    }
  };

  const int ntile = kt1 - kt0;
  gload(rk0, rv0, kt0);
  lstore(rk0, rv0, 0);
  gload(rk0, rv0, kt0 + 1);
  gload(rk1, rv1, kt0 + 2);
  __syncthreads();
  for (int j = 0; j < ntile; j += 2) {
    compute(0, kt0 + j);
    lstore(rk0, rv0, 1);
    gload(rk0, rv0, kt0 + j + 3);
    __syncthreads();
    if (j + 1 >= ntile) break;
    compute(1, kt0 + j + 1);
    lstore(rk1, rv1, 0);
    gload(rk1, rv1, kt0 + j + 4);
    __syncthreads();
  }
  lsum = hsum(lsum);
  const float inv = 1.f / lsum;
  float sq = 0.f;
#pragma unroll
  for (int i = 0; i < 16; ++i) { o0[i] *= inv; o1[i] *= inv; sq += o0[i] * o0[i] + o1[i] * o1[i]; }
  sq = hsum(sq);
  if (h == 0) ((float*)(p.ws + OFF_SSQ))[(tok0 + qpos) * 16 + MODE * 4 + head] = sq;
  u16* op = (u16*)(p.ws + OFF_ACTB) + (tok0 + qpos) * DM + MODE * 256 + head * 64 + 4 * h;
#pragma unroll
  for (int g4 = 0; g4 < 4; ++g4) {
    u32x2 w0 = {pack2(o0[4 * g4], o0[4 * g4 + 1]), pack2(o0[4 * g4 + 2], o0[4 * g4 + 3])};
    u32x2 w1 = {pack2(o1[4 * g4], o1[4 * g4 + 1]), pack2(o1[4 * g4 + 2], o1[4 * g4 + 3])};
    *(u32x2*)(op + 8 * g4) = w0;
    *(u32x2*)(op + 32 + 8 * g4) = w1;
  }
}


DI bool sb_tile(int bid, int nb, int it, int NT, int& mt, int& nt) {
  const int G = nb >> 3, x = bid & 7, l = bid >> 3;
  const int s = l + it * G;
  const int sb = (s >> 5) * 8 + x, w = s & 31;
  const int NG = NT >> 1;
  if (sb >= 24 * NG) return false;
  const int mg = sb / NG, ng = sb - mg * NG;
  mt = mg * 16 + (w >> 1); nt = ng * 2 + (w & 1);
  return true;
}

DI bool att_tile_index(int bid, int nb, int it, int& tile) {
  if (nb != 256) { tile = bid + it * nb; return tile < 1536; }
  const int x = bid & 7, l = bid >> 3;
  const int pair = 2 * (it * 8 + x) + (l >> 4);
  tile = pair * 16 + ((l + 3 * it) & 15);
  return pair < 96;
}

template <int EPI, bool GSCALE = false>
DI void gemm8_phase(const Params& p, int layer, const u16* A, const u16* Bt, int K, int NT, char* smem) {
  const int bid = blockIdx.x, nb = gridDim.x;
  int mt, nt;
  bool have = sb_tile(bid, nb, 0, NT, mt, nt);
  if (have) gemm8_prestage(A, Bt, K, mt * 256, nt * 256, smem);
  for (int it = 0; have; ++it) {
    int mt2 = 0, nt2 = 0;
    const bool have2 = sb_tile(bid, nb, it + 1, NT, mt2, nt2);
    gemm8_tile<EPI, GSCALE>(p, layer, A, Bt, K, mt * 256, nt * 256, smem, have2, mt2 * 256, nt2 * 256);
    have = have2; mt = mt2; nt = nt2;
  }
}

constexpr int NPHASE = 17;
constexpr int MT = T_TOK / 256;

DI void run_phase(const Params& p, int ph, char* smem) {
  const int bid = blockIdx.x, nb = gridDim.x;
  u16* wtb = (u16*)(p.ws + OFF_WT);
  const u16* actb = (const u16*)(p.ws + OFF_ACTB);
  if (ph == 0) {
    for (int j = bid; j < 128; j += nb) rope_tab_build(p.ws, j * NTHR + opaque_tid());
    for (int j = bid; j < WJ_TOTAL; j += nb) wprep_job(p, j, smem);
    for (int rb = bid; rb < T_TOK / 8; rb += nb) norm_rows(p, 0, rb, 0);
    return;
  }
  if (ph == 16) { for (int rb = bid; rb < T_TOK / 8; rb += nb) norm_rows(p, 1, rb, 1); return; }
  const int layer = (ph - 1) >> 3, sub = (ph - 1) & 7;
  const u16* wl = wtb + (size_t)layer * WT_LAYER;
  switch (sub) {
    case 0:
      gemm8_phase<EPI_PROJ>(p, layer, actb, wl + WT_IN, 1024, 10, smem);
      break;
    case 1:
      for (int c = bid; c < (T_TOK / NTHR) * 8; c += nb) e1_chunk(p, layer, c);
      for (int t = bid; t < MT * 2; t += nb) { const int nt = t & 1, mt = t >> 1; gemm_tile<EPI_UQ, false, true>(p, layer, (const u16*)(p.ws + OFF_PROJ) + 2048, DIN, wl + WT_UQ, 256, mt * 256, nt * 256, smem); }
      for (int t = bid; t < MT * 2; t += nb) { const int nt = t & 1, mt = t >> 1; gemm_tile<EPI_UKV, false, true>(p, layer, (const u16*)(p.ws + OFF_PROJ) + 2304, DIN, wl + WT_UKV, 128, mt * 256, nt * 256, smem); }
      break;
    case 2:
      for (int it = 0, t; att_tile_index(bid, nb, it, t); ++it) attn_tile<3>(p, layer, t, smem);
      for (int it = 0, t; att_tile_index(bid, nb, it, t); ++it) attn_tile<1>(p, layer, t, smem);
      for (int it = 0, t; att_tile_index(bid, nb, it, t); ++it) attn_tile<0>(p, layer, t, smem);
      for (int it = 0, t; att_tile_index(bid, nb, it, t); ++it) attn_tile<2>(p, layer, t, smem);
      break;
    case 3:
      gemm8_phase<EPI_RES, true>(p, layer, actb, wl + WT_OUT, 1024, 4, smem);
      break;
    case 4:
      for (int rb = bid; rb < T_TOK / 8; rb += nb) norm_rows(p, 1, rb, 0);
      break;
    case 5:
      gemm8_phase<EPI_SWIGLU>(p, layer, actb, wl + WT_GU, 1024, 22, smem);
      break;
    case 6:
      gemm8_phase<EPI_RES>(p, 1, (const u16*)(p.ws + OFF_ACT), wl + WT_DN, DFF, 4, smem);
      break;
    case 7:
      for (int rb = bid; rb < T_TOK / 8; rb += nb) norm_rows(p, 1, rb, 0);
      break;
  }
}

__global__ void __launch_bounds__(NTHR, 2) mega(Params p, int ph_lo, int ph_hi) {
  __shared__ __attribute__((aligned(16))) char smem[SMEM_BYTES];
  cg::grid_group grid = cg::this_grid();
  for (int ph = ph_lo; ph < ph_hi; ++ph) {
    if (ph > ph_lo) grid.sync();
    run_phase(p, ph, smem);
#ifdef DUPMASK
    if (ph >= 1 && ph < 16 && ((DUPMASK >> ((ph - 1) & 7)) & 1)) { grid.sync(); run_phase(p, ph, smem); }
#endif
  }
}

extern "C" void kernel_launch(void* const* d_in, const int* in_sizes, int n_in, void* d_out, int out_size, void* d_ws, size_t ws_size, hipStream_t stream) {
  Params p{};
  p.x_prompt = (const float*)d_in[0]; p.x_sample = (const float*)d_in[1]; p.t5_bias = (const float*)d_in[2]; p.norm_mix = (const float*)d_in[3];
  p.w_in = (const float*)d_in[4]; p.b_q_gain = (const float*)d_in[5]; p.b_k_gain = (const float*)d_in[6]; p.c_rpb = (const float*)d_in[7];
  p.d_q_gain = (const float*)d_in[8]; p.d_w_uq = (const float*)d_in[9]; p.d_kv_gain = (const float*)d_in[10]; p.d_w_ukv = (const float*)d_in[11];
  p.out_gain = (const float*)d_in[12]; p.w_out = (const float*)d_in[13]; p.norm_ffn = (const float*)d_in[14]; p.w_gate = (const float*)d_in[15];
  p.w_up = (const float*)d_in[16]; p.w_down = (const float*)d_in[17]; p.final_norm = (const float*)d_in[18];
  p.out = (float*)d_out; p.ws = (char*)d_ws;
  if (ws_size < WS_NEED) { fprintf(stderr, "workspace too small: %zu < %zu\n", ws_size, (size_t)WS_NEED); return; }
  static int grid_blocks = 0;
  if (!grid_blocks) {
    int dev = 0, cus = 0, per_cu = 0;
    hipGetDevice(&dev);
    hipDeviceGetAttribute(&cus, hipDeviceAttributeMultiprocessorCount, dev);
    hipOccupancyMaxActiveBlocksPerMultiprocessor(&per_cu, mega, NTHR, 0);
    if (per_cu < 1) per_cu = 1;
    if (per_cu > 1) per_cu = 1;
    grid_blocks = cus * per_cu;
  }
#if ONE_LAUNCH
  int lo = 0, hi = NPHASE;
  void* args[] = {&p, &lo, &hi};
  hipError_t e = hipLaunchCooperativeKernel((void*)mega, dim3(grid_blocks), dim3(NTHR), args, 0, stream);
  if (e != hipSuccess) fprintf(stderr, "cooperative launch failed: %s (grid %d)\n", hipGetErrorString(e), grid_blocks);
#else
  for (int ph = 0; ph < NPHASE; ++ph) hipLaunchKernelGGL(mega, dim3(grid_blocks), dim3(NTHR), 0, stream, p, ph, ph + 1);
#endif
}
```

```cpp
#include <hip/hip_runtime.h>
#include <hip/hip_cooperative_groups.h>
#include <cstdio>
#include <cstdint>
namespace cg = cooperative_groups;

#ifndef ONE_LAUNCH
#define ONE_LAUNCH 1
#endif

#define DI __device__ __forceinline__
typedef short bf16x8 __attribute__((ext_vector_type(8)));
typedef short s16x4 __attribute__((ext_vector_type(4)));
typedef float f32x16 __attribute__((ext_vector_type(16)));
typedef float f32x4 __attribute__((ext_vector_type(4)));
typedef float f32x2 __attribute__((ext_vector_type(2)));
typedef unsigned u32x4 __attribute__((ext_vector_type(4)));
typedef unsigned u32x2 __attribute__((ext_vector_type(2)));
typedef __bf16 bf16v2 __attribute__((ext_vector_type(2)));
typedef unsigned short u16;

constexpr int T_TOK = 98304, SEQ = 4096, DM = 1024, DIN = 2464, DINP = 2560, DFF = 2816;
constexpr int NPROMPT = 8 * 4096;
constexpr int NTHR = 512;
constexpr float LOG2E = 1.4426950408889634f;
constexpr float QSCALE64 = 0.125f * LOG2E;
constexpr float QSCALE96 = 0.10206207261596575f * LOG2E;
constexpr float NEGBIG = -1e30f;
constexpr float EPS = 1e-6f;

constexpr size_t al256(size_t x) { return (x + 255) & ~(size_t)255; }
constexpr size_t WT_IN = 0;
constexpr size_t WT_UQ = WT_IN + (size_t)DINP * 1024;
constexpr size_t WT_UKV = WT_UQ + 512 * 256;
constexpr size_t WT_OUT = WT_UKV + 512 * 128;
constexpr size_t WT_GU = WT_OUT + 1024 * 1024;
constexpr size_t WT_DN = WT_GU + (size_t)5632 * 1024;
constexpr size_t WT_LAYER = WT_DN + (size_t)1024 * 2816;
constexpr size_t OFF_WT = 0;
constexpr size_t OFF_TBLA = al256(OFF_WT + 2 * WT_LAYER * 2);
constexpr size_t OFF_ROPE = al256(OFF_TBLA + 4 * 2560 * 4);
constexpr size_t OFF_ACTB = al256(OFF_ROPE + 4096 * 16 * 8);
constexpr size_t OFF_PROJ = al256(OFF_ACTB + (size_t)T_TOK * 1024 * 2);
constexpr size_t OFF_QD = al256(OFF_PROJ + (size_t)T_TOK * DIN * 2);
constexpr size_t OFF_KD = al256(OFF_QD + (size_t)T_TOK * 384 * 2);
constexpr size_t OFF_VD = al256(OFF_KD + (size_t)T_TOK * 384 * 2);
constexpr size_t OFF_SSQ = al256(OFF_VD + (size_t)T_TOK * 256 * 2);
constexpr size_t WS_NEED = al256(OFF_SSQ + (size_t)T_TOK * 16 * 4);
constexpr size_t OFF_ACT = OFF_PROJ;
static_assert(OFF_ACT + (size_t)T_TOK * DFF * 2 <= OFF_KD, "act alias overflow");

struct Params {
  const float *x_prompt, *x_sample, *t5_bias, *norm_mix, *w_in, *b_q_gain, *b_k_gain, *c_rpb, *d_q_gain, *d_w_uq,
      *d_kv_gain, *d_w_ukv, *out_gain, *w_out, *norm_ffn, *w_gate, *w_up, *w_down, *final_norm;
  float* out;
  char* ws;
};

constexpr int SMEM_BYTES = 2 * (256 + 256) * 72 * 2 + 1024;

DI unsigned pack2(float a, float b) { f32x2 v = {a, b}; bf16v2 r = __builtin_convertvector(v, bf16v2); return __builtin_bit_cast(unsigned, r); }
DI float bflo(unsigned w) { return __uint_as_float(w << 16); }
DI float bfhi(unsigned w) { return __uint_as_float(w & 0xffff0000u); }
DI f32x16 mfma(bf16x8 a, bf16x8 b, f32x16 c) { return __builtin_amdgcn_mfma_f32_32x32x16_bf16(a, b, c, 0, 0, 0); }
DI float hmax(float v) {
  auto rr = __builtin_amdgcn_permlane32_swap(__float_as_uint(v), __float_as_uint(v), false, false);
  return __builtin_fmaxf(__uint_as_float(rr[0]), __uint_as_float(rr[1]));
}
DI float hsum(float v) {
  auto rr = __builtin_amdgcn_permlane32_swap(__float_as_uint(v), __float_as_uint(v), false, false);
  return __uint_as_float(rr[0]) + __uint_as_float(rr[1]);
}
DI float fexp2(float x) { return __builtin_amdgcn_exp2f(x); }
DI int crow(int i, int h) { return (i & 3) + 8 * (i >> 2) + 4 * h; }
typedef short v4i16_t __attribute__((ext_vector_type(4)));
DI s16x4 tr_read(const u16* p) {
  return __builtin_bit_cast(s16x4, __builtin_amdgcn_ds_read_tr16_b64_v4i16((__attribute__((address_space(3))) v4i16_t*)p));
}
constexpr double inv_rev_c(int i) {
  constexpr double b[4] = {1.0, 0.5623413251903491, 0.31622776601683794, 0.1778279410038923};
  double v = b[i & 3];
  for (int k = 0; k < (i >> 2); ++k) v *= 0.1;
  return v * 0.15915494309189535;
}
DI void rope_tab_build(char* ws, int idx) {
  const int pos = idx >> 4, i = idx & 15;
  double invrev = inv_rev_c(0);
#pragma unroll
  for (int k = 1; k < 16; ++k) if (i == k) invrev = inv_rev_c(k);
  double rev = (double)pos * invrev;
  float f = (float)(rev - (double)(int)rev);
  f32x2 cs = {__builtin_amdgcn_cosf(f), __builtin_amdgcn_sinf(f)};
  ((f32x2*)(ws + OFF_ROPE))[idx] = cs;
}
#define ROPE16(ws_, pos_, A_, B_)                                                              \
  {                                                                                            \
    const f32x4* rt_ = (const f32x4*)((ws_) + OFF_ROPE) + (size_t)(pos_) * 8;                  \
    _Pragma("unroll") for (int i2_ = 0; i2_ < 8; ++i2_) {                                      \
      const f32x4 cs_ = rt_[i2_];                                                              \
      float a_ = A_[2 * i2_], b_ = B_[2 * i2_];                                                \
      A_[2 * i2_] = a_ * cs_[0] - b_ * cs_[1]; B_[2 * i2_] = a_ * cs_[1] + b_ * cs_[0];        \
      a_ = A_[2 * i2_ + 1]; b_ = B_[2 * i2_ + 1];                                              \
      A_[2 * i2_ + 1] = a_ * cs_[2] - b_ * cs_[3]; B_[2 * i2_ + 1] = a_ * cs_[3] + b_ * cs_[2]; \
    }                                                                                          \
  }
DI const float* xrow(const Params& p, int layer, size_t tok) {
  if (layer == 0) return tok < (size_t)NPROMPT ? p.x_prompt + tok * DM : p.x_sample + (tok - NPROMPT) * DM;
  return p.out + tok * DM;
}

DI int opaque_tid() { int t = threadIdx.x; asm volatile("" : "+v"(t)); return t; }
DI void wt_tile(const float* __restrict__ W, int K, int N, const float* __restrict__ g, u16* __restrict__ Wt, int k0, int n0, int mapmode, float* tile) {
  const int tid = opaque_tid();
  for (int i = tid; i < 4096; i += NTHR) {
    int kk = i >> 6, nn = i & 63, n = n0 + nn;
    float v = 0.f;
    if (n < N) { v = W[(size_t)(k0 + kk) * N + n]; if (g) v *= g[k0 + kk]; }
    tile[kk * 65 + nn] = v;
  }
  __syncthreads();
  for (int i = tid; i < 2048; i += NTHR) {
    int nn = i >> 5, kp = i & 31, n = n0 + nn;
    float cs = 1.f; int drow = n;
    if (mapmode == 1) { if (n < 256 || (n >= 1280 && n < 1536)) cs = QSCALE64; }
    else if (mapmode == 2) cs = QSCALE96;
    else if (mapmode == 3) drow = 32 * (n >> 4) + (n & 15);
    else if (mapmode == 4) drow = 32 * (n >> 4) + 16 + (n & 15);
    unsigned w = pack2(tile[(2 * kp) * 65 + nn] * cs, tile[(2 * kp + 1) * 65 + nn] * cs);
    *(unsigned*)(Wt + (size_t)drow * K + k0 + 2 * kp) = w;
  }
  __syncthreads();
}

constexpr int WJ_IN = 640, WJ_UQ = 32, WJ_UKV = 16, WJ_OUT = 256, WJ_G = 704, WJ_U = 704, WJ_D = 704;
constexpr int WJ_LAYER = WJ_IN + WJ_UQ + WJ_UKV + WJ_OUT + WJ_G + WJ_U + WJ_D;
constexpr int WJ_TOTAL = 2 * WJ_LAYER + 20;

DI void wprep_job(const Params& p, int job, char* smem) {
  float* tile = (float*)smem;
  u16* wtb = (u16*)(p.ws + OFF_WT);
  if (job >= 2 * WJ_LAYER) {
    int idx = (job - 2 * WJ_LAYER) * NTHR + opaque_tid();
    int head = idx / 2560, e = idx % 2560, d = e - 1280, n = d < 0 ? -d : d;
    int mult = (n <= 64 ? 1 : 0) + (((n & 3) == 0 && n <= 256) ? 1 : 0) + (((n & 15) == 0 && n <= 1024) ? 1 : 0);
    float v = NEGBIG;
    if (mult > 0) {
      int bk;
      if (n < 8) bk = n;
      else { float nf = (float)n; int lg = 8 + (int)(__logf(nf * 0.125f) / 4.852030263919617f * 8.0f); bk = lg < 15 ? lg : 15; }
      if (d > 0) bk += 16;
      v = (p.t5_bias[bk * 4 + head] + __logf((float)mult)) * LOG2E;
    }
    ((float*)(p.ws + OFF_TBLA))[idx] = v;
    return;
  }
  int layer = job / WJ_LAYER, j = job % WJ_LAYER;
  u16* wl = wtb + (size_t)layer * WT_LAYER;
  if (j < WJ_IN) { int kt = j & 15, nt = j >> 4; wt_tile(p.w_in + (size_t)layer * 1024 * DIN, 1024, DIN, p.norm_mix + layer * 1024, wl + WT_IN, kt * 64, nt * 64, 1, tile); return; }
  j -= WJ_IN;
  if (j < WJ_UQ) { int kt = j & 3, nt = j >> 2; wt_tile(p.d_w_uq + (size_t)layer * 256 * 384, 256, 384, p.d_q_gain + layer * 256, wl + WT_UQ, kt * 64, nt * 64, 2, tile); return; }
  j -= WJ_UQ;
  if (j < WJ_UKV) { int kt = j & 1, nt = j >> 1; wt_tile(p.d_w_ukv + (size_t)layer * 128 * 512, 128, 512, p.d_kv_gain + layer * 128, wl + WT_UKV, kt * 64, nt * 64, 0, tile); return; }
  j -= WJ_UKV;
  if (j < WJ_OUT) { int kt = j & 15, nt = j >> 4; wt_tile(p.w_out + (size_t)layer * 1024 * 1024, 1024, 1024, p.out_gain + layer * 1024, wl + WT_OUT, kt * 64, nt * 64, 0, tile); return; }
  j -= WJ_OUT;
  if (j < WJ_G) { int kt = j & 15, nt = j >> 4; wt_tile(p.w_gate + (size_t)layer * 1024 * DFF, 1024, DFF, p.norm_ffn + layer * 1024, wl + WT_GU, kt * 64, nt * 64, 3, tile); return; }
  j -= WJ_G;
  if (j < WJ_U) { int kt = j & 15, nt = j >> 4; wt_tile(p.w_up + (size_t)layer * 1024 * DFF, 1024, DFF, p.norm_ffn + layer * 1024, wl + WT_GU, kt * 64, nt * 64, 4, tile); return; }
  j -= WJ_U;
  { int kt = j % 44, nt = j / 44; wt_tile(p.w_down + (size_t)layer * DFF * 1024, DFF, 1024, nullptr, wl + WT_DN, kt * 64, nt * 64, 0, tile); }
}

DI void norm_rows(const Params& p, int layer, int rb, int mode) {
  const int tid = opaque_tid();
  const int lane = tid & 63, wave = tid >> 6;
  const size_t row = (size_t)rb * 8 + wave;
  const float* src = xrow(p, layer, row);
  f32x4 v[4];
  float ss = 0.f;
#pragma unroll
  for (int i = 0; i < 4; ++i) { v[i] = *(const f32x4*)(src + lane * 4 + 256 * i); ss += v[i][0] * v[i][0] + v[i][1] * v[i][1] + v[i][2] * v[i][2] + v[i][3] * v[i][3]; }
#pragma unroll
  for (int o = 1; o < 64; o <<= 1) ss += __shfl_xor(ss, o);
  const float rstd = rsqrtf(ss * (1.f / 1024.f) + EPS);
  if (mode == 0) {
    u16* dst = (u16*)(p.ws + OFF_ACTB) + row * DM;
#pragma unroll
    for (int i = 0; i < 4; ++i) { u32x2 w = {pack2(v[i][0] * rstd, v[i][1] * rstd), pack2(v[i][2] * rstd, v[i][3] * rstd)}; *(u32x2*)(dst + lane * 4 + 256 * i) = w; }
  } else {
    float* dst = p.out + row * DM;
#pragma unroll
    for (int i = 0; i < 4; ++i) { f32x4 g = *(const f32x4*)(p.final_norm + lane * 4 + 256 * i); f32x4 o = {v[i][0] * rstd * g[0], v[i][1] * rstd * g[1], v[i][2] * rstd * g[2], v[i][3] * rstd * g[3]}; *(f32x4*)(dst + lane * 4 + 256 * i) = o; }
  }
}

enum { EPI_PROJ = 0, EPI_UQ = 1, EPI_UKV = 2, EPI_RES = 3, EPI_SWIGLU = 4 };
constexpr int GS = 72;
constexpr int BM = 256;
constexpr int TMW = 4;

template <int EPI, bool ASCALE, bool ROWNORM>
DI void gemm_tile(const Params& p, int layer, const u16* __restrict__ A, int lda, const u16* __restrict__ Wt, int K, int m0, int n0, char* smem) {
  u16* As = (u16*)smem;
  u16* Bs = As + 2 * BM * GS;
  float* rowscale = (float*)(Bs + 2 * 256 * GS);
  const int tid = opaque_tid(), lane = tid & 63, wave = tid >> 6, r = lane & 31, h = lane >> 5;
  const int wm = wave >> 2, wn = wave & 3;
  const int lrow = tid >> 3, kc = tid & 7;
  const u16* At = A + (size_t)m0 * lda;
  const u16* Bt = Wt + (size_t)n0 * K;
  const unsigned aoff = (unsigned)lrow * lda + kc * 8, boff = (unsigned)lrow * K + kc * 8;
  const float* ssq = (const float*)(p.ws + OFF_SSQ);

  if (ROWNORM) {
    const int rr = tid >> 1, half = tid & 1;
    const u16* src = A + (size_t)(m0 + rr) * lda + half * (K / 2);
    float ss = 0.f;
    for (int i = 0; i < K / 16; ++i) {
      u32x4 w = *(const u32x4*)(src + i * 8);
#pragma unroll
      for (int e = 0; e < 4; ++e) { float a = bflo(w[e]), b = bfhi(w[e]); ss += a * a + b * b; }
    }
    ss += __shfl_xor(ss, 1);
    if (half == 0) rowscale[rr] = rsqrtf(ss / (float)K + EPS);
  }

  f32x16 acc[TMW][2];
#pragma unroll
  for (int a = 0; a < TMW; ++a)
#pragma unroll
    for (int b = 0; b < 2; ++b)
#pragma unroll
      for (int i = 0; i < 16; ++i) acc[a][b][i] = 0.f;

  u32x4 ra[4], rb[4];
  float sc[4] = {1.f, 1.f, 1.f, 1.f};
  const int KT = K / 64;
  auto gload = [&](int kt) {
#pragma unroll
    for (int pp = 0; pp < 4; ++pp) ra[pp] = *(const u32x4*)(At + (size_t)(64 * pp) * lda + (aoff + (unsigned)kt * 64));
#pragma unroll
    for (int pp = 0; pp < 4; ++pp) rb[pp] = *(const u32x4*)(Bt + (size_t)(64 * pp) * K + (boff + (unsigned)kt * 64));
  };
  auto lstore = [&](int buf, int kt) {
    if (ASCALE) {
      if ((kt & 3) == 0) {
        const int g = kt >> 2;
#pragma unroll
        for (int pp = 0; pp < 4; ++pp) {
          f32x4 s4 = *(const f32x4*)(ssq + (size_t)(m0 + lrow + 64 * pp) * 16 + 4 * g);
          sc[pp] = rsqrtf((s4[0] + s4[1] + s4[2] + s4[3]) * (1.f / 256.f) + EPS);
        }
      }
#pragma unroll
      for (int pp = 0; pp < 4; ++pp)
#pragma unroll
        for (int e = 0; e < 4; ++e) ra[pp][e] = pack2(bflo(ra[pp][e]) * sc[pp], bfhi(ra[pp][e]) * sc[pp]);
    }
#pragma unroll
    for (int pp = 0; pp < 4; ++pp) *(u32x4*)(As + (buf * BM + lrow + 64 * pp) * GS + kc * 8) = ra[pp];
#pragma unroll
    for (int pp = 0; pp < 4; ++pp) *(u32x4*)(Bs + (buf * 256 + lrow + 64 * pp) * GS + kc * 8) = rb[pp];
  };
  auto compute = [&](int buf) {
    const u16* Ab = As + (buf * BM + wm * 128 + r) * GS + 8 * h;
    const u16* Bb = Bs + (buf * 256 + wn * 64 + r) * GS + 8 * h;
#pragma unroll
    for (int ks = 0; ks < 4; ++ks) {
      bf16x8 b0 = *(const bf16x8*)(Bb + ks * 16);
      bf16x8 b1 = *(const bf16x8*)(Bb + 32 * GS + ks * 16);
#pragma unroll
      for (int tm = 0; tm < TMW; ++tm) {
        bf16x8 a = *(const bf16x8*)(Ab + tm * 32 * GS + ks * 16);
        acc[tm][0] = mfma(a, b0, acc[tm][0]);
        acc[tm][1] = mfma(a, b1, acc[tm][1]);
      }
    }
  };
  gload(0);
  lstore(0, 0);
  if (KT > 1) gload(1);
  __syncthreads();
  for (int kt = 0; kt < KT; ++kt) {
    compute(kt & 1);
    if (kt + 1 < KT) lstore((kt + 1) & 1, kt + 1);
    if (kt + 2 < KT) gload(kt + 2);
    __syncthreads();
  }

  const int wms = __builtin_amdgcn_readfirstlane(wm), wns = __builtin_amdgcn_readfirstlane(wn);
  const int mrow0 = m0 + wms * 128;
  const int nwb = n0 + wns * 64;
  if (ROWNORM) {
#pragma unroll
    for (int tm = 0; tm < TMW; ++tm) {
#pragma unroll
      for (int i = 0; i < 16; ++i) {
        const float rs = rowscale[wms * 128 + 4 * h + 32 * tm + (i & 3) + 8 * (i >> 2)];
        acc[tm][0][i] *= rs; acc[tm][1][i] *= rs;
      }
    }
  }
  if (EPI == EPI_SWIGLU) {
    u16* dw = (u16*)(p.ws + OFF_ACT) + (size_t)mrow0 * DFF + (nwb >> 1);
    const unsigned lo = (unsigned)(4 * h) * DFF + r;
#pragma unroll
    for (int tm = 0; tm < TMW; ++tm) {
#pragma unroll
      for (int i = 0; i < 16; ++i) {
        const float g = acc[tm][0][i], u = acc[tm][1][i];
        const float a = g * __builtin_amdgcn_rcpf(1.f + fexp2(-g * LOG2E)) * u;
        dw[lo + (unsigned)((32 * tm + (i & 3) + 8 * (i >> 2)) * DFF)] = (u16)(pack2(a, 0.f) & 0xffff);
      }
      __builtin_amdgcn_sched_barrier(0);
    }
  } else {
#pragma unroll
    for (int tn = 0; tn < 2; ++tn) {
      const int nb0 = nwb + 32 * tn;
      if (EPI == EPI_RES) {
        const float* xw = (layer == 0 ? (m0 < NPROMPT ? p.x_prompt + (size_t)mrow0 * DM : p.x_sample + (size_t)(mrow0 - NPROMPT) * DM) : p.out + (size_t)mrow0 * DM) + nb0;
        float* ow = p.out + (size_t)mrow0 * DM + nb0;
        const unsigned lo = (unsigned)(4 * h) * DM + r;
#pragma unroll
        for (int tm = 0; tm < TMW; ++tm) {
#pragma unroll
          for (int g4 = 0; g4 < 4; ++g4) {
            float xv[4];
#pragma unroll
            for (int e = 0; e < 4; ++e) xv[e] = xw[lo + (unsigned)((32 * tm + 8 * g4 + e) * DM)];
#pragma unroll
            for (int e = 0; e < 4; ++e) ow[lo + (unsigned)((32 * tm + 8 * g4 + e) * DM)] = xv[e] + acc[tm][tn][4 * g4 + e];
          }
          __builtin_amdgcn_sched_barrier(0);
        }
      } else {
        u16* dw; int ld; bool ok = true;
        if (EPI == EPI_PROJ) { dw = (u16*)(p.ws + OFF_PROJ) + (size_t)mrow0 * DIN + nb0; ld = DIN; ok = (nb0 + r) < DIN; }
        else if (EPI == EPI_UQ) { dw = (u16*)(p.ws + OFF_QD) + (size_t)mrow0 * 384 + nb0; ld = 384; ok = nb0 < 384; }
        else {
          const int head = nb0 >> 7, w = nb0 & 127;
          if (w < 64) { dw = (u16*)(p.ws + OFF_KD) + (size_t)mrow0 * 384 + head * 96 + w; ld = 384; }
          else { dw = (u16*)(p.ws + OFF_VD) + (size_t)mrow0 * 256 + head * 64 + (w - 64); ld = 256; }
        }
        const unsigned lo = (unsigned)(4 * h) * ld + r;
        if (ok) {
#pragma unroll
          for (int tm = 0; tm < TMW; ++tm) {
#pragma unroll
            for (int i = 0; i < 16; ++i) dw[lo + (unsigned)((32 * tm + (i & 3) + 8 * (i >> 2)) * ld)] = (u16)(pack2(acc[tm][tn][i], 0.f) & 0xffff);
            __builtin_amdgcn_sched_barrier(0);
          }
        }
      }
    }
  }
  if (ROWNORM) __syncthreads();
}


typedef float f32x4v __attribute__((ext_vector_type(4)));
constexpr int G8_HT = 128 * 64;
DI int lds_byte8(int r, int c) { const int st = (r >> 4) * 2 + (c >> 5), ob = (r & 15) * 64 + (c & 31) * 2; return st * 1024 + (ob ^ (((ob >> 9) & 1) << 5)); }
DI void stage_rc8(int b, int& R, int& C) { const int st = b >> 10, sb = b & 1023, swz = sb ^ (((sb >> 9) & 1) << 5); R = (st >> 1) * 16 + (swz >> 6); C = (st & 1) * 32 + ((swz & 63) >> 1); }

DI void gemm8_prestage(const u16* __restrict__ A, const u16* __restrict__ Bt, int K, int brow, int bcol, char* smem) {
  u16* shm = (u16*)smem;
  const int tid = opaque_tid();
  int sr0, sc0, sr1, sc1;
  stage_rc8(tid * 16, sr0, sc0);
  stage_rc8(tid * 16 + 8192, sr1, sc1);
  const unsigned go0 = (unsigned)sr0 * K + sc0, go1 = (unsigned)sr1 * K + sc1;
#define G8P_STAGE(P, BASE, br) do { const u16* g_ = (BASE) + (size_t)(br) * K; \
    __builtin_amdgcn_global_load_lds((const unsigned*)(g_ + go0), (__attribute__((address_space(3))) unsigned*)((char*)(P) + tid * 16), 16, 0, 0); \
    __builtin_amdgcn_global_load_lds((const unsigned*)(g_ + go1), (__attribute__((address_space(3))) unsigned*)((char*)(P) + tid * 16 + 8192), 16, 0, 0); } while (0)
  G8P_STAGE(shm + 4 * G8_HT, Bt, bcol); G8P_STAGE(shm, A, brow);
  G8P_STAGE(shm + 5 * G8_HT, Bt, bcol + 128); G8P_STAGE(shm + G8_HT, A, brow + 128);
#undef G8P_STAGE
}

template <int EPI, bool GSCALE = false>
DI void gemm8_tile(const Params& p, int layer, const u16* __restrict__ A, const u16* __restrict__ Bt, int K, int brow, int bcol, char* smem,
                   bool next_valid, int next_brow, int next_bcol) {
  u16* shm = (u16*)smem;
  const int tid = opaque_tid();
  float* gfac = (float*)(smem + 8 * G8_HT * 2);
  if (GSCALE) {
    if (tid < 256) {
      const float* sq = (const float*)(p.ws + OFF_SSQ) + (size_t)(brow + tid) * 16;
      float rs[4];
#pragma unroll
      for (int g = 0; g < 4; ++g) { const f32x4 s4 = *(const f32x4*)(sq + 4 * g); rs[g] = rsqrtf((s4[0] + s4[1] + s4[2] + s4[3]) * (1.f / 256.f) + EPS); }
      gfac[tid] = rs[0] / rs[1]; gfac[256 + tid] = rs[1] / rs[2]; gfac[512 + tid] = rs[2] / rs[3]; gfac[768 + tid] = rs[3];
    }
  }
  const int wid = tid >> 6, lane = tid & 63, wr = wid >> 2, wc = wid & 3, fr = lane & 15, fq = lane >> 4;
  int sr0, sc0, sr1, sc1;
  stage_rc8(tid * 16, sr0, sc0);
  stage_rc8(tid * 16 + 8192, sr1, sc1);
  const unsigned go0 = (unsigned)sr0 * K + sc0, go1 = (unsigned)sr1 * K + sc1;
#define G8_SA(b, hh) (shm + ((b) * 2 + (hh)) * G8_HT)
#define G8_SB(b, hh) (shm + (4 + (b) * 2 + (hh)) * G8_HT)
#define G8_STAGE(P, BASE, br, kt) do { const u16* g_ = (BASE) + (size_t)(br) * K + (size_t)(kt) * 64; \
    __builtin_amdgcn_global_load_lds((const unsigned*)(g_ + go0), (__attribute__((address_space(3))) unsigned*)((char*)(P) + tid * 16), 16, 0, 0); \
    __builtin_amdgcn_global_load_lds((const unsigned*)(g_ + go1), (__attribute__((address_space(3))) unsigned*)((char*)(P) + tid * 16 + 8192), 16, 0, 0); } while (0)
#define G8_LDA(dst, b, hh) _Pragma("unroll") for (int m = 0; m < 4; ++m) _Pragma("unroll") for (int k = 0; k < 2; ++k) \
    dst[m][k] = *reinterpret_cast<const bf16x8*>((char*)G8_SA(b, hh) + lds_byte8(wr * 64 + m * 16 + fr, k * 32 + fq * 8))
#define G8_LDB(dst, b, hh) _Pragma("unroll") for (int n = 0; n < 2; ++n) _Pragma("unroll") for (int k = 0; k < 2; ++k) \
    dst[n][k] = *reinterpret_cast<const bf16x8*>((char*)G8_SB(b, hh) + lds_byte8(wc * 32 + n * 16 + fr, k * 32 + fq * 8))
#define G8_MMA(ai, bj, At_, Bt_) do { __builtin_amdgcn_s_setprio(1); \
    _Pragma("unroll") for (int m = 0; m < 4; ++m) _Pragma("unroll") for (int n = 0; n < 2; ++n) _Pragma("unroll") for (int k = 0; k < 2; ++k) \
      acc[ai][bj][m][n] = __builtin_amdgcn_mfma_f32_16x16x32_bf16(At_[m][k], Bt_[n][k], acc[ai][bj][m][n], 0, 0, 0); \
    __builtin_amdgcn_s_setprio(0); } while (0)
#define G8_WAIT_V(n) asm volatile("s_waitcnt vmcnt(" #n ")" ::: "memory")
#define G8_WAIT_L(n) asm volatile("s_waitcnt lgkmcnt(" #n ")" ::: "memory")
#define G8_BAR __builtin_amdgcn_s_barrier()
#define G8_SCHED __builtin_amdgcn_sched_barrier(0)
  f32x4v acc[2][2][4][2];
#pragma unroll
  for (int a = 0; a < 2; ++a)
#pragma unroll
    for (int b = 0; b < 2; ++b)
#pragma unroll
      for (int m = 0; m < 4; ++m)
#pragma unroll
        for (int n = 0; n < 2; ++n) acc[a][b][m][n] = (f32x4v){0.f, 0.f, 0.f, 0.f};
  bf16x8 At[4][2], B0[2][2], B1[2][2];
  const int nt = K / 64;
  if (wr == 1) G8_BAR;
  G8_WAIT_V(4); G8_BAR;
  G8_STAGE(G8_SB(1, 0), Bt, bcol, 1); G8_STAGE(G8_SA(1, 0), A, brow, 1); G8_STAGE(G8_SB(1, 1), Bt, bcol + 128, 1);
  G8_WAIT_V(6); G8_BAR;
  for (int t = 0; t < nt - 2; t += 2) {
    G8_LDB(B0, 0, 0); G8_SCHED; G8_LDA(At, 0, 0); G8_STAGE(G8_SA(1, 1), A, brow + 128, t + 1);
    G8_WAIT_L(8); G8_BAR; G8_WAIT_L(0); G8_MMA(0, 0, At, B0); G8_BAR; G8_SCHED;
    G8_LDB(B1, 0, 1); G8_STAGE(G8_SB(0, 0), Bt, bcol, t + 2);
    G8_BAR; G8_WAIT_L(0); G8_MMA(0, 1, At, B1); G8_BAR;
    G8_LDA(At, 0, 1); G8_STAGE(G8_SA(0, 0), A, brow, t + 2);
    G8_BAR; G8_WAIT_L(0); G8_MMA(1, 0, At, B0); G8_BAR; G8_SCHED;
    G8_STAGE(G8_SB(0, 1), Bt, bcol + 128, t + 2);
    G8_WAIT_V(6); G8_BAR; G8_MMA(1, 1, At, B1); G8_BAR;
    G8_LDB(B0, 1, 0); G8_SCHED; G8_LDA(At, 1, 0); G8_STAGE(G8_SA(0, 1), A, brow + 128, t + 2);
    G8_WAIT_L(8); G8_BAR; G8_WAIT_L(0); G8_MMA(0, 0, At, B0); G8_BAR; G8_SCHED;
    G8_LDB(B1, 1, 1); G8_STAGE(G8_SB(1, 0), Bt, bcol, t + 3);
    G8_BAR; G8_WAIT_L(0); G8_MMA(0, 1, At, B1); G8_BAR;
    G8_LDA(At, 1, 1); G8_STAGE(G8_SA(1, 0), A, brow, t + 3);
    G8_BAR; G8_WAIT_L(0); G8_MMA(1, 0, At, B0); G8_BAR; G8_SCHED;
    G8_STAGE(G8_SB(1, 1), Bt, bcol + 128, t + 3);
    G8_WAIT_V(6); G8_BAR; G8_MMA(1, 1, At, B1); G8_BAR;
    if (GSCALE && (t & 3) == 2) {
      const float* gf = gfac + (t >> 2) * 256 + wr * 64 + fq * 4;
#pragma unroll
      for (int ai = 0; ai < 2; ++ai)
#pragma unroll
        for (int m = 0; m < 4; ++m) {
          const f32x4 f4 = *(const f32x4*)(gf + ai * 128 + m * 16);
#pragma unroll
          for (int bj = 0; bj < 2; ++bj)
#pragma unroll
            for (int n = 0; n < 2; ++n)
#pragma unroll
              for (int j = 0; j < 4; ++j) acc[ai][bj][m][n][j] *= f4[j];
        }
    }
  }
  { G8_LDB(B0, 0, 0); G8_LDA(At, 0, 0); G8_STAGE(G8_SA(1, 1), A, brow + 128, nt - 1);
    G8_BAR; G8_WAIT_L(0); G8_MMA(0, 0, At, B0); G8_BAR;
    G8_LDB(B1, 0, 1); G8_BAR; G8_WAIT_L(0); G8_MMA(0, 1, At, B1); G8_BAR;
    G8_LDA(At, 0, 1); G8_WAIT_V(4); G8_BAR; G8_WAIT_L(0); G8_MMA(1, 0, At, B0); G8_MMA(1, 1, At, B1); G8_BAR; }
  { G8_LDB(B0, 1, 0); G8_LDA(At, 1, 0); G8_WAIT_V(2); G8_BAR; G8_WAIT_L(0); G8_MMA(0, 0, At, B0); G8_BAR;
    G8_LDB(B1, 1, 1); G8_WAIT_V(0); G8_BAR; G8_WAIT_L(0); G8_MMA(0, 1, At, B1); G8_BAR;
    G8_LDA(At, 1, 1); G8_BAR; G8_WAIT_L(0); G8_MMA(1, 0, At, B0); G8_MMA(1, 1, At, B1); G8_BAR; }
  if (wr == 0) G8_BAR;
  if (GSCALE) {
    const float* gf = gfac + 768 + wr * 64 + fq * 4;
#pragma unroll
    for (int ai = 0; ai < 2; ++ai)
#pragma unroll
      for (int m = 0; m < 4; ++m) {
        const f32x4 f4 = *(const f32x4*)(gf + ai * 128 + m * 16);
#pragma unroll
        for (int bj = 0; bj < 2; ++bj)
#pragma unroll
          for (int n = 0; n < 2; ++n)
#pragma unroll
            for (int j = 0; j < 4; ++j) acc[ai][bj][m][n][j] *= f4[j];
      }
  }
  if (next_valid) gemm8_prestage(A, Bt, K, next_brow, next_bcol, smem);
  const int wrs = __builtin_amdgcn_readfirstlane(wr), wcs = __builtin_amdgcn_readfirstlane(wc);
  if (EPI == EPI_RES) {
#pragma unroll
    for (int ai = 0; ai < 2; ++ai) {
      const int mrow0 = brow + ai * 128 + wrs * 64;
      const float* xw = (layer == 0 ? (brow < NPROMPT ? p.x_prompt + (size_t)mrow0 * DM : p.x_sample + (size_t)(mrow0 - NPROMPT) * DM) : p.out + (size_t)mrow0 * DM) + bcol + wcs * 32;
      float* ow = p.out + (size_t)mrow0 * DM + bcol + wcs * 32;
      const unsigned lo = (unsigned)(fq * 4) * DM + fr;
      float xv[4][4][4];
#pragma unroll
      for (int m = 0; m < 4; ++m)
#pragma unroll
        for (int j = 0; j < 4; ++j) {
          const float* xr = xw + (lo + (unsigned)((m * 16 + j) * DM));
#pragma unroll
          for (int c = 0; c < 4; ++c) xv[m][j][c] = xr[(c >> 1) * 128 + (c & 1) * 16];
        }
      __builtin_amdgcn_sched_barrier(0);
#pragma unroll
      for (int m = 0; m < 4; ++m)
#pragma unroll
        for (int j = 0; j < 4; ++j) {
          float* orow = ow + (lo + (unsigned)((m * 16 + j) * DM));
#pragma unroll
          for (int c = 0; c < 4; ++c) orow[(c >> 1) * 128 + (c & 1) * 16] = xv[m][j][c] + acc[ai][c >> 1][m][c & 1][j];
        }
      __builtin_amdgcn_sched_barrier(0);
    }
  }
#pragma unroll
  for (int ai = 0; ai < 2 && EPI != EPI_RES; ++ai) {
    const int mrow0 = brow + ai * 128 + wrs * 64;
#pragma unroll
    for (int bj = 0; bj < 2; ++bj) {
      const int ncol0 = bcol + bj * 128 + wcs * 32;
      if (EPI == EPI_SWIGLU) {
        u16* dw = (u16*)(p.ws + OFF_ACT) + (size_t)mrow0 * DFF + (ncol0 >> 1);
        const unsigned lo = (unsigned)(fq * 4) * DFF + fr;
#pragma unroll
        for (int m = 0; m < 4; ++m) {
#pragma unroll
          for (int j = 0; j < 4; ++j) {
            const float g = acc[ai][bj][m][0][j], u = acc[ai][bj][m][1][j];
            const float a = g * __builtin_amdgcn_rcpf(1.f + fexp2(-g * LOG2E)) * u;
            dw[lo + (unsigned)((m * 16 + j) * DFF)] = (u16)(pack2(a, 0.f) & 0xffff);
          }
        }
        __builtin_amdgcn_sched_barrier(0);
      } else if (EPI == EPI_RES) {
      } else {
#pragma unroll
        for (int n = 0; n < 2; ++n) {
          const int nb0 = ncol0 + n * 16;
          if (nb0 < DIN) {
            u16* dw = (u16*)(p.ws + OFF_PROJ) + (size_t)mrow0 * DIN + nb0;
            const unsigned lo = (unsigned)(fq * 4) * DIN + fr;
#pragma unroll
            for (int m = 0; m < 4; ++m)
#pragma unroll
              for (int j = 0; j < 4; ++j) dw[lo + (unsigned)((m * 16 + j) * DIN)] = (u16)(pack2(acc[ai][bj][m][n][j], 0.f) & 0xffff);
          }
          __builtin_amdgcn_sched_barrier(0);
        }
      }
    }
  }
  G8_WAIT_V(0);
  __syncthreads();
}

DI void e1_chunk(const Params& p, int layer, int chunk) {
  const int j = chunk & 7;
  const size_t tok = (size_t)(chunk >> 3) * NTHR + opaque_tid();
  if (j == 7) return;
  u16* proj = (u16*)(p.ws + OFF_PROJ);
  const int t = (int)(tok & 4095);
  if (j < 6) {
    u16* ptr = proj + tok * DIN + (j < 4 ? 768 + 64 * j : 1024 + 64 * (j - 4));
    const float* gain = (j < 4 ? p.b_q_gain : p.b_k_gain) + layer * 64;
    const float post = j < 4 ? QSCALE64 : 1.f;
    float x[64];
    float ss = 0.f;
#pragma unroll
    for (int c = 0; c < 8; ++c) {
      u32x4 w = *(const u32x4*)(ptr + c * 8);
#pragma unroll
      for (int e = 0; e < 4; ++e) { x[c * 8 + 2 * e] = bflo(w[e]); x[c * 8 + 2 * e + 1] = bfhi(w[e]); }
    }
#pragma unroll
    for (int d = 0; d < 64; ++d) ss += x[d] * x[d];
    const float rstd = rsqrtf(ss * (1.f / 64.f) + EPS);
    __builtin_amdgcn_sched_barrier(0);
#pragma unroll
    for (int c = 0; c < 4; ++c) {
#pragma unroll
      for (int d = 0; d < 16; ++d) x[c * 16 + d] = x[c * 16 + d] * rstd * gain[c * 16 + d];
      __builtin_amdgcn_sched_barrier(0);
    }
    const int prow = t >> 6, pcol = t & 63;
    { float* xa = x; float* xb = x + 16; ROPE16(p.ws, prow, xa, xb); }
    __builtin_amdgcn_sched_barrier(0);
    { float* xa = x + 32; float* xb = x + 48; ROPE16(p.ws, pcol, xa, xb); }
    __builtin_amdgcn_sched_barrier(0);
#pragma unroll
    for (int c = 0; c < 8; ++c) {
      u32x4 w;
#pragma unroll
      for (int e = 0; e < 4; ++e) w[e] = pack2(x[c * 8 + 2 * e] * post, x[c * 8 + 2 * e + 1] * post);
      *(u32x4*)(ptr + c * 8) = w;
    }
  } else {
    const u16* src = proj + tok * DIN + 2432;
    float x[32];
#pragma unroll
    for (int c = 0; c < 4; ++c) {
      u32x4 w = *(const u32x4*)(src + c * 8);
#pragma unroll
      for (int e = 0; e < 4; ++e) { x[c * 8 + 2 * e] = bflo(w[e]); x[c * 8 + 2 * e + 1] = bfhi(w[e]); }
    }
    { float* xa = x; float* xb = x + 16; ROPE16(p.ws, t, xa, xb); }
    u16* kd = (u16*)(p.ws + OFF_KD) + tok * 384 + 64;
#pragma unroll
    for (int c = 0; c < 4; ++c) {
      u32x4 w;
#pragma unroll
      for (int e = 0; e < 4; ++e) w[e] = pack2(x[c * 8 + 2 * e], x[c * 8 + 2 * e + 1]);
#pragma unroll
      for (int hh = 0; hh < 4; ++hh) *(u32x4*)(kd + hh * 96 + c * 8) = w;
    }
  }
}

template <int MODE>
DI void attn_tile(const Params& p, int layer, int tile, char* smem) {
  constexpr int DQK = (MODE == 3) ? 96 : 64;
  constexpr int NKQ = DQK / 16;
  constexpr int KROW = DQK + 8;
  constexpr int VROW = 72;
  constexpr int KCH = DQK / 8;
  constexpr int KLD = (64 * KCH + NTHR - 1) / NTHR;
  u16* Ks = (u16*)smem;
  u16* Vs = (u16*)(smem + 26624);
  float* tbl = (float*)(smem + 26624 + 18432);

  const int tid = opaque_tid(), lane = tid & 63, wave = tid >> 6, r = lane & 31, h = lane >> 5;
  const int qb = tile & 15, head = (tile >> 4) & 3, seq = tile >> 6;
  const size_t tok0 = (size_t)seq * SEQ;
  const u16* proj = (const u16*)(p.ws + OFF_PROJ);
  const u16 *Qp, *Kp, *Vp;
  int ldq, ldk, ldv;
  if (MODE == 0) { Qp = proj + 64 * head; Kp = proj + 256 + 64 * head; Vp = proj + 512 + 64 * head; ldq = ldk = ldv = DIN; }
  else if (MODE == 1) { Qp = proj + 768 + 64 * head; Kp = proj + 1024 + 64 * (head >> 1); Vp = proj + 1152 + 64 * (head >> 1); ldq = ldk = ldv = DIN; }
  else if (MODE == 2) { Qp = proj + 1280 + 64 * head; Kp = proj + 1536 + 64 * head; Vp = proj + 1792 + 64 * head; ldq = ldk = ldv = DIN; }
  else { Qp = (const u16*)(p.ws + OFF_QD) + 96 * head; Kp = (const u16*)(p.ws + OFF_KD) + 96 * head; Vp = (const u16*)(p.ws + OFF_VD) + 64 * head; ldq = ldk = 384; ldv = 256; }

  int kt0 = 0, kt1 = 64;
  if (MODE == 0) { kt0 = 4 * qb - 16; if (kt0 < 0) kt0 = 0; kt1 = 4 * qb + 20; if (kt1 > 64) kt1 = 64; }
  if (MODE == 2) { int r0 = 4 * qb - 4; r0 = r0 < 0 ? 0 : (r0 > 56 ? 56 : r0); int r1 = 4 * qb + 3 - 4; r1 = r1 < 0 ? 0 : (r1 > 56 ? 56 : r1); kt0 = r0; kt1 = r1 + 8; }

  if (MODE == 0) { const float* src = (const float*)(p.ws + OFF_TBLA) + head * 2560; for (int i = tid; i < 2560; i += NTHR) tbl[i] = src[i]; }
  if (MODE == 2) { const float* src = p.c_rpb + (size_t)(layer * 4 + head) * 465; for (int i = tid; i < 465; i += NTHR) tbl[i] = src[i] * LOG2E; }

  const int qpos = qb * 256 + wave * 32 + r;
  bf16x8 qf[NKQ];
  {
    const u16* qrow = Qp + (tok0 + qpos) * ldq + 8 * h;
#pragma unroll
    for (int d0 = 0; d0 < NKQ; ++d0) qf[d0] = *(const bf16x8*)(qrow + d0 * 16);
  }
  if (MODE == 3) {
    bf16x8 x1 = qf[NKQ - 2], x2 = qf[NKQ - 1];
    const f32x4* rt = (const f32x4*)(p.ws + OFF_ROPE) + (size_t)qpos * 8 + 4 * h;
#pragma unroll
    for (int j2 = 0; j2 < 4; ++j2) {
      const f32x4 cs4 = rt[j2];
#pragma unroll
      for (int e = 0; e < 2; ++e) {
        const int j = 2 * j2 + e;
        const float c = cs4[2 * e], sn = cs4[2 * e + 1];
        float a = __uint_as_float(((unsigned)(u16)x1[j]) << 16), b = __uint_as_float(((unsigned)(u16)x2[j]) << 16);
        unsigned w = pack2(a * c - b * sn, a * sn + b * c);
        x1[j] = (short)(w & 0xffff); x2[j] = (short)(w >> 16);
      }
    }
    qf[NKQ - 2] = x1; qf[NKQ - 1] = x2;
  }

  u32x4 rk0[KLD], rv0, rk1[KLD], rv1;
  const u16* Kt = Kp + tok0 * ldk;
  const u16* Vt = Vp + tok0 * ldv;
  unsigned koff[KLD];
#pragma unroll
  for (int pp = 0; pp < KLD; ++pp) { int c = tid + NTHR * pp; if (c >= 64 * KCH) c = tid; const int row = c / KCH, col = c % KCH; koff[pp] = (unsigned)row * ldk + col * 8; }
  const unsigned voff = (unsigned)(tid >> 3) * ldv + (tid & 7) * 8;
  const int ktl = kt1 - 1;
  auto gload = [&](u32x4 (&rk)[KLD], u32x4& rv, int kt) {
    kt = kt < ktl ? kt : ktl;
#pragma unroll
    for (int pp = 0; pp < KLD; ++pp) rk[pp] = *(const u32x4*)(Kt + (koff[pp] + (unsigned)(kt * 64) * ldk));
    rv = *(const u32x4*)(Vt + (voff + (unsigned)(kt * 64) * ldv));
  };
  auto lstore = [&](u32x4 (&rk)[KLD], u32x4& rv, int buf) {
#pragma unroll
    for (int pp = 0; pp < KLD; ++pp) { const int c = tid + NTHR * pp; if (c < 64 * KCH) { const int row = c / KCH, col = c % KCH; *(u32x4*)(Ks + (buf * 64 + row) * KROW + col * 8) = rk[pp]; } }
    *(u32x4*)(Vs + (buf * 64 + (tid >> 3)) * VROW + (tid & 7) * 8) = rv;
  };

  f32x16 o0, o1, negm;
#pragma unroll
  for (int i = 0; i < 16; ++i) { o0[i] = 0.f; o1[i] = 0.f; negm[i] = 0.f; }
  float mref = 0.f, lsum = 0.f;
  bool started = false;
  int qr = 0, qc = 0, cs = 0, rs = 0;
  if (MODE == 2) { qr = qpos >> 6; qc = qpos & 63; cs = qc - 8; cs = cs < 0 ? 0 : (cs > 48 ? 48 : cs); rs = qr - 4; rs = rs < 0 ? 0 : (rs > 56 ? 56 : rs); }
  const int i16 = lane & 15, qq = i16 >> 2, pp4 = i16 & 3, g16 = (lane >> 4) & 1;

  auto compute = [&](int buf, int kt) {
    bool active = true;
    if (MODE == 2) active = (kt >= rs) && (kt < rs + 8);
    if (active) {
      const u16* Kb = Ks + buf * 64 * KROW + r * KROW + 8 * h;
      const u16* Vb = Vs + buf * 64 * VROW;
      bf16x8 vf[8];
#pragma unroll
      for (int cs2 = 0; cs2 < 4; ++cs2) {
        const u16* vp = Vb + (16 * cs2 + 4 * h + qq) * VROW + 16 * g16 + 4 * pp4;
        { s16x4 lo = tr_read(vp), hi = tr_read(vp + 8 * VROW); vf[2 * cs2] = __builtin_shufflevector(lo, hi, 0, 1, 2, 3, 4, 5, 6, 7); }
        { s16x4 lo = tr_read(vp + 32), hi = tr_read(vp + 8 * VROW + 32); vf[2 * cs2 + 1] = __builtin_shufflevector(lo, hi, 0, 1, 2, 3, 4, 5, 6, 7); }
      }
      f32x16 s0 = negm, s1 = negm;
#pragma unroll
      for (int d0 = 0; d0 < NKQ; ++d0) {
        bf16x8 k0 = *(const bf16x8*)(Kb + d0 * 16);
        bf16x8 k1 = *(const bf16x8*)(Kb + 32 * KROW + d0 * 16);
        s0 = mfma(k0, qf[d0], s0);
        s1 = mfma(k1, qf[d0], s1);
      }
      if (MODE == 0) {
        const float* tb = tbl + (kt * 64 + 4 * h - qpos + 1280);
#pragma unroll
        for (int i = 0; i < 16; ++i) { s0[i] += tb[(i & 3) + 8 * (i >> 2)]; s1[i] += tb[32 + (i & 3) + 8 * (i >> 2)]; }
      }
      if (MODE == 2) {
        const float* tb = tbl + (kt - qr + 7) * 31 + (15 - qc);
#pragma unroll
        for (int i = 0; i < 16; ++i) {
          const int kc0 = 4 * h + (i & 3) + 8 * (i >> 2), kc1 = kc0 + 32;
          const bool v0 = (kc0 >= cs) && (kc0 < cs + 16), v1 = (kc1 >= cs) && (kc1 < cs + 16);
          const float b0 = tb[v0 ? kc0 : qc], b1 = tb[v1 ? kc1 : qc];
          s0[i] = v0 ? s0[i] + b0 : NEGBIG;
          s1[i] = v1 ? s1[i] + b1 : NEGBIG;
        }
      }
      float ma = __builtin_fmaxf(__builtin_fmaxf(s0[0], s0[1]), s0[2]), mb = __builtin_fmaxf(__builtin_fmaxf(s1[0], s1[1]), s1[2]);
#pragma unroll
      for (int i = 3; i < 15; i += 2) { ma = __builtin_fmaxf(__builtin_fmaxf(ma, s0[i]), s0[i + 1]); mb = __builtin_fmaxf(__builtin_fmaxf(mb, s1[i]), s1[i + 1]); }
      float mt = __builtin_fmaxf(__builtin_fmaxf(ma, s0[15]), s1[15]);
      mt = hmax(__builtin_fmaxf(mt, mb));
      const bool fresh = !started && (mt > -1e29f);
      if (__any(fresh || (started && mt > 8.f))) {
        float delta = 0.f, al = 1.f;
        if (fresh) { delta = mt; started = true; }
        else if (started) { delta = __builtin_fmaxf(mt, 0.f); al = fexp2(-delta); }
        mref += delta;
        lsum *= al;
#pragma unroll
        for (int i = 0; i < 16; ++i) { o0[i] *= al; o1[i] *= al; s0[i] -= delta; s1[i] -= delta; negm[i] = -mref; }
      }
      float ps = 0.f;
#pragma unroll
      for (int i = 0; i < 16; ++i) { s0[i] = fexp2(s0[i]); s1[i] = fexp2(s1[i]); ps += s0[i] + s1[i]; }
      lsum += ps;
#pragma unroll
      for (int c = 0; c < 2; ++c) {
#pragma unroll
        for (int s = 0; s < 2; ++s) {
          u32x4 pw;
          if (c == 0) pw = (u32x4){pack2(s0[8 * s], s0[8 * s + 1]), pack2(s0[8 * s + 2], s0[8 * s + 3]), pack2(s0[8 * s + 4], s0[8 * s + 5]), pack2(s0[8 * s + 6], s0[8 * s + 7])};
          else pw = (u32x4){pack2(s1[8 * s], s1[8 * s + 1]), pack2(s1[8 * s + 2], s1[8 * s + 3]), pack2(s1[8 * s + 4], s1[8 * s + 5]), pack2(s1[8 * s + 6], s1[8 * s + 7])};
          const bf16x8 pf = __builtin_bit_cast(bf16x8, pw);
          o0 = mfma(vf[2 * (2 * c + s)], pf, o0);
          o1 = mfma(vf[2 * (2 * c + s) + 1], pf, o1);
        }
      }
    }
  };

  const int ntile = kt1 - kt0;
  gload(rk0, rv0, kt0);
  lstore(rk0, rv0, 0);
  gload(rk0, rv0, kt0 + 1);
  gload(rk1, rv1, kt0 + 2);
  __syncthreads();
  for (int j = 0; j < ntile; j += 2) {
    compute(0, kt0 + j);
    lstore(rk0, rv0, 1);
    gload(rk0, rv0, kt0 + j + 3);
    __syncthreads();
    if (j + 1 >= ntile) break;
    compute(1, kt0 + j + 1);
    lstore(rk1, rv1, 0);
    gload(rk1, rv1, kt0 + j + 4);
    __syncthreads();
  }
  lsum = hsum(lsum);
  const float inv = 1.f / lsum;
  float sq = 0.f;
#pragma unroll
  for (int i = 0; i < 16; ++i) { o0[i] *= inv; o1[i] *= inv; sq += o0[i] * o0[i] + o1[i] * o1[i]; }
  sq = hsum(sq);
  if (h == 0) ((float*)(p.ws + OFF_SSQ))[(tok0 + qpos) * 16 + MODE * 4 + head] = sq;
  u16* op = (u16*)(p.ws + OFF_ACTB) + (tok0 + qpos) * DM + MODE * 256 + head * 64 + 4 * h;
#pragma unroll
  for (int g4 = 0; g4 < 4; ++g4) {
    u32x2 w0 = {pack2(o0[4 * g4], o0[4 * g4 + 1]), pack2(o0[4 * g4 + 2], o0[4 * g4 + 3])};
    u32x2 w1 = {pack2(o1[4 * g4], o1[4 * g4 + 1]), pack2(o1[4 * g4 + 2], o1[4 * g4 + 3])};
    *(u32x2*)(op + 8 * g4) = w0;
    *(u32x2*)(op + 32 + 8 * g4) = w1;
  }
}


DI bool sb_tile(int bid, int nb, int it, int NT, int& mt, int& nt) {
  const int G = nb >> 3, x = bid & 7, l = bid >> 3;
  const int s = l + it * G;
  const int sb = (s >> 5) * 8 + x, w = s & 31;
  const int NG = NT >> 1;
  if (sb >= 24 * NG) return false;
  const int mg = sb / NG, ng = sb - mg * NG;
  mt = mg * 16 + (w >> 1); nt = ng * 2 + (w & 1);
  return true;
}

DI bool att_tile_index(int bid, int nb, int it, int& tile) {
  if (nb != 256) { tile = bid + it * nb; return tile < 1536; }
  const int x = bid & 7, l = bid >> 3;
  const int pair = 2 * (it * 8 + x) + (l >> 4);
  tile = pair * 16 + ((l + 3 * it) & 15);
  return pair < 96;
}

template <int EPI, bool GSCALE = false>
DI void gemm8_phase(const Params& p, int layer, const u16* A, const u16* Bt, int K, int NT, char* smem) {
  const int bid = blockIdx.x, nb = gridDim.x;
  int mt, nt;
  bool have = sb_tile(bid, nb, 0, NT, mt, nt);
  if (have) gemm8_prestage(A, Bt, K, mt * 256, nt * 256, smem);
  for (int it = 0; have; ++it) {
    int mt2 = 0, nt2 = 0;
    const bool have2 = sb_tile(bid, nb, it + 1, NT, mt2, nt2);
    gemm8_tile<EPI, GSCALE>(p, layer, A, Bt, K, mt * 256, nt * 256, smem, have2, mt2 * 256, nt2 * 256);
    have = have2; mt = mt2; nt = nt2;
  }
}

constexpr int NPHASE = 17;
constexpr int MT = T_TOK / 256;

DI void run_phase(const Params& p, int ph, char* smem) {
  const int bid = blockIdx.x, nb = gridDim.x;
  u16* wtb = (u16*)(p.ws + OFF_WT);
  const u16* actb = (const u16*)(p.ws + OFF_ACTB);
  if (ph == 0) {
    for (int j = bid; j < 128; j += nb) rope_tab_build(p.ws, j * NTHR + opaque_tid());
    for (int j = bid; j < WJ_TOTAL; j += nb) wprep_job(p, j, smem);
    for (int rb = bid; rb < T_TOK / 8; rb += nb) norm_rows(p, 0, rb, 0);
    return;
  }
  if (ph == 16) { for (int rb = bid; rb < T_TOK / 8; rb += nb) norm_rows(p, 1, rb, 1); return; }
  const int layer = (ph - 1) >> 3, sub = (ph - 1) & 7;
  const u16* wl = wtb + (size_t)layer * WT_LAYER;
  switch (sub) {
    case 0:
      gemm8_phase<EPI_PROJ>(p, layer, actb, wl + WT_IN, 1024, 10, smem);
      break;
    case 1:
      for (int c = bid; c < (T_TOK / NTHR) * 8; c += nb) e1_chunk(p, layer, c);
      for (int t = bid; t < MT * 2; t += nb) { const int nt = t & 1, mt = t >> 1; gemm_tile<EPI_UQ, false, true>(p, layer, (const u16*)(p.ws + OFF_PROJ) + 2048, DIN, wl + WT_UQ, 256, mt * 256, nt * 256, smem); }
      for (int t = bid; t < MT * 2; t += nb) { const int nt = t & 1, mt = t >> 1; gemm_tile<EPI_UKV, false, true>(p, layer, (const u16*)(p.ws + OFF_PROJ) + 2304, DIN, wl + WT_UKV, 128, mt * 256, nt * 256, smem); }
      break;
    case 2:
      for (int it = 0, t; att_tile_index(bid, nb, it, t); ++it) attn_tile<3>(p, layer, t, smem);
      for (int it = 0, t; att_tile_index(bid, nb, it, t); ++it) attn_tile<1>(p, layer, t, smem);
      for (int it = 0, t; att_tile_index(bid, nb, it, t); ++it) attn_tile<0>(p, layer, t, smem);
      for (int it = 0, t; att_tile_index(bid, nb, it, t); ++it) attn_tile<2>(p, layer, t, smem);
      break;
    case 3:
      gemm8_phase<EPI_RES, true>(p, layer, actb, wl + WT_OUT, 1024, 4, smem);
      break;
    case 4:
      for (int rb = bid; rb < T_TOK / 8; rb += nb) norm_rows(p, 1, rb, 0);
      break;
    case 5:
      gemm8_phase<EPI_SWIGLU>(p, layer, actb, wl + WT_GU, 1024, 22, smem);
      break;
    case 6:
      gemm8_phase<EPI_RES>(p, 1, (const u16*)(p.ws + OFF_ACT), wl + WT_DN, DFF, 4, smem);
      break;
    case 7:
      for (int rb = bid; rb < T_TOK / 8; rb += nb) norm_rows(p, 1, rb, 0);
      break;
  }
}

__global__ void __launch_bounds__(NTHR, 2) mega(Params p, int ph_lo, int ph_hi) {
  __shared__ __attribute__((aligned(16))) char smem[SMEM_BYTES];
  cg::grid_group grid = cg::this_grid();
  for (int ph = ph_lo; ph < ph_hi; ++ph) {
    if (ph > ph_lo) grid.sync();
    run_phase(p, ph, smem);
#ifdef DUPMASK
    if (ph >= 1 && ph < 16 && ((DUPMASK >> ((ph - 1) & 7)) & 1)) { grid.sync(); run_phase(p, ph, smem); }
#endif
  }
}

extern "C" void kernel_launch(void* const* d_in, const int* in_sizes, int n_in, void* d_out, int out_size, void* d_ws, size_t ws_size, hipStream_t stream) {
  Params p{};
  p.x_prompt = (const float*)d_in[0]; p.x_sample = (const float*)d_in[1]; p.t5_bias = (const float*)d_in[2]; p.norm_mix = (const float*)d_in[3];
  p.w_in = (const float*)d_in[4]; p.b_q_gain = (const float*)d_in[5]; p.b_k_gain = (const float*)d_in[6]; p.c_rpb = (const float*)d_in[7];
  p.d_q_gain = (const float*)d_in[8]; p.d_w_uq = (const float*)d_in[9]; p.d_kv_gain = (const float*)d_in[10]; p.d_w_ukv = (const float*)d_in[11];
  p.out_gain = (const float*)d_in[12]; p.w_out = (const float*)d_in[13]; p.norm_ffn = (const float*)d_in[14]; p.w_gate = (const float*)d_in[15];
  p.w_up = (const float*)d_in[16]; p.w_down = (const float*)d_in[17]; p.final_norm = (const float*)d_in[18];
  p.out = (float*)d_out; p.ws = (char*)d_ws;
  if (ws_size < WS_NEED) { fprintf(stderr, "workspace too small: %zu < %zu\n", ws_size, (size_t)WS_NEED); return; }
  static int grid_blocks = 0;
  if (!grid_blocks) {
    int dev = 0, cus = 0, per_cu = 0;
    hipGetDevice(&dev);
    hipDeviceGetAttribute(&cus, hipDeviceAttributeMultiprocessorCount, dev);
    hipOccupancyMaxActiveBlocksPerMultiprocessor(&per_cu, mega, NTHR, 0);
    if (per_cu < 1) per_cu = 1;
    if (per_cu > 1) per_cu = 1;
    grid_blocks = cus * per_cu;
  }
#if ONE_LAUNCH
  int lo = 0, hi = NPHASE;
  void* args[] = {&p, &lo, &hi};
  hipError_t e = hipLaunchCooperativeKernel((void*)mega, dim3(grid_blocks), dim3(NTHR), args, 0, stream);
  if (e != hipSuccess) fprintf(stderr, "cooperative launch failed: %s (grid %d)\n", hipGetErrorString(e), grid_blocks);
#else
  for (int ph = 0; ph < NPHASE; ++ph) hipLaunchKernelGGL(mega, dim3(grid_blocks), dim3(NTHR), 0, stream, p, ph, ph + 1);
#endif
}
```

```cpp
#include <hip/hip_runtime.h>
#include <hip/hip_cooperative_groups.h>
#include <cstdio>
#include <cstdint>
namespace cg = cooperative_groups;

#ifndef ONE_LAUNCH
#define ONE_LAUNCH 1
#endif

#define DI __device__ __forceinline__
typedef short bf16x8 __attribute__((ext_vector_type(8)));
typedef short s16x4 __attribute__((ext_vector_type(4)));
typedef float f32x16 __attribute__((ext_vector_type(16)));
typedef float f32x4 __attribute__((ext_vector_type(4)));
typedef float f32x2 __attribute__((ext_vector_type(2)));
typedef unsigned u32x4 __attribute__((ext_vector_type(4)));
typedef unsigned u32x2 __attribute__((ext_vector_type(2)));
typedef __bf16 bf16v2 __attribute__((ext_vector_type(2)));
typedef unsigned short u16;

constexpr int T_TOK = 98304, SEQ = 4096, DM = 1024, DIN = 2464, DINP = 2560, DFF = 2816;
constexpr int NPROMPT = 8 * 4096;
constexpr int NTHR = 512;
constexpr float LOG2E = 1.4426950408889634f;
constexpr float QSCALE64 = 0.125f * LOG2E;
constexpr float QSCALE96 = 0.10206207261596575f * LOG2E;
constexpr float NEGBIG = -1e30f;
constexpr float EPS = 1e-6f;

constexpr size_t al256(size_t x) { return (x + 255) & ~(size_t)255; }
constexpr size_t WT_IN = 0;
constexpr size_t WT_UQ = WT_IN + (size_t)DINP * 1024;
constexpr size_t WT_UKV = WT_UQ + 512 * 256;
constexpr size_t WT_OUT = WT_UKV + 512 * 128;
constexpr size_t WT_GU = WT_OUT + 1024 * 1024;
constexpr size_t WT_DN = WT_GU + (size_t)5632 * 1024;
constexpr size_t WT_LAYER = WT_DN + (size_t)1024 * 2816;
constexpr size_t OFF_WT = 0;
constexpr size_t OFF_TBLA = al256(OFF_WT + 2 * WT_LAYER * 2);
constexpr size_t OFF_ROPE = al256(OFF_TBLA + 4 * 2560 * 4);
constexpr size_t OFF_ACTB = al256(OFF_ROPE + 4096 * 16 * 8);
constexpr size_t OFF_PROJ = al256(OFF_ACTB + (size_t)T_TOK * 1024 * 2);
constexpr size_t OFF_QD = al256(OFF_PROJ + (size_t)T_TOK * DIN * 2);
constexpr size_t OFF_KD = al256(OFF_QD + (size_t)T_TOK * 384 * 2);
constexpr size_t OFF_VD = al256(OFF_KD + (size_t)T_TOK * 384 * 2);
constexpr size_t OFF_SSQ = al256(OFF_VD + (size_t)T_TOK * 256 * 2);
constexpr size_t WS_NEED = al256(OFF_SSQ + (size_t)T_TOK * 16 * 4);
constexpr size_t OFF_ACT = OFF_PROJ;
static_assert(OFF_ACT + (size_t)T_TOK * DFF * 2 <= OFF_KD, "act alias overflow");

struct Params {
  const float *x_prompt, *x_sample, *t5_bias, *norm_mix, *w_in, *b_q_gain, *b_k_gain, *c_rpb, *d_q_gain, *d_w_uq,
      *d_kv_gain, *d_w_ukv, *out_gain, *w_out, *norm_ffn, *w_gate, *w_up, *w_down, *final_norm;
  float* out;
  char* ws;
};

constexpr int SMEM_BYTES = 2 * (256 + 256) * 72 * 2 + 1024;

DI unsigned pack2(float a, float b) { f32x2 v = {a, b}; bf16v2 r = __builtin_convertvector(v, bf16v2); return __builtin_bit_cast(unsigned, r); }
DI float bflo(unsigned w) { return __uint_as_float(w << 16); }
DI float bfhi(unsigned w) { return __uint_as_float(w & 0xffff0000u); }
DI f32x16 mfma(bf16x8 a, bf16x8 b, f32x16 c) { return __builtin_amdgcn_mfma_f32_32x32x16_bf16(a, b, c, 0, 0, 0); }
DI float hmax(float v) {
  auto rr = __builtin_amdgcn_permlane32_swap(__float_as_uint(v), __float_as_uint(v), false, false);
  return __builtin_fmaxf(__uint_as_float(rr[0]), __uint_as_float(rr[1]));
}
DI float hsum(float v) {
  auto rr = __builtin_amdgcn_permlane32_swap(__float_as_uint(v), __float_as_uint(v), false, false);
  return __uint_as_float(rr[0]) + __uint_as_float(rr[1]);
}
DI float fexp2(float x) { return __builtin_amdgcn_exp2f(x); }
DI int crow(int i, int h) { return (i & 3) + 8 * (i >> 2) + 4 * h; }
typedef short v4i16_t __attribute__((ext_vector_type(4)));
DI s16x4 tr_read(const u16* p) {
  return __builtin_bit_cast(s16x4, __builtin_amdgcn_ds_read_tr16_b64_v4i16((__attribute__((address_space(3))) v4i16_t*)p));
}
constexpr double inv_rev_c(int i) {
  constexpr double b[4] = {1.0, 0.5623413251903491, 0.31622776601683794, 0.1778279410038923};
  double v = b[i & 3];
  for (int k = 0; k < (i >> 2); ++k) v *= 0.1;
  return v * 0.15915494309189535;
}
DI void rope_tab_build(char* ws, int idx) {
  const int pos = idx >> 4, i = idx & 15;
  double invrev = inv_rev_c(0);
#pragma unroll
  for (int k = 1; k < 16; ++k) if (i == k) invrev = inv_rev_c(k);
  double rev = (double)pos * invrev;
  float f = (float)(rev - (double)(int)rev);
  f32x2 cs = {__builtin_amdgcn_cosf(f), __builtin_amdgcn_sinf(f)};
  ((f32x2*)(ws + OFF_ROPE))[idx] = cs;
}
#define ROPE16(ws_, pos_, A_, B_)                                                              \
  {                                                                                            \
    const f32x4* rt_ = (const f32x4*)((ws_) + OFF_ROPE) + (size_t)(pos_) * 8;                  \
    _Pragma("unroll") for (int i2_ = 0; i2_ < 8; ++i2_) {                                      \
      const f32x4 cs_ = rt_[i2_];                                                              \
      float a_ = A_[2 * i2_], b_ = B_[2 * i2_];                                                \
      A_[2 * i2_] = a_ * cs_[0] - b_ * cs_[1]; B_[2 * i2_] = a_ * cs_[1] + b_ * cs_[0];        \
      a_ = A_[2 * i2_ + 1]; b_ = B_[2 * i2_ + 1];                                              \
      A_[2 * i2_ + 1] = a_ * cs_[2] - b_ * cs_[3]; B_[2 * i2_ + 1] = a_ * cs_[3] + b_ * cs_[2]; \
    }                                                                                          \
  }
DI const float* xrow(const Params& p, int layer, size_t tok) {
  if (layer == 0) return tok < (size_t)NPROMPT ? p.x_prompt + tok * DM : p.x_sample + (tok - NPROMPT) * DM;
  return p.out + tok * DM;
}

DI int opaque_tid() { int t = threadIdx.x; asm volatile("" : "+v"(t)); return t; }
DI void wt_tile(const float* __restrict__ W, int K, int N, const float* __restrict__ g, u16* __restrict__ Wt, int k0, int n0, int mapmode, float* tile) {
  const int tid = opaque_tid();
  for (int i = tid; i < 4096; i += NTHR) {
    int kk = i >> 6, nn = i & 63, n = n0 + nn;
    float v = 0.f;
    if (n < N) { v = W[(size_t)(k0 + kk) * N + n]; if (g) v *= g[k0 + kk]; }
    tile[kk * 65 + nn] = v;
  }
  __syncthreads();
  for (int i = tid; i < 2048; i += NTHR) {
    int nn = i >> 5, kp = i & 31, n = n0 + nn;
    float cs = 1.f; int drow = n;
    if (mapmode == 1) { if (n < 256 || (n >= 1280 && n < 1536)) cs = QSCALE64; }
    else if (mapmode == 2) cs = QSCALE96;
    else if (mapmode == 3) drow = 32 * (n >> 4) + (n & 15);
    else if (mapmode == 4) drow = 32 * (n >> 4) + 16 + (n & 15);
    unsigned w = pack2(tile[(2 * kp) * 65 + nn] * cs, tile[(2 * kp + 1) * 65 + nn] * cs);
    *(unsigned*)(Wt + (size_t)drow * K + k0 + 2 * kp) = w;
  }
  __syncthreads();
}

constexpr int WJ_IN = 640, WJ_UQ = 32, WJ_UKV = 16, WJ_OUT = 256, WJ_G = 704, WJ_U = 704, WJ_D = 704;
constexpr int WJ_LAYER = WJ_IN + WJ_UQ + WJ_UKV + WJ_OUT + WJ_G + WJ_U + WJ_D;
constexpr int WJ_TOTAL = 2 * WJ_LAYER + 20;

DI void wprep_job(const Params& p, int job, char* smem) {
  float* tile = (float*)smem;
  u16* wtb = (u16*)(p.ws + OFF_WT);
  if (job >= 2 * WJ_LAYER) {
    int idx = (job - 2 * WJ_LAYER) * NTHR + opaque_tid();
    int head = idx / 2560, e = idx % 2560, d = e - 1280, n = d < 0 ? -d : d;
    int mult = (n <= 64 ? 1 : 0) + (((n & 3) == 0 && n <= 256) ? 1 : 0) + (((n & 15) == 0 && n <= 1024) ? 1 : 0);
    float v = NEGBIG;
    if (mult > 0) {
      int bk;
      if (n < 8) bk = n;
      else { float nf = (float)n; int lg = 8 + (int)(__logf(nf * 0.125f) / 4.852030263919617f * 8.0f); bk = lg < 15 ? lg : 15; }
      if (d > 0) bk += 16;
      v = (p.t5_bias[bk * 4 + head] + __logf((float)mult)) * LOG2E;
    }
    ((float*)(p.ws + OFF_TBLA))[idx] = v;
    return;
  }
  int layer = job / WJ_LAYER, j = job % WJ_LAYER;
  u16* wl = wtb + (size_t)layer * WT_LAYER;
  if (j < WJ_IN) { int kt = j & 15, nt = j >> 4; wt_tile(p.w_in + (size_t)layer * 1024 * DIN, 1024, DIN, p.norm_mix + layer * 1024, wl + WT_IN, kt * 64, nt * 64, 1, tile); return; }
  j -= WJ_IN;
  if (j < WJ_UQ) { int kt = j & 3, nt = j >> 2; wt_tile(p.d_w_uq + (size_t)layer * 256 * 384, 256, 384, p.d_q_gain + layer * 256, wl + WT_UQ, kt * 64, nt * 64, 2, tile); return; }
  j -= WJ_UQ;
  if (j < WJ_UKV) { int kt = j & 1, nt = j >> 1; wt_tile(p.d_w_ukv + (size_t)layer * 128 * 512, 128, 512, p.d_kv_gain + layer * 128, wl + WT_UKV, kt * 64, nt * 64, 0, tile); return; }
  j -= WJ_UKV;
  if (j < WJ_OUT) { int kt = j & 15, nt = j >> 4; wt_tile(p.w_out + (size_t)layer * 1024 * 1024, 1024, 1024, p.out_gain + layer * 1024, wl + WT_OUT, kt * 64, nt * 64, 0, tile); return; }
  j -= WJ_OUT;
  if (j < WJ_G) { int kt = j & 15, nt = j >> 4; wt_tile(p.w_gate + (size_t)layer * 1024 * DFF, 1024, DFF, p.norm_ffn + layer * 1024, wl + WT_GU, kt * 64, nt * 64, 3, tile); return; }
  j -= WJ_G;
  if (j < WJ_U) { int kt = j & 15, nt = j >> 4; wt_tile(p.w_up + (size_t)layer * 1024 * DFF, 1024, DFF, p.norm_ffn + layer * 1024, wl + WT_GU, kt * 64, nt * 64, 4, tile); return; }
  j -= WJ_U;
  { int kt = j % 44, nt = j / 44; wt_tile(p.w_down + (size_t)layer * DFF * 1024, DFF, 1024, nullptr, wl + WT_DN, kt * 64, nt * 64, 0, tile); }
}

DI void norm_rows(const Params& p, int layer, int rb, int mode) {
  const int tid = opaque_tid();
  const int lane = tid & 63, wave = tid >> 6;
  const size_t row = (size_t)rb * 8 + wave;
  const float* src = xrow(p, layer, row);
  f32x4 v[4];
  float ss = 0.f;
#pragma unroll
  for (int i = 0; i < 4; ++i) { v[i] = *(const f32x4*)(src + lane * 4 + 256 * i); ss += v[i][0] * v[i][0] + v[i][1] * v[i][1] + v[i][2] * v[i][2] + v[i][3] * v[i][3]; }
#pragma unroll
  for (int o = 1; o < 64; o <<= 1) ss += __shfl_xor(ss, o);
  const float rstd = rsqrtf(ss * (1.f / 1024.f) + EPS);
  if (mode == 0) {
    u16* dst = (u16*)(p.ws + OFF_ACTB) + row * DM;
#pragma unroll
    for (int i = 0; i < 4; ++i) { u32x2 w = {pack2(v[i][0] * rstd, v[i][1] * rstd), pack2(v[i][2] * rstd, v[i][3] * rstd)}; *(u32x2*)(dst + lane * 4 + 256 * i) = w; }
  } else {
    float* dst = p.out + row * DM;
#pragma unroll
    for (int i = 0; i < 4; ++i) { f32x4 g = *(const f32x4*)(p.final_norm + lane * 4 + 256 * i); f32x4 o = {v[i][0] * rstd * g[0], v[i][1] * rstd * g[1], v[i][2] * rstd * g[2], v[i][3] * rstd * g[3]}; *(f32x4*)(dst + lane * 4 + 256 * i) = o; }
  }
}

enum { EPI_PROJ = 0, EPI_UQ = 1, EPI_UKV = 2, EPI_RES = 3, EPI_SWIGLU = 4 };
constexpr int GS = 72;
constexpr int BM = 256;
constexpr int TMW = 4;

template <int EPI, bool ASCALE, bool ROWNORM>
DI void gemm_tile(const Params& p, int layer, const u16* __restrict__ A, int lda, const u16* __restrict__ Wt, int K, int m0, int n0, char* smem) {
  u16* As = (u16*)smem;
  u16* Bs = As + 2 * BM * GS;
  float* rowscale = (float*)(Bs + 2 * 256 * GS);
  const int tid = opaque_tid(), lane = tid & 63, wave = tid >> 6, r = lane & 31, h = lane >> 5;
  const int wm = wave >> 2, wn = wave & 3;
  const int lrow = tid >> 3, kc = tid & 7;
  const u16* At = A + (size_t)m0 * lda;
  const u16* Bt = Wt + (size_t)n0 * K;
  const unsigned aoff = (unsigned)lrow * lda + kc * 8, boff = (unsigned)lrow * K + kc * 8;
  const float* ssq = (const float*)(p.ws + OFF_SSQ);

  if (ROWNORM) {
    const int rr = tid >> 1, half = tid & 1;
    const u16* src = A + (size_t)(m0 + rr) * lda + half * (K / 2);
    float ss = 0.f;
    for (int i = 0; i < K / 16; ++i) {
      u32x4 w = *(const u32x4*)(src + i * 8);
#pragma unroll
      for (int e = 0; e < 4; ++e) { float a = bflo(w[e]), b = bfhi(w[e]); ss += a * a + b * b; }
    }
    ss += __shfl_xor(ss, 1);
    if (half == 0) rowscale[rr] = rsqrtf(ss / (float)K + EPS);
  }

  f32x16 acc[TMW][2];
#pragma unroll
  for (int a = 0; a < TMW; ++a)
#pragma unroll
    for (int b = 0; b < 2; ++b)
#pragma unroll
      for (int i = 0; i < 16; ++i) acc[a][b][i] = 0.f;

  u32x4 ra[4], rb[4];
  float sc[4] = {1.f, 1.f, 1.f, 1.f};
  const int KT = K / 64;
  auto gload = [&](int kt) {
#pragma unroll
    for (int pp = 0; pp < 4; ++pp) ra[pp] = *(const u32x4*)(At + (size_t)(64 * pp) * lda + (aoff + (unsigned)kt * 64));
#pragma unroll
    for (int pp = 0; pp < 4; ++pp) rb[pp] = *(const u32x4*)(Bt + (size_t)(64 * pp) * K + (boff + (unsigned)kt * 64));
  };
  auto lstore = [&](int buf, int kt) {
    if (ASCALE) {
      if ((kt & 3) == 0) {
        const int g = kt >> 2;
#pragma unroll
        for (int pp = 0; pp < 4; ++pp) {
          f32x4 s4 = *(const f32x4*)(ssq + (size_t)(m0 + lrow + 64 * pp) * 16 + 4 * g);
          sc[pp] = rsqrtf((s4[0] + s4[1] + s4[2] + s4[3]) * (1.f / 256.f) + EPS);
        }
      }
#pragma unroll
      for (int pp = 0; pp < 4; ++pp)
#pragma unroll
        for (int e = 0; e < 4; ++e) ra[pp][e] = pack2(bflo(ra[pp][e]) * sc[pp], bfhi(ra[pp][e]) * sc[pp]);
    }
#pragma unroll
    for (int pp = 0; pp < 4; ++pp) *(u32x4*)(As + (buf * BM + lrow + 64 * pp) * GS + kc * 8) = ra[pp];
#pragma unroll
    for (int pp = 0; pp < 4; ++pp) *(u32x4*)(Bs + (buf * 256 + lrow + 64 * pp) * GS + kc * 8) = rb[pp];
  };
  auto compute = [&](int buf) {
    const u16* Ab = As + (buf * BM + wm * 128 + r) * GS + 8 * h;
    const u16* Bb = Bs + (buf * 256 + wn * 64 + r) * GS + 8 * h;
#pragma unroll
    for (int ks = 0; ks < 4; ++ks) {
      bf16x8 b0 = *(const bf16x8*)(Bb + ks * 16);
      bf16x8 b1 = *(const bf16x8*)(Bb + 32 * GS + ks * 16);
#pragma unroll
      for (int tm = 0; tm < TMW; ++tm) {
        bf16x8 a = *(const bf16x8*)(Ab + tm * 32 * GS + ks * 16);
        acc[tm][0] = mfma(a, b0, acc[tm][0]);
        acc[tm][1] = mfma(a, b1, acc[tm][1]);
      }
    }
  };
  gload(0);
  lstore(0, 0);
  if (KT > 1) gload(1);
  __syncthreads();
  for (int kt = 0; kt < KT; ++kt) {
    compute(kt & 1);
    if (kt + 1 < KT) lstore((kt + 1) & 1, kt + 1);
    if (kt + 2 < KT) gload(kt + 2);
    __syncthreads();
  }

  const int wms = __builtin_amdgcn_readfirstlane(wm), wns = __builtin_amdgcn_readfirstlane(wn);
  const int mrow0 = m0 + wms * 128;
  const int nwb = n0 + wns * 64;
  if (ROWNORM) {
#pragma unroll
    for (int tm = 0; tm < TMW; ++tm) {
#pragma unroll
      for (int i = 0; i < 16; ++i) {
        const float rs = rowscale[wms * 128 + 4 * h + 32 * tm + (i & 3) + 8 * (i >> 2)];
        acc[tm][0][i] *= rs; acc[tm][1][i] *= rs;
      }
    }
  }
  if (EPI == EPI_SWIGLU) {
    u16* dw = (u16*)(p.ws + OFF_ACT) + (size_t)mrow0 * DFF + (nwb >> 1);
    const unsigned lo = (unsigned)(4 * h) * DFF + r;
#pragma unroll
    for (int tm = 0; tm < TMW; ++tm) {
#pragma unroll
      for (int i = 0; i < 16; ++i) {
        const float g = acc[tm][0][i], u = acc[tm][1][i];
        const float a = g * __builtin_amdgcn_rcpf(1.f + fexp2(-g * LOG2E)) * u;
        dw[lo + (unsigned)((32 * tm + (i & 3) + 8 * (i >> 2)) * DFF)] = (u16)(pack2(a, 0.f) & 0xffff);
      }
      __builtin_amdgcn_sched_barrier(0);
    }
  } else {
#pragma unroll
    for (int tn = 0; tn < 2; ++tn) {
      const int nb0 = nwb + 32 * tn;
      if (EPI == EPI_RES) {
        const float* xw = (layer == 0 ? (m0 < NPROMPT ? p.x_prompt + (size_t)mrow0 * DM : p.x_sample + (size_t)(mrow0 - NPROMPT) * DM) : p.out + (size_t)mrow0 * DM) + nb0;
        float* ow = p.out + (size_t)mrow0 * DM + nb0;
        const unsigned lo = (unsigned)(4 * h) * DM + r;
#pragma unroll
        for (int tm = 0; tm < TMW; ++tm) {
#pragma unroll
          for (int g4 = 0; g4 < 4; ++g4) {
            float xv[4];
#pragma unroll
            for (int e = 0; e < 4; ++e) xv[e] = xw[lo + (unsigned)((32 * tm + 8 * g4 + e) * DM)];
#pragma unroll
            for (int e = 0; e < 4; ++e) ow[lo + (unsigned)((32 * tm + 8 * g4 + e) * DM)] = xv[e] + acc[tm][tn][4 * g4 + e];
          }
          __builtin_amdgcn_sched_barrier(0);
        }
      } else {
        u16* dw; int ld; bool ok = true;
        if (EPI == EPI_PROJ) { dw = (u16*)(p.ws + OFF_PROJ) + (size_t)mrow0 * DIN + nb0; ld = DIN; ok = (nb0 + r) < DIN; }
        else if (EPI == EPI_UQ) { dw = (u16*)(p.ws + OFF_QD) + (size_t)mrow0 * 384 + nb0; ld = 384; ok = nb0 < 384; }
        else {
          const int head = nb0 >> 7, w = nb0 & 127;
          if (w < 64) { dw = (u16*)(p.ws + OFF_KD) + (size_t)mrow0 * 384 + head * 96 + w; ld = 384; }
          else { dw = (u16*)(p.ws + OFF_VD) + (size_t)mrow0 * 256 + head * 64 + (w - 64); ld = 256; }
        }
        const unsigned lo = (unsigned)(4 * h) * ld + r;
        if (ok) {
#pragma unroll
          for (int tm = 0; tm < TMW; ++tm) {
#pragma unroll
            for (int i = 0; i < 16; ++i) dw[lo + (unsigned)((32 * tm + (i & 3) + 8 * (i >> 2)) * ld)] = (u16)(pack2(acc[tm][tn][i], 0.f) & 0xffff);
            __builtin_amdgcn_sched_barrier(0);
          }
        }
      }
    }
  }
  if (ROWNORM) __syncthreads();
}


typedef float f32x4v __attribute__((ext_vector_type(4)));
constexpr int G8_HT = 128 * 64;
DI int lds_byte8(int r, int c) { const int st = (r >> 4) * 2 + (c >> 5), ob = (r & 15) * 64 + (c & 31) * 2; return st * 1024 + (ob ^ (((ob >> 9) & 1) << 5)); }
DI void stage_rc8(int b, int& R, int& C) { const int st = b >> 10, sb = b & 1023, swz = sb ^ (((sb >> 9) & 1) << 5); R = (st >> 1) * 16 + (swz >> 6); C = (st & 1) * 32 + ((swz & 63) >> 1); }

DI void gemm8_prestage(const u16* __restrict__ A, const u16* __restrict__ Bt, int K, int brow, int bcol, char* smem) {
  u16* shm = (u16*)smem;
  const int tid = opaque_tid();
  int sr0, sc0, sr1, sc1;
  stage_rc8(tid * 16, sr0, sc0);
  stage_rc8(tid * 16 + 8192, sr1, sc1);
  const unsigned go0 = (unsigned)sr0 * K + sc0, go1 = (unsigned)sr1 * K + sc1;
#define G8P_STAGE(P, BASE, br) do { const u16* g_ = (BASE) + (size_t)(br) * K; \
    __builtin_amdgcn_global_load_lds((const unsigned*)(g_ + go0), (__attribute__((address_space(3))) unsigned*)((char*)(P) + tid * 16), 16, 0, 0); \
    __builtin_amdgcn_global_load_lds((const unsigned*)(g_ + go1), (__attribute__((address_space(3))) unsigned*)((char*)(P) + tid * 16 + 8192), 16, 0, 0); } while (0)
  G8P_STAGE(shm + 4 * G8_HT, Bt, bcol); G8P_STAGE(shm, A, brow);
  G8P_STAGE(shm + 5 * G8_HT, Bt, bcol + 128); G8P_STAGE(shm + G8_HT, A, brow + 128);
#undef G8P_STAGE
}

template <int EPI, bool GSCALE = false>
DI void gemm8_tile(const Params& p, int layer, const u16* __restrict__ A, const u16* __restrict__ Bt, int K, int brow, int bcol, char* smem,
                   bool next_valid, int next_brow, int next_bcol) {
  u16* shm = (u16*)smem;
  const int tid = opaque_tid();
  float* gfac = (float*)(smem + 8 * G8_HT * 2);
  if (GSCALE) {
    if (tid < 256) {
      const float* sq = (const float*)(p.ws + OFF_SSQ) + (size_t)(brow + tid) * 16;
      float rs[4];
#pragma unroll
      for (int g = 0; g < 4; ++g) { const f32x4 s4 = *(const f32x4*)(sq + 4 * g); rs[g] = rsqrtf((s4[0] + s4[1] + s4[2] + s4[3]) * (1.f / 256.f) + EPS); }
      gfac[tid] = rs[0] / rs[1]; gfac[256 + tid] = rs[1] / rs[2]; gfac[512 + tid] = rs[2] / rs[3]; gfac[768 + tid] = rs[3];
    }
  }
  const int wid = tid >> 6, lane = tid & 63, wr = wid >> 2, wc = wid & 3, fr = lane & 15, fq = lane >> 4;
  int sr0, sc0, sr1, sc1;
  stage_rc8(tid * 16, sr0, sc0);
  stage_rc8(tid * 16 + 8192, sr1, sc1);
  const unsigned go0 = (unsigned)sr0 * K + sc0, go1 = (unsigned)sr1 * K + sc1;
#define G8_SA(b, hh) (shm + ((b) * 2 + (hh)) * G8_HT)
#define G8_SB(b, hh) (shm + (4 + (b) * 2 + (hh)) * G8_HT)
#define G8_STAGE(P, BASE, br, kt) do { const u16* g_ = (BASE) + (size_t)(br) * K + (size_t)(kt) * 64; \
    __builtin_amdgcn_global_load_lds((const unsigned*)(g_ + go0), (__attribute__((address_space(3))) unsigned*)((char*)(P) + tid * 16), 16, 0, 0); \
    __builtin_amdgcn_global_load_lds((const unsigned*)(g_ + go1), (__attribute__((address_space(3))) unsigned*)((char*)(P) + tid * 16 + 8192), 16, 0, 0); } while (0)
#define G8_LDA(dst, b, hh) _Pragma("unroll") for (int m = 0; m < 4; ++m) _Pragma("unroll") for (int k = 0; k < 2; ++k) \
    dst[m][k] = *reinterpret_cast<const bf16x8*>((char*)G8_SA(b, hh) + lds_byte8(wr * 64 + m * 16 + fr, k * 32 + fq * 8))
#define G8_LDB(dst, b, hh) _Pragma("unroll") for (int n = 0; n < 2; ++n) _Pragma("unroll") for (int k = 0; k < 2; ++k) \
    dst[n][k] = *reinterpret_cast<const bf16x8*>((char*)G8_SB(b, hh) + lds_byte8(wc * 32 + n * 16 + fr, k * 32 + fq * 8))
#define G8_MMA(ai, bj, At_, Bt_) do { __builtin_amdgcn_s_setprio(1); \
    _Pragma("unroll") for (int m = 0; m < 4; ++m) _Pragma("unroll") for (int n = 0; n < 2; ++n) _Pragma("unroll") for (int k = 0; k < 2; ++k) \
      acc[ai][bj][m][n] = __builtin_amdgcn_mfma_f32_16x16x32_bf16(At_[m][k], Bt_[n][k], acc[ai][bj][m][n], 0, 0, 0); \
    __builtin_amdgcn_s_setprio(0); } while (0)
#define G8_WAIT_V(n) asm volatile("s_waitcnt vmcnt(" #n ")" ::: "memory")
#define G8_WAIT_L(n) asm volatile("s_waitcnt lgkmcnt(" #n ")" ::: "memory")
#define G8_BAR __builtin_amdgcn_s_barrier()
#define G8_SCHED __builtin_amdgcn_sched_barrier(0)
  f32x4v acc[2][2][4][2];
#pragma unroll
  for (int a = 0; a < 2; ++a)
#pragma unroll
    for (int b = 0; b < 2; ++b)
#pragma unroll
      for (int m = 0; m < 4; ++m)
#pragma unroll
        for (int n = 0; n < 2; ++n) acc[a][b][m][n] = (f32x4v){0.f, 0.f, 0.f, 0.f};
  bf16x8 At[4][2], B0[2][2], B1[2][2];
  const int nt = K / 64;
  if (wr == 1) G8_BAR;
  G8_WAIT_V(4); G8_BAR;
  G8_STAGE(G8_SB(1, 0), Bt, bcol, 1); G8_STAGE(G8_SA(1, 0), A, brow, 1); G8_STAGE(G8_SB(1, 1), Bt, bcol + 128, 1);
  G8_WAIT_V(6); G8_BAR;
  for (int t = 0; t < nt - 2; t += 2) {
    G8_LDB(B0, 0, 0); G8_SCHED; G8_LDA(At, 0, 0); G8_STAGE(G8_SA(1, 1), A, brow + 128, t + 1);
    G8_WAIT_L(8); G8_BAR; G8_WAIT_L(0); G8_MMA(0, 0, At, B0); G8_BAR; G8_SCHED;
    G8_LDB(B1, 0, 1); G8_STAGE(G8_SB(0, 0), Bt, bcol, t + 2);
    G8_BAR; G8_WAIT_L(0); G8_MMA(0, 1, At, B1); G8_BAR;
    G8_LDA(At, 0, 1); G8_STAGE(G8_SA(0, 0), A, brow, t + 2);
    G8_BAR; G8_WAIT_L(0); G8_MMA(1, 0, At, B0); G8_BAR; G8_SCHED;
    G8_STAGE(G8_SB(0, 1), Bt, bcol + 128, t + 2);
    G8_WAIT_V(6); G8_BAR; G8_MMA(1, 1, At, B1); G8_BAR;
    G8_LDB(B0, 1, 0); G8_SCHED; G8_LDA(At, 1, 0); G8_STAGE(G8_SA(0, 1), A, brow + 128, t + 2);
    G8_WAIT_L(8); G8_BAR; G8_WAIT_L(0); G8_MMA(0, 0, At, B0); G8_BAR; G8_SCHED;
    G8_LDB(B1, 1, 1); G8_STAGE(G8_SB(1, 0), Bt, bcol, t + 3);
    G8_BAR; G8_WAIT_L(0); G8_MMA(0, 1, At, B1); G8_BAR;
    G8_LDA(At, 1, 1); G8_STAGE(G8_SA(1, 0), A, brow, t + 3);
    G8_BAR; G8_WAIT_L(0); G8_MMA(1, 0, At, B0); G8_BAR; G8_SCHED;
    G8_STAGE(G8_SB(1, 1), Bt, bcol + 128, t + 3);
    G8_WAIT_V(6); G8_BAR; G8_MMA(1, 1, At, B1); G8_BAR;
    if (GSCALE && (t & 3) == 2) {
      const float* gf = gfac + (t >> 2) * 256 + wr * 64 + fq * 4;
#pragma unroll
      for (int ai = 0; ai < 2; ++ai)
#pragma unroll
        for (int m = 0; m < 4; ++m) {
          const f32x4 f4 = *(const f32x4*)(gf + ai * 128 + m * 16);
#pragma unroll
          for (int bj = 0; bj < 2; ++bj)
#pragma unroll
            for (int n = 0; n < 2; ++n)
#pragma unroll
              for (int j = 0; j < 4; ++j) acc[ai][bj][m][n][j] *= f4[j];
        }
    }
  }
  { G8_LDB(B0, 0, 0); G8_LDA(At, 0, 0); G8_STAGE(G8_SA(1, 1), A, brow + 128, nt - 1);
    G8_BAR; G8_WAIT_L(0); G8_MMA(0, 0, At, B0); G8_BAR;
    G8_LDB(B1, 0, 1); G8_BAR; G8_WAIT_L(0); G8_MMA(0, 1, At, B1); G8_BAR;
    G8_LDA(At, 0, 1); G8_WAIT_V(4); G8_BAR; G8_WAIT_L(0); G8_MMA(1, 0, At, B0); G8_MMA(1, 1, At, B1); G8_BAR; }
  { G8_LDB(B0, 1, 0); G8_LDA(At, 1, 0); G8_WAIT_V(2); G8_BAR; G8_WAIT_L(0); G8_MMA(0, 0, At, B0); G8_BAR;
    G8_LDB(B1, 1, 1); G8_WAIT_V(0); G8_BAR; G8_WAIT_L(0); G8_MMA(0, 1, At, B1); G8_BAR;
    G8_LDA(At, 1, 1); G8_BAR; G8_WAIT_L(0); G8_MMA(1, 0, At, B0); G8_MMA(1, 1, At, B1); G8_BAR; }
  if (wr == 0) G8_BAR;
  if (GSCALE) {
    const float* gf = gfac + 768 + wr * 64 + fq * 4;
#pragma unroll
    for (int ai = 0; ai < 2; ++ai)
#pragma unroll
      for (int m = 0; m < 4; ++m) {
        const f32x4 f4 = *(const f32x4*)(gf + ai * 128 + m * 16);
#pragma unroll
        for (int bj = 0; bj < 2; ++bj)
#pragma unroll
          for (int n = 0; n < 2; ++n)
#pragma unroll
            for (int j = 0; j < 4; ++j) acc[ai][bj][m][n][j] *= f4[j];
      }
  }
  if (next_valid) gemm8_prestage(A, Bt, K, next_brow, next_bcol, smem);
  const int wrs = __builtin_amdgcn_readfirstlane(wr), wcs = __builtin_amdgcn_readfirstlane(wc);
  if (EPI == EPI_RES) {
#pragma unroll
    for (int ai = 0; ai < 2; ++ai) {
      const int mrow0 = brow + ai * 128 + wrs * 64;
      const float* xw = (layer == 0 ? (brow < NPROMPT ? p.x_prompt + (size_t)mrow0 * DM : p.x_sample + (size_t)(mrow0 - NPROMPT) * DM) : p.out + (size_t)mrow0 * DM) + bcol + wcs * 32;
      float* ow = p.out + (size_t)mrow0 * DM + bcol + wcs * 32;
      const unsigned lo = (unsigned)(fq * 4) * DM + fr;
      float xv[4][4][4];
#pragma unroll
      for (int m = 0; m < 4; ++m)
#pragma unroll
        for (int j = 0; j < 4; ++j) {
          const float* xr = xw + (lo + (unsigned)((m * 16 + j) * DM));
#pragma unroll
          for (int c = 0; c < 4; ++c) xv[m][j][c] = xr[(c >> 1) * 128 + (c & 1) * 16];
        }
      __builtin_amdgcn_sched_barrier(0);
#pragma unroll
      for (int m = 0; m < 4; ++m)
#pragma unroll
        for (int j = 0; j < 4; ++j) {
          float* orow = ow + (lo + (unsigned)((m * 16 + j) * DM));
#pragma unroll
          for (int c = 0; c < 4; ++c) orow[(c >> 1) * 128 + (c & 1) * 16] = xv[m][j][c] + acc[ai][c >> 1][m][c & 1][j];
        }
      __builtin_amdgcn_sched_barrier(0);
    }
  }
#pragma unroll
  for (int ai = 0; ai < 2 && EPI != EPI_RES; ++ai) {
    const int mrow0 = brow + ai * 128 + wrs * 64;
#pragma unroll
    for (int bj = 0; bj < 2; ++bj) {
      const int ncol0 = bcol + bj * 128 + wcs * 32;
      if (EPI == EPI_SWIGLU) {
        u16* dw = (u16*)(p.ws + OFF_ACT) + (size_t)mrow0 * DFF + (ncol0 >> 1);
        const unsigned lo = (unsigned)(fq * 4) * DFF + fr;
#pragma unroll
        for (int m = 0; m < 4; ++m) {
#pragma unroll
          for (int j = 0; j < 4; ++j) {
            const float g = acc[ai][bj][m][0][j], u = acc[ai][bj][m][1][j];
            const float a = g * __builtin_amdgcn_rcpf(1.f + fexp2(-g * LOG2E)) * u;
            dw[lo + (unsigned)((m * 16 + j) * DFF)] = (u16)(pack2(a, 0.f) & 0xffff);
          }
        }
        __builtin_amdgcn_sched_barrier(0);
      } else if (EPI == EPI_RES) {
      } else {
#pragma unroll
        for (int n = 0; n < 2; ++n) {
          const int nb0 = ncol0 + n * 16;
          if (nb0 < DIN) {
            u16* dw = (u16*)(p.ws + OFF_PROJ) + (size_t)mrow0 * DIN + nb0;
            const unsigned lo = (unsigned)(fq * 4) * DIN + fr;
#pragma unroll
            for (int m = 0; m < 4; ++m)
#pragma unroll
              for (int j = 0; j < 4; ++j) dw[lo + (unsigned)((m * 16 + j) * DIN)] = (u16)(pack2(acc[ai][bj][m][n][j], 0.f) & 0xffff);
          }
          __builtin_amdgcn_sched_barrier(0);
        }
      }
    }
  }
  G8_WAIT_V(0);
  __syncthreads();
}

DI void e1_chunk(const Params& p, int layer, int chunk) {
  const int j = chunk & 7;
  const size_t tok = (size_t)(chunk >> 3) * NTHR + opaque_tid();
  if (j == 7) return;
  u16* proj = (u16*)(p.ws + OFF_PROJ);
  const int t = (int)(tok & 4095);
  if (j < 6) {
    u16* ptr = proj + tok * DIN + (j < 4 ? 768 + 64 * j : 1024 + 64 * (j - 4));
    const float* gain = (j < 4 ? p.b_q_gain : p.b_k_gain) + layer * 64;
    const float post = j < 4 ? QSCALE64 : 1.f;
    float x[64];
    float ss = 0.f;
#pragma unroll
    for (int c = 0; c < 8; ++c) {
      u32x4 w = *(const u32x4*)(ptr + c * 8);
#pragma unroll
      for (int e = 0; e < 4; ++e) { x[c * 8 + 2 * e] = bflo(w[e]); x[c * 8 + 2 * e + 1] = bfhi(w[e]); }
    }
#pragma unroll
    for (int d = 0; d < 64; ++d) ss += x[d] * x[d];
    const float rstd = rsqrtf(ss * (1.f / 64.f) + EPS);
    __builtin_amdgcn_sched_barrier(0);
#pragma unroll
    for (int c = 0; c < 4; ++c) {
#pragma unroll
      for (int d = 0; d < 16; ++d) x[c * 16 + d] = x[c * 16 + d] * rstd * gain[c * 16 + d];
      __builtin_amdgcn_sched_barrier(0);
    }
    const int prow = t >> 6, pcol = t & 63;
    { float* xa = x; float* xb = x + 16; ROPE16(p.ws, prow, xa, xb); }
    __builtin_amdgcn_sched_barrier(0);
    { float* xa = x + 32; float* xb = x + 48; ROPE16(p.ws, pcol, xa, xb); }
    __builtin_amdgcn_sched_barrier(0);
#pragma unroll
    for (int c = 0; c < 8; ++c) {
      u32x4 w;
#pragma unroll
      for (int e = 0; e < 4; ++e) w[e] = pack2(x[c * 8 + 2 * e] * post, x[c * 8 + 2 * e + 1] * post);
      *(u32x4*)(ptr + c * 8) = w;
    }
  } else {
    const u16* src = proj + tok * DIN + 2432;
    float x[32];
#pragma unroll
    for (int c = 0; c < 4; ++c) {
      u32x4 w = *(const u32x4*)(src + c * 8);
#pragma unroll
      for (int e = 0; e < 4; ++e) { x[c * 8 + 2 * e] = bflo(w[e]); x[c * 8 + 2 * e + 1] = bfhi(w[e]); }
    }
    { float* xa = x; float* xb = x + 16; ROPE16(p.ws, t, xa, xb); }
    u16* kd = (u16*)(p.ws + OFF_KD) + tok * 384 + 64;
#pragma unroll
    for (int c = 0; c < 4; ++c) {
      u32x4 w;
#pragma unroll
      for (int e = 0; e < 4; ++e) w[e] = pack2(x[c * 8 + 2 * e], x[c * 8 + 2 * e + 1]);
#pragma unroll
      for (int hh = 0; hh < 4; ++hh) *(u32x4*)(kd + hh * 96 + c * 8) = w;
    }
  }
}

template <int MODE>
DI void attn_tile(const Params& p, int layer, int tile, char* smem) {
  constexpr int DQK = (MODE == 3) ? 96 : 64;
  constexpr int NKQ = DQK / 16;
  constexpr int KROW = DQK + 8;
  constexpr int VROW = 72;
  constexpr int KCH = DQK / 8;
  constexpr int KLD = (64 * KCH + NTHR - 1) / NTHR;
  u16* Ks = (u16*)smem;
  u16* Vs = (u16*)(smem + 26624);
  float* tbl = (float*)(smem + 26624 + 18432);

  const int tid = opaque_tid(), lane = tid & 63, wave = tid >> 6, r = lane & 31, h = lane >> 5;
  const int qb = tile & 15, head = (tile >> 4) & 3, seq = tile >> 6;
  const size_t tok0 = (size_t)seq * SEQ;
  const u16* proj = (const u16*)(p.ws + OFF_PROJ);
  const u16 *Qp, *Kp, *Vp;
  int ldq, ldk, ldv;
  if (MODE == 0) { Qp = proj + 64 * head; Kp = proj + 256 + 64 * head; Vp = proj + 512 + 64 * head; ldq = ldk = ldv = DIN; }
  else if (MODE == 1) { Qp = proj + 768 + 64 * head; Kp = proj + 1024 + 64 * (head >> 1); Vp = proj + 1152 + 64 * (head >> 1); ldq = ldk = ldv = DIN; }
  else if (MODE == 2) { Qp = proj + 1280 + 64 * head; Kp = proj + 1536 + 64 * head; Vp = proj + 1792 + 64 * head; ldq = ldk = ldv = DIN; }
  else { Qp = (const u16*)(p.ws + OFF_QD) + 96 * head; Kp = (const u16*)(p.ws + OFF_KD) + 96 * head; Vp = (const u16*)(p.ws + OFF_VD) + 64 * head; ldq = ldk = 384; ldv = 256; }

  int kt0 = 0, kt1 = 64;
  if (MODE == 0) { kt0 = 4 * qb - 16; if (kt0 < 0) kt0 = 0; kt1 = 4 * qb + 20; if (kt1 > 64) kt1 = 64; }
  if (MODE == 2) { int r0 = 4 * qb - 4; r0 = r0 < 0 ? 0 : (r0 > 56 ? 56 : r0); int r1 = 4 * qb + 3 - 4; r1 = r1 < 0 ? 0 : (r1 > 56 ? 56 : r1); kt0 = r0; kt1 = r1 + 8; }

  if (MODE == 0) { const float* src = (const float*)(p.ws + OFF_TBLA) + head * 2560; for (int i = tid; i < 2560; i += NTHR) tbl[i] = src[i]; }
  if (MODE == 2) { const float* src = p.c_rpb + (size_t)(layer * 4 + head) * 465; for (int i = tid; i < 465; i += NTHR) tbl[i] = src[i] * LOG2E; }

  const int qpos = qb * 256 + wave * 32 + r;
  bf16x8 qf[NKQ];
  {
    const u16* qrow = Qp + (tok0 + qpos) * ldq + 8 * h;
#pragma unroll
    for (int d0 = 0; d0 < NKQ; ++d0) qf[d0] = *(const bf16x8*)(qrow + d0 * 16);
  }
  if (MODE == 3) {
    bf16x8 x1 = qf[NKQ - 2], x2 = qf[NKQ - 1];
    const f32x4* rt = (const f32x4*)(p.ws + OFF_ROPE) + (size_t)qpos * 8 + 4 * h;
#pragma unroll
    for (int j2 = 0; j2 < 4; ++j2) {
      const f32x4 cs4 = rt[j2];
#pragma unroll
      for (int e = 0; e < 2; ++e) {
        const int j = 2 * j2 + e;
        const float c = cs4[2 * e], sn = cs4[2 * e + 1];
        float a = __uint_as_float(((unsigned)(u16)x1[j]) << 16), b = __uint_as_float(((unsigned)(u16)x2[j]) << 16);
        unsigned w = pack2(a * c - b * sn, a * sn + b * c);
        x1[j] = (short)(w & 0xffff); x2[j] = (short)(w >> 16);
      }
    }
    qf[NKQ - 2] = x1; qf[NKQ - 1] = x2;
  }

  u32x4 rk0[KLD], rv0, rk1[KLD], rv1;
  const u16* Kt = Kp + tok0 * ldk;
  const u16* Vt = Vp + tok0 * ldv;
  unsigned koff[KLD];
#pragma unroll
  for (int pp = 0; pp < KLD; ++pp) { int c = tid + NTHR * pp; if (c >= 64 * KCH) c = tid; const int row = c / KCH, col = c % KCH; koff[pp] = (unsigned)row * ldk + col * 8; }
  const unsigned voff = (unsigned)(tid >> 3) * ldv + (tid & 7) * 8;
  const int ktl = kt1 - 1;
  auto gload = [&](u32x4 (&rk)[KLD], u32x4& rv, int kt) {
    kt = kt < ktl ? kt : ktl;
#pragma unroll
    for (int pp = 0; pp < KLD; ++pp) rk[pp] = *(const u32x4*)(Kt + (koff[pp] + (unsigned)(kt * 64) * ldk));
    rv = *(const u32x4*)(Vt + (voff + (unsigned)(kt * 64) * ldv));
  };
  auto lstore = [&](u32x4 (&rk)[KLD], u32x4& rv, int buf) {
#pragma unroll
    for (int pp = 0; pp < KLD; ++pp) { const int c = tid + NTHR * pp; if (c < 64 * KCH) { const int row = c / KCH, col = c % KCH; *(u32x4*)(Ks + (buf * 64 + row) * KROW + col * 8) = rk[pp]; } }
    *(u32x4*)(Vs + (buf * 64 + (tid >> 3)) * VROW + (tid & 7) * 8) = rv;
  };

  f32x16 o0, o1, negm;
#pragma unroll
  for (int i = 0; i < 16; ++i) { o0[i] = 0.f; o1[i] = 0.f; negm[i] = 0.f; }
  float mref = 0.f, lsum = 0.f;
  bool started = false;
  int qr = 0, qc = 0, cs = 0, rs = 0;
  if (MODE == 2) { qr = qpos >> 6; qc = qpos & 63; cs = qc - 8; cs = cs < 0 ? 0 : (cs > 48 ? 48 : cs); rs = qr - 4; rs = rs < 0 ? 0 : (rs > 56 ? 56 : rs); }
  const int i16 = lane & 15, qq = i16 >> 2, pp4 = i16 & 3, g16 = (lane >> 4) & 1;

  auto compute = [&](int buf, int kt) {
    bool active = true;
    if (MODE == 2) active = (kt >= rs) && (kt < rs + 8);
    if (active) {
      const u16* Kb = Ks + buf * 64 * KROW + r * KROW + 8 * h;
      const u16* Vb = Vs + buf * 64 * VROW;
      bf16x8 vf[8];
#pragma unroll
      for (int cs2 = 0; cs2 < 4; ++cs2) {
        const u16* vp = Vb + (16 * cs2 + 4 * h + qq) * VROW + 16 * g16 + 4 * pp4;
        { s16x4 lo = tr_read(vp), hi = tr_read(vp + 8 * VROW); vf[2 * cs2] = __builtin_shufflevector(lo, hi, 0, 1, 2, 3, 4, 5, 6, 7); }
        { s16x4 lo = tr_read(vp + 32), hi = tr_read(vp + 8 * VROW + 32); vf[2 * cs2 + 1] = __builtin_shufflevector(lo, hi, 0, 1, 2, 3, 4, 5, 6, 7); }
      }
      f32x16 s0 = negm, s1 = negm;
#pragma unroll
      for (int d0 = 0; d0 < NKQ; ++d0) {
        bf16x8 k0 = *(const bf16x8*)(Kb + d0 * 16);
        bf16x8 k1 = *(const bf16x8*)(Kb + 32 * KROW + d0 * 16);
        s0 = mfma(k0, qf[d0], s0);
        s1 = mfma(k1, qf[d0], s1);
      }
      if (MODE == 0) {
        const float* tb = tbl + (kt * 64 + 4 * h - qpos + 1280);
#pragma unroll
        for (int i = 0; i < 16; ++i) { s0[i] += tb[(i & 3) + 8 * (i >> 2)]; s1[i] += tb[32 + (i & 3) + 8 * (i >> 2)]; }
      }
      if (MODE == 2) {
        const float* tb = tbl + (kt - qr + 7) * 31 + (15 - qc);
#pragma unroll
        for (int i = 0; i < 16; ++i) {
          const int kc0 = 4 * h + (i & 3) + 8 * (i >> 2), kc1 = kc0 + 32;
          const bool v0 = (kc0 >= cs) && (kc0 < cs + 16), v1 = (kc1 >= cs) && (kc1 < cs + 16);
          const float b0 = tb[v0 ? kc0 : qc], b1 = tb[v1 ? kc1 : qc];
          s0[i] = v0 ? s0[i] + b0 : NEGBIG;
          s1[i] = v1 ? s1[i] + b1 : NEGBIG;
        }
      }
      float ma = __builtin_fmaxf(__builtin_fmaxf(s0[0], s0[1]), s0[2]), mb = __builtin_fmaxf(__builtin_fmaxf(s1[0], s1[1]), s1[2]);
#pragma unroll
      for (int i = 3; i < 15; i += 2) { ma = __builtin_fmaxf(__builtin_fmaxf(ma, s0[i]), s0[i + 1]); mb = __builtin_fmaxf(__builtin_fmaxf(mb, s1[i]), s1[i + 1]); }
      float mt = __builtin_fmaxf(__builtin_fmaxf(ma, s0[15]), s1[15]);
      mt = hmax(__builtin_fmaxf(mt, mb));
      const bool fresh = !started && (mt > -1e29f);
      if (__any(fresh || (started && mt > 8.f))) {
        float delta = 0.f, al = 1.f;
        if (fresh) { delta = mt; started = true; }
        else if (started) { delta = __builtin_fmaxf(mt, 0.f); al = fexp2(-delta); }
        mref += delta;
        lsum *= al;
#pragma unroll
        for (int i = 0; i < 16; ++i) { o0[i] *= al; o1[i] *= al; s0[i] -= delta; s1[i] -= delta; negm[i] = -mref; }
      }
      float ps = 0.f;
#pragma unroll
      for (int i = 0; i < 16; ++i) { s0[i] = fexp2(s0[i]); s1[i] = fexp2(s1[i]); ps += s0[i] + s1[i]; }
      lsum += ps;
#pragma unroll
      for (int c = 0; c < 2; ++c) {
#pragma unroll
        for (int s = 0; s < 2; ++s) {
          u32x4 pw;
          if (c == 0) pw = (u32x4){pack2(s0[8 * s], s0[8 * s + 1]), pack2(s0[8 * s + 2], s0[8 * s + 3]), pack2(s0[8 * s + 4], s0[8 * s + 5]), pack2(s0[8 * s + 6], s0[8 * s + 7])};
          else pw = (u32x4){pack2(s1[8 * s], s1[8 * s + 1]), pack2(s1[8 * s + 2], s1[8 * s + 3]), pack2(s1[8 * s + 4], s1[8 * s + 5]), pack2(s1[8 * s + 6], s1[8 * s + 7])};
          const bf16x8 pf = __builtin_bit_cast(bf16x8, pw);
          o0 = mfma(vf[2 * (2 * c + s)], pf, o0);
          o1 = mfma(vf[2 * (2 * c + s) + 1], pf, o1);
        }
      }
    }
  };

  const int ntile = kt1 - kt0;
  gload(rk0, rv0, kt0);
  lstore(rk0, rv0, 0);
  gload(rk0, rv0, kt0 + 1);
  gload(rk1, rv1, kt0 + 2);
  __syncthreads();
  for (int j = 0; j < ntile; j += 2) {
    compute(0, kt0 + j);
    lstore(rk0, rv0, 1);
    gload(rk0, rv0, kt0 + j + 3);
    __syncthreads();
    if (j + 1 >= ntile) break;
    compute(1, kt0 + j + 1);
    lstore(rk1, rv1, 0);
    gload(rk1, rv1, kt0 + j + 4);
    __syncthreads();
  }
  lsum = hsum(lsum);
  const float inv = 1.f / lsum;
  float sq = 0.f;
#pragma unroll
  for (int i = 0; i < 16; ++i) { o0[i] *= inv; o1[i] *= inv; sq += o0[i] * o0[i] + o1[i] * o1[i]; }
  sq = hsum(sq);
  if (h == 0) ((float*)(p.ws + OFF_SSQ))[(tok0 + qpos) * 16 + MODE * 4 + head] = sq;
  u16* op = (u16*)(p.ws + OFF_ACTB) + (tok0 + qpos) * DM + MODE * 256 + head * 64 + 4 * h;
#pragma unroll
  for (int g4 = 0; g4 < 4; ++g4) {
    u32x2 w0 = {pack2(o0[4 * g4], o0[4 * g4 + 1]), pack2(o0[4 * g4 + 2], o0[4 * g4 + 3])};
    u32x2 w1 = {pack2(o1[4 * g4], o1[4 * g4 + 1]), pack2(o1[4 * g4 + 2], o1[4 * g4 + 3])};
    *(u32x2*)(op + 8 * g4) = w0;
    *(u32x2*)(op + 32 + 8 * g4) = w1;
  }
}


DI bool sb_tile(int bid, int nb, int it, int NT, int& mt, int& nt) {
  const int G = nb >> 3, x = bid & 7, l = bid >> 3;
  const int s = l + it * G;
  const int sb = (s >> 5) * 8 + x, w = s & 31;
  if (NT == 4) {
    if (sb >= 48) return false;
    mt = sb * 8 + (w >> 2); nt = w & 3;
    return true;
  }
  const int NG = NT >> 1;
  if (sb >= 24 * NG) return false;
  const int mg = sb / NG, ng = sb - mg * NG;
  mt = mg * 16 + (w >> 1); nt = ng * 2 + (w & 1);
  return true;
}

DI bool att_tile_index(int bid, int nb, int it, int& tile) {
  if (nb != 256) { tile = bid + it * nb; return tile < 1536; }
  const int x = bid & 7, l = bid >> 3;
  const int pair = 2 * (it * 8 + x) + (l >> 4);
  tile = pair * 16 + ((l + 3 * it) & 15);
  return pair < 96;
}

template <int EPI, bool GSCALE = false>
DI void gemm8_phase(const Params& p, int layer, const u16* A, const u16* Bt, int K, int NT, char* smem) {
  const int bid = blockIdx.x, nb = gridDim.x;
  int mt, nt;
  bool have = sb_tile(bid, nb, 0, NT, mt, nt);
  if (have) gemm8_prestage(A, Bt, K, mt * 256, nt * 256, smem);
  for (int it = 0; have; ++it) {
    int mt2 = 0, nt2 = 0;
    const bool have2 = sb_tile(bid, nb, it + 1, NT, mt2, nt2);
    gemm8_tile<EPI, GSCALE>(p, layer, A, Bt, K, mt * 256, nt * 256, smem, have2, mt2 * 256, nt2 * 256);
    have = have2; mt = mt2; nt = nt2;
  }
}

constexpr int NPHASE = 17;
constexpr int MT = T_TOK / 256;

DI void run_phase(const Params& p, int ph, char* smem) {
  const int bid = blockIdx.x, nb = gridDim.x;
  u16* wtb = (u16*)(p.ws + OFF_WT);
  const u16* actb = (const u16*)(p.ws + OFF_ACTB);
  if (ph == 0) {
    for (int j = bid; j < 128; j += nb) rope_tab_build(p.ws, j * NTHR + opaque_tid());
    for (int j = bid; j < WJ_TOTAL; j += nb) wprep_job(p, j, smem);
    for (int rb = bid; rb < T_TOK / 8; rb += nb) norm_rows(p, 0, rb, 0);
    return;
  }
  if (ph == 16) { for (int rb = bid; rb < T_TOK / 8; rb += nb) norm_rows(p, 1, rb, 1); return; }
  const int layer = (ph - 1) >> 3, sub = (ph - 1) & 7;
  const u16* wl = wtb + (size_t)layer * WT_LAYER;
  switch (sub) {
    case 0:
      gemm8_phase<EPI_PROJ>(p, layer, actb, wl + WT_IN, 1024, 10, smem);
      break;
    case 1:
      for (int c = bid; c < (T_TOK / NTHR) * 8; c += nb) e1_chunk(p, layer, c);
      for (int t = bid; t < MT * 2; t += nb) { const int nt = t & 1, mt = t >> 1; gemm_tile<EPI_UQ, false, true>(p, layer, (const u16*)(p.ws + OFF_PROJ) + 2048, DIN, wl + WT_UQ, 256, mt * 256, nt * 256, smem); }
      for (int t = bid; t < MT * 2; t += nb) { const int nt = t & 1, mt = t >> 1; gemm_tile<EPI_UKV, false, true>(p, layer, (const u16*)(p.ws + OFF_PROJ) + 2304, DIN, wl + WT_UKV, 128, mt * 256, nt * 256, smem); }
      break;
    case 2:
      for (int it = 0, t; att_tile_index(bid, nb, it, t); ++it) attn_tile<3>(p, layer, t, smem);
      for (int it = 0, t; att_tile_index(bid, nb, it, t); ++it) attn_tile<1>(p, layer, t, smem);
      for (int it = 0, t; att_tile_index(bid, nb, it, t); ++it) attn_tile<0>(p, layer, t, smem);
      for (int it = 0, t; att_tile_index(bid, nb, it, t); ++it) attn_tile<2>(p, layer, t, smem);
      break;
    case 3:
      gemm8_phase<EPI_RES, true>(p, layer, actb, wl + WT_OUT, 1024, 4, smem);
      break;
    case 4:
      for (int rb = bid; rb < T_TOK / 8; rb += nb) norm_rows(p, 1, rb, 0);
      break;
    case 5:
      gemm8_phase<EPI_SWIGLU>(p, layer, actb, wl + WT_GU, 1024, 22, smem);
      break;
    case 6:
      gemm8_phase<EPI_RES>(p, 1, (const u16*)(p.ws + OFF_ACT), wl + WT_DN, DFF, 4, smem);
      break;
    case 7:
      for (int rb = bid; rb < T_TOK / 8; rb += nb) norm_rows(p, 1, rb, 0);
      break;
  }
}

__global__ void __launch_bounds__(NTHR, 2) mega(Params p, int ph_lo, int ph_hi) {
  __shared__ __attribute__((aligned(16))) char smem[SMEM_BYTES];
  cg::grid_group grid = cg::this_grid();
  for (int ph = ph_lo; ph < ph_hi; ++ph) {
    if (ph > ph_lo) grid.sync();
    run_phase(p, ph, smem);
#ifdef DUPMASK
    if (ph >= 1 && ph < 16 && ((DUPMASK >> ((ph - 1) & 7)) & 1)) { grid.sync(); run_phase(p, ph, smem); }
#endif
  }
}

extern "C" void kernel_launch(void* const* d_in, const int* in_sizes, int n_in, void* d_out, int out_size, void* d_ws, size_t ws_size, hipStream_t stream) {
  Params p{};
  p.x_prompt = (const float*)d_in[0]; p.x_sample = (const float*)d_in[1]; p.t5_bias = (const float*)d_in[2]; p.norm_mix = (const float*)d_in[3];
  p.w_in = (const float*)d_in[4]; p.b_q_gain = (const float*)d_in[5]; p.b_k_gain = (const float*)d_in[6]; p.c_rpb = (const float*)d_in[7];
  p.d_q_gain = (const float*)d_in[8]; p.d_w_uq = (const float*)d_in[9]; p.d_kv_gain = (const float*)d_in[10]; p.d_w_ukv = (const float*)d_in[11];
  p.out_gain = (const float*)d_in[12]; p.w_out = (const float*)d_in[13]; p.norm_ffn = (const float*)d_in[14]; p.w_gate = (const float*)d_in[15];
  p.w_up = (const float*)d_in[16]; p.w_down = (const float*)d_in[17]; p.final_norm = (const float*)d_in[18];
  p.out = (float*)d_out; p.ws = (char*)d_ws;
  if (ws_size < WS_NEED) { fprintf(stderr, "workspace too small: %zu < %zu\n", ws_size, (size_t)WS_NEED); return; }
  static int grid_blocks = 0;
  if (!grid_blocks) {
    int dev = 0, cus = 0, per_cu = 0;
    hipGetDevice(&dev);
    hipDeviceGetAttribute(&cus, hipDeviceAttributeMultiprocessorCount, dev);
    hipOccupancyMaxActiveBlocksPerMultiprocessor(&per_cu, mega, NTHR, 0);
    if (per_cu < 1) per_cu = 1;
    if (per_cu > 1) per_cu = 1;
    grid_blocks = cus * per_cu;
  }
#if ONE_LAUNCH
  int lo = 0, hi = NPHASE;
  void* args[] = {&p, &lo, &hi};
  hipError_t e = hipLaunchCooperativeKernel((void*)mega, dim3(grid_blocks), dim3(NTHR), args, 0, stream);
  if (e != hipSuccess) fprintf(stderr, "cooperative launch failed: %s (grid %d)\n", hipGetErrorString(e), grid_blocks);
#else
  for (int ph = 0; ph < NPHASE; ++ph) hipLaunchKernelGGL(mega, dim3(grid_blocks), dim3(NTHR), 0, stream, p, ph, ph + 1);
#endif
}
```

```cpp
#include <hip/hip_runtime.h>
#include <hip/hip_cooperative_groups.h>
#include <cstdio>
#include <cstdint>
namespace cg = cooperative_groups;

#ifndef ONE_LAUNCH
#define ONE_LAUNCH 1
#endif

#define DI __device__ __forceinline__
typedef short bf16x8 __attribute__((ext_vector_type(8)));
typedef short s16x4 __attribute__((ext_vector_type(4)));
typedef float f32x16 __attribute__((ext_vector_type(16)));
typedef float f32x4 __attribute__((ext_vector_type(4)));
typedef float f32x2 __attribute__((ext_vector_type(2)));
typedef unsigned u32x4 __attribute__((ext_vector_type(4)));
typedef unsigned u32x2 __attribute__((ext_vector_type(2)));
typedef __bf16 bf16v2 __attribute__((ext_vector_type(2)));
typedef unsigned short u16;

constexpr int T_TOK = 98304, SEQ = 4096, DM = 1024, DIN = 2464, DINP = 2560, DFF = 2816;
constexpr int NPROMPT = 8 * 4096;
constexpr int NTHR = 512;
constexpr float LOG2E = 1.4426950408889634f;
constexpr float QSCALE64 = 0.125f * LOG2E;
constexpr float QSCALE96 = 0.10206207261596575f * LOG2E;
constexpr float NEGBIG = -1e30f;
constexpr float EPS = 1e-6f;

constexpr size_t al256(size_t x) { return (x + 255) & ~(size_t)255; }
constexpr size_t WT_IN = 0;
constexpr size_t WT_UQ = WT_IN + (size_t)DINP * 1024;
constexpr size_t WT_UKV = WT_UQ + 512 * 256;
constexpr size_t WT_OUT = WT_UKV + 512 * 128;
constexpr size_t WT_GU = WT_OUT + 1024 * 1024;
constexpr size_t WT_DN = WT_GU + (size_t)5632 * 1024;
constexpr size_t WT_LAYER = WT_DN + (size_t)1024 * 2816;
constexpr size_t OFF_WT = 0;
constexpr size_t OFF_TBLA = al256(OFF_WT + 2 * WT_LAYER * 2);
constexpr size_t OFF_ROPE = al256(OFF_TBLA + 4 * 2560 * 4);
constexpr size_t OFF_ACTB = al256(OFF_ROPE + 4096 * 16 * 8);
constexpr size_t OFF_PROJ = al256(OFF_ACTB + (size_t)T_TOK * 1024 * 2);
constexpr size_t OFF_QD = al256(OFF_PROJ + (size_t)T_TOK * DIN * 2);
constexpr size_t OFF_KD = al256(OFF_QD + (size_t)T_TOK * 384 * 2);
constexpr size_t OFF_VD = al256(OFF_KD + (size_t)T_TOK * 384 * 2);
constexpr size_t OFF_SSQ = al256(OFF_VD + (size_t)T_TOK * 256 * 2);
constexpr size_t WS_NEED = al256(OFF_SSQ + (size_t)T_TOK * 16 * 4);
constexpr size_t OFF_ACT = OFF_PROJ;
static_assert(OFF_ACT + (size_t)T_TOK * DFF * 2 <= OFF_KD, "act alias overflow");

struct Params {
  const float *x_prompt, *x_sample, *t5_bias, *norm_mix, *w_in, *b_q_gain, *b_k_gain, *c_rpb, *d_q_gain, *d_w_uq,
      *d_kv_gain, *d_w_ukv, *out_gain, *w_out, *norm_ffn, *w_gate, *w_up, *w_down, *final_norm;
  float* out;
  char* ws;
};

constexpr int SMEM_BYTES = 2 * (256 + 256) * 72 * 2 + 1024;

DI unsigned pack2(float a, float b) { f32x2 v = {a, b}; bf16v2 r = __builtin_convertvector(v, bf16v2); return __builtin_bit_cast(unsigned, r); }
DI float bflo(unsigned w) { return __uint_as_float(w << 16); }
DI float bfhi(unsigned w) { return __uint_as_float(w & 0xffff0000u); }
DI f32x16 mfma(bf16x8 a, bf16x8 b, f32x16 c) { return __builtin_amdgcn_mfma_f32_32x32x16_bf16(a, b, c, 0, 0, 0); }
DI float hmax(float v) {
  auto rr = __builtin_amdgcn_permlane32_swap(__float_as_uint(v), __float_as_uint(v), false, false);
  return __builtin_fmaxf(__uint_as_float(rr[0]), __uint_as_float(rr[1]));
}
DI float hsum(float v) {
  auto rr = __builtin_amdgcn_permlane32_swap(__float_as_uint(v), __float_as_uint(v), false, false);
  return __uint_as_float(rr[0]) + __uint_as_float(rr[1]);
}
DI float fexp2(float x) { return __builtin_amdgcn_exp2f(x); }
DI int crow(int i, int h) { return (i & 3) + 8 * (i >> 2) + 4 * h; }
typedef short v4i16_t __attribute__((ext_vector_type(4)));
DI s16x4 tr_read(const u16* p) {
  return __builtin_bit_cast(s16x4, __builtin_amdgcn_ds_read_tr16_b64_v4i16((__attribute__((address_space(3))) v4i16_t*)p));
}
constexpr double inv_rev_c(int i) {
  constexpr double b[4] = {1.0, 0.5623413251903491, 0.31622776601683794, 0.1778279410038923};
  double v = b[i & 3];
  for (int k = 0; k < (i >> 2); ++k) v *= 0.1;
  return v * 0.15915494309189535;
}
DI void rope_tab_build(char* ws, int idx) {
  const int pos = idx >> 4, i = idx & 15;
  double invrev = inv_rev_c(0);
#pragma unroll
  for (int k = 1; k < 16; ++k) if (i == k) invrev = inv_rev_c(k);
  double rev = (double)pos * invrev;
  float f = (float)(rev - (double)(int)rev);
  f32x2 cs = {__builtin_amdgcn_cosf(f), __builtin_amdgcn_sinf(f)};
  ((f32x2*)(ws + OFF_ROPE))[idx] = cs;
}
#define ROPE16(ws_, pos_, A_, B_)                                                              \
  {                                                                                            \
    const f32x4* rt_ = (const f32x4*)((ws_) + OFF_ROPE) + (size_t)(pos_) * 8;                  \
    _Pragma("unroll") for (int i2_ = 0; i2_ < 8; ++i2_) {                                      \
      const f32x4 cs_ = rt_[i2_];                                                              \
      float a_ = A_[2 * i2_], b_ = B_[2 * i2_];                                                \
      A_[2 * i2_] = a_ * cs_[0] - b_ * cs_[1]; B_[2 * i2_] = a_ * cs_[1] + b_ * cs_[0];        \
      a_ = A_[2 * i2_ + 1]; b_ = B_[2 * i2_ + 1];                                              \
      A_[2 * i2_ + 1] = a_ * cs_[2] - b_ * cs_[3]; B_[2 * i2_ + 1] = a_ * cs_[3] + b_ * cs_[2]; \
    }                                                                                          \
  }
DI const float* xrow(const Params& p, int layer, size_t tok) {
  if (layer == 0) return tok < (size_t)NPROMPT ? p.x_prompt + tok * DM : p.x_sample + (tok - NPROMPT) * DM;
  return p.out + tok * DM;
}

DI int opaque_tid() { int t = threadIdx.x; asm volatile("" : "+v"(t)); return t; }
DI void wt_tile(const float* __restrict__ W, int K, int N, const float* __restrict__ g, u16* __restrict__ Wt, int k0, int n0, int mapmode, float* tile) {
  const int tid = opaque_tid();
  for (int i = tid; i < 4096; i += NTHR) {
    int kk = i >> 6, nn = i & 63, n = n0 + nn;
    float v = 0.f;
    if (n < N) { v = W[(size_t)(k0 + kk) * N + n]; if (g) v *= g[k0 + kk]; }
    tile[kk * 65 + nn] = v;
  }
  __syncthreads();
  for (int i = tid; i < 2048; i += NTHR) {
    int nn = i >> 5, kp = i & 31, n = n0 + nn;
    float cs = 1.f; int drow = n;
    if (mapmode == 1) { if (n < 256 || (n >= 1280 && n < 1536)) cs = QSCALE64; }
    else if (mapmode == 2) cs = QSCALE96;
    else if (mapmode == 3) drow = 32 * (n >> 4) + (n & 15);
    else if (mapmode == 4) drow = 32 * (n >> 4) + 16 + (n & 15);
    unsigned w = pack2(tile[(2 * kp) * 65 + nn] * cs, tile[(2 * kp + 1) * 65 + nn] * cs);
    *(unsigned*)(Wt + (size_t)drow * K + k0 + 2 * kp) = w;
  }
  __syncthreads();
}

constexpr int WJ_IN = 640, WJ_UQ = 32, WJ_UKV = 16, WJ_OUT = 256, WJ_G = 704, WJ_U = 704, WJ_D = 704;
constexpr int WJ_LAYER = WJ_IN + WJ_UQ + WJ_UKV + WJ_OUT + WJ_G + WJ_U + WJ_D;
constexpr int WJ_TOTAL = 2 * WJ_LAYER + 20;

DI void wprep_job(const Params& p, int job, char* smem) {
  float* tile = (float*)smem;
  u16* wtb = (u16*)(p.ws + OFF_WT);
  if (job >= 2 * WJ_LAYER) {
    int idx = (job - 2 * WJ_LAYER) * NTHR + opaque_tid();
    int head = idx / 2560, e = idx % 2560, d = e - 1280, n = d < 0 ? -d : d;
    int mult = (n <= 64 ? 1 : 0) + (((n & 3) == 0 && n <= 256) ? 1 : 0) + (((n & 15) == 0 && n <= 1024) ? 1 : 0);
    float v = NEGBIG;
    if (mult > 0) {
      int bk;
      if (n < 8) bk = n;
      else { float nf = (float)n; int lg = 8 + (int)(__logf(nf * 0.125f) / 4.852030263919617f * 8.0f); bk = lg < 15 ? lg : 15; }
      if (d > 0) bk += 16;
      v = (p.t5_bias[bk * 4 + head] + __logf((float)mult)) * LOG2E;
    }
    ((float*)(p.ws + OFF_TBLA))[idx] = v;
    return;
  }
  int layer = job / WJ_LAYER, j = job % WJ_LAYER;
  u16* wl = wtb + (size_t)layer * WT_LAYER;
  if (j < WJ_IN) { int kt = j & 15, nt = j >> 4; wt_tile(p.w_in + (size_t)layer * 1024 * DIN, 1024, DIN, p.norm_mix + layer * 1024, wl + WT_IN, kt * 64, nt * 64, 1, tile); return; }
  j -= WJ_IN;
  if (j < WJ_UQ) { int kt = j & 3, nt = j >> 2; wt_tile(p.d_w_uq + (size_t)layer * 256 * 384, 256, 384, p.d_q_gain + layer * 256, wl + WT_UQ, kt * 64, nt * 64, 2, tile); return; }
  j -= WJ_UQ;
  if (j < WJ_UKV) { int kt = j & 1, nt = j >> 1; wt_tile(p.d_w_ukv + (size_t)layer * 128 * 512, 128, 512, p.d_kv_gain + layer * 128, wl + WT_UKV, kt * 64, nt * 64, 0, tile); return; }
  j -= WJ_UKV;
  if (j < WJ_OUT) { int kt = j & 15, nt = j >> 4; wt_tile(p.w_out + (size_t)layer * 1024 * 1024, 1024, 1024, p.out_gain + layer * 1024, wl + WT_OUT, kt * 64, nt * 64, 0, tile); return; }
  j -= WJ_OUT;
  if (j < WJ_G) { int kt = j & 15, nt = j >> 4; wt_tile(p.w_gate + (size_t)layer * 1024 * DFF, 1024, DFF, p.norm_ffn + layer * 1024, wl + WT_GU, kt * 64, nt * 64, 3, tile); return; }
  j -= WJ_G;
  if (j < WJ_U) { int kt = j & 15, nt = j >> 4; wt_tile(p.w_up + (size_t)layer * 1024 * DFF, 1024, DFF, p.norm_ffn + layer * 1024, wl + WT_GU, kt * 64, nt * 64, 4, tile); return; }
  j -= WJ_U;
  { int kt = j % 44, nt = j / 44; wt_tile(p.w_down + (size_t)layer * DFF * 1024, DFF, 1024, nullptr, wl + WT_DN, kt * 64, nt * 64, 0, tile); }
}

DI void norm_rows(const Params& p, int layer, int rb, int mode) {
  const int tid = opaque_tid();
  const int lane = tid & 63, wave = tid >> 6;
  const size_t row = (size_t)rb * 8 + wave;
  const float* src = xrow(p, layer, row);
  f32x4 v[4];
  float ss = 0.f;
#pragma unroll
  for (int i = 0; i < 4; ++i) { v[i] = __builtin_nontemporal_load((const f32x4*)(src + lane * 4 + 256 * i)); ss += v[i][0] * v[i][0] + v[i][1] * v[i][1] + v[i][2] * v[i][2] + v[i][3] * v[i][3]; }
#pragma unroll
  for (int o = 1; o < 64; o <<= 1) ss += __shfl_xor(ss, o);
  const float rstd = rsqrtf(ss * (1.f / 1024.f) + EPS);
  if (mode == 0) {
    u16* dst = (u16*)(p.ws + OFF_ACTB) + row * DM;
#pragma unroll
    for (int i = 0; i < 4; ++i) { u32x2 w = {pack2(v[i][0] * rstd, v[i][1] * rstd), pack2(v[i][2] * rstd, v[i][3] * rstd)}; *(u32x2*)(dst + lane * 4 + 256 * i) = w; }
  } else {
    float* dst = p.out + row * DM;
#pragma unroll
    for (int i = 0; i < 4; ++i) { f32x4 g = *(const f32x4*)(p.final_norm + lane * 4 + 256 * i); f32x4 o = {v[i][0] * rstd * g[0], v[i][1] * rstd * g[1], v[i][2] * rstd * g[2], v[i][3] * rstd * g[3]}; __builtin_nontemporal_store(o, (f32x4*)(dst + lane * 4 + 256 * i)); }
  }
}

enum { EPI_PROJ = 0, EPI_UQ = 1, EPI_UKV = 2, EPI_RES = 3, EPI_SWIGLU = 4 };
constexpr int GS = 72;
constexpr int BM = 256;
constexpr int TMW = 4;

template <int EPI, bool ASCALE, bool ROWNORM>
DI void gemm_tile(const Params& p, int layer, const u16* __restrict__ A, int lda, const u16* __restrict__ Wt, int K, int m0, int n0, char* smem) {
  u16* As = (u16*)smem;
  u16* Bs = As + 2 * BM * GS;
  float* rowscale = (float*)(Bs + 2 * 256 * GS);
  const int tid = opaque_tid(), lane = tid & 63, wave = tid >> 6, r = lane & 31, h = lane >> 5;
  const int wm = wave >> 2, wn = wave & 3;
  const int lrow = tid >> 3, kc = tid & 7;
  const u16* At = A + (size_t)m0 * lda;
  const u16* Bt = Wt + (size_t)n0 * K;
  const unsigned aoff = (unsigned)lrow * lda + kc * 8, boff = (unsigned)lrow * K + kc * 8;
  const float* ssq = (const float*)(p.ws + OFF_SSQ);

  if (ROWNORM) {
    const int rr = tid >> 1, half = tid & 1;
    const u16* src = A + (size_t)(m0 + rr) * lda + half * (K / 2);
    float ss = 0.f;
    for (int i = 0; i < K / 16; ++i) {
      u32x4 w = *(const u32x4*)(src + i * 8);
#pragma unroll
      for (int e = 0; e < 4; ++e) { float a = bflo(w[e]), b = bfhi(w[e]); ss += a * a + b * b; }
    }
    ss += __shfl_xor(ss, 1);
    if (half == 0) rowscale[rr] = rsqrtf(ss / (float)K + EPS);
  }

  f32x16 acc[TMW][2];
#pragma unroll
  for (int a = 0; a < TMW; ++a)
#pragma unroll
    for (int b = 0; b < 2; ++b)
#pragma unroll
      for (int i = 0; i < 16; ++i) acc[a][b][i] = 0.f;

  u32x4 ra[4], rb[4];
  float sc[4] = {1.f, 1.f, 1.f, 1.f};
  const int KT = K / 64;
  auto gload = [&](int kt) {
#pragma unroll
    for (int pp = 0; pp < 4; ++pp) ra[pp] = *(const u32x4*)(At + (size_t)(64 * pp) * lda + (aoff + (unsigned)kt * 64));
#pragma unroll
    for (int pp = 0; pp < 4; ++pp) rb[pp] = *(const u32x4*)(Bt + (size_t)(64 * pp) * K + (boff + (unsigned)kt * 64));
  };
  auto lstore = [&](int buf, int kt) {
    if (ASCALE) {
      if ((kt & 3) == 0) {
        const int g = kt >> 2;
#pragma unroll
        for (int pp = 0; pp < 4; ++pp) {
          f32x4 s4 = *(const f32x4*)(ssq + (size_t)(m0 + lrow + 64 * pp) * 16 + 4 * g);
          sc[pp] = rsqrtf((s4[0] + s4[1] + s4[2] + s4[3]) * (1.f / 256.f) + EPS);
        }
      }
#pragma unroll
      for (int pp = 0; pp < 4; ++pp)
#pragma unroll
        for (int e = 0; e < 4; ++e) ra[pp][e] = pack2(bflo(ra[pp][e]) * sc[pp], bfhi(ra[pp][e]) * sc[pp]);
    }
#pragma unroll
    for (int pp = 0; pp < 4; ++pp) *(u32x4*)(As + (buf * BM + lrow + 64 * pp) * GS + kc * 8) = ra[pp];
#pragma unroll
    for (int pp = 0; pp < 4; ++pp) *(u32x4*)(Bs + (buf * 256 + lrow + 64 * pp) * GS + kc * 8) = rb[pp];
  };
  auto compute = [&](int buf) {
    const u16* Ab = As + (buf * BM + wm * 128 + r) * GS + 8 * h;
    const u16* Bb = Bs + (buf * 256 + wn * 64 + r) * GS + 8 * h;
#pragma unroll
    for (int ks = 0; ks < 4; ++ks) {
      bf16x8 b0 = *(const bf16x8*)(Bb + ks * 16);
      bf16x8 b1 = *(const bf16x8*)(Bb + 32 * GS + ks * 16);
#pragma unroll
      for (int tm = 0; tm < TMW; ++tm) {
        bf16x8 a = *(const bf16x8*)(Ab + tm * 32 * GS + ks * 16);
        acc[tm][0] = mfma(a, b0, acc[tm][0]);
        acc[tm][1] = mfma(a, b1, acc[tm][1]);
      }
    }
  };
  gload(0);
  lstore(0, 0);
  if (KT > 1) gload(1);
  __syncthreads();
  for (int kt = 0; kt < KT; ++kt) {
    compute(kt & 1);
    if (kt + 1 < KT) lstore((kt + 1) & 1, kt + 1);
    if (kt + 2 < KT) gload(kt + 2);
    __syncthreads();
  }

  const int wms = __builtin_amdgcn_readfirstlane(wm), wns = __builtin_amdgcn_readfirstlane(wn);
  const int mrow0 = m0 + wms * 128;
  const int nwb = n0 + wns * 64;
  if (ROWNORM) {
#pragma unroll
    for (int tm = 0; tm < TMW; ++tm) {
#pragma unroll
      for (int i = 0; i < 16; ++i) {
        const float rs = rowscale[wms * 128 + 4 * h + 32 * tm + (i & 3) + 8 * (i >> 2)];
        acc[tm][0][i] *= rs; acc[tm][1][i] *= rs;
      }
    }
  }
  if (EPI == EPI_SWIGLU) {
    u16* dw = (u16*)(p.ws + OFF_ACT) + (size_t)mrow0 * DFF + (nwb >> 1);
    const unsigned lo = (unsigned)(4 * h) * DFF + r;
#pragma unroll
    for (int tm = 0; tm < TMW; ++tm) {
#pragma unroll
      for (int i = 0; i < 16; ++i) {
        const float g = acc[tm][0][i], u = acc[tm][1][i];
        const float a = g * __builtin_amdgcn_rcpf(1.f + fexp2(-g * LOG2E)) * u;
        dw[lo + (unsigned)((32 * tm + (i & 3) + 8 * (i >> 2)) * DFF)] = (u16)(pack2(a, 0.f) & 0xffff);
      }
      __builtin_amdgcn_sched_barrier(0);
    }
  } else {
#pragma unroll
    for (int tn = 0; tn < 2; ++tn) {
      const int nb0 = nwb + 32 * tn;
      if (EPI == EPI_RES) {
        const float* xw = (layer == 0 ? (m0 < NPROMPT ? p.x_prompt + (size_t)mrow0 * DM : p.x_sample + (size_t)(mrow0 - NPROMPT) * DM) : p.out + (size_t)mrow0 * DM) + nb0;
        float* ow = p.out + (size_t)mrow0 * DM + nb0;
        const unsigned lo = (unsigned)(4 * h) * DM + r;
#pragma unroll
        for (int tm = 0; tm < TMW; ++tm) {
#pragma unroll
          for (int g4 = 0; g4 < 4; ++g4) {
            float xv[4];
#pragma unroll
            for (int e = 0; e < 4; ++e) xv[e] = xw[lo + (unsigned)((32 * tm + 8 * g4 + e) * DM)];
#pragma unroll
            for (int e = 0; e < 4; ++e) ow[lo + (unsigned)((32 * tm + 8 * g4 + e) * DM)] = xv[e] + acc[tm][tn][4 * g4 + e];
          }
          __builtin_amdgcn_sched_barrier(0);
        }
      } else {
        u16* dw; int ld; bool ok = true;
        if (EPI == EPI_PROJ) { dw = (u16*)(p.ws + OFF_PROJ) + (size_t)mrow0 * DIN + nb0; ld = DIN; ok = (nb0 + r) < DIN; }
        else if (EPI == EPI_UQ) { dw = (u16*)(p.ws + OFF_QD) + (size_t)mrow0 * 384 + nb0; ld = 384; ok = nb0 < 384; }
        else {
          const int head = nb0 >> 7, w = nb0 & 127;
          if (w < 64) { dw = (u16*)(p.ws + OFF_KD) + (size_t)mrow0 * 384 + head * 96 + w; ld = 384; }
          else { dw = (u16*)(p.ws + OFF_VD) + (size_t)mrow0 * 256 + head * 64 + (w - 64); ld = 256; }
        }
        const unsigned lo = (unsigned)(4 * h) * ld + r;
        if (ok) {
#pragma unroll
          for (int tm = 0; tm < TMW; ++tm) {
#pragma unroll
            for (int i = 0; i < 16; ++i) dw[lo + (unsigned)((32 * tm + (i & 3) + 8 * (i >> 2)) * ld)] = (u16)(pack2(acc[tm][tn][i], 0.f) & 0xffff);
            __builtin_amdgcn_sched_barrier(0);
          }
        }
      }
    }
  }
  if (ROWNORM) __syncthreads();
}


typedef float f32x4v __attribute__((ext_vector_type(4)));
constexpr int G8_HT = 128 * 64;
DI int lds_byte8(int r, int c) { const int st = (r >> 4) * 2 + (c >> 5), ob = (r & 15) * 64 + (c & 31) * 2; return st * 1024 + (ob ^ (((ob >> 9) & 1) << 5)); }
DI void stage_rc8(int b, int& R, int& C) { const int st = b >> 10, sb = b & 1023, swz = sb ^ (((sb >> 9) & 1) << 5); R = (st >> 1) * 16 + (swz >> 6); C = (st & 1) * 32 + ((swz & 63) >> 1); }

DI void gemm8_prestage(const u16* __restrict__ A, const u16* __restrict__ Bt, int K, int brow, int bcol, char* smem) {
  u16* shm = (u16*)smem;
  const int tid = opaque_tid();
  int sr0, sc0, sr1, sc1;
  stage_rc8(tid * 16, sr0, sc0);
  stage_rc8(tid * 16 + 8192, sr1, sc1);
  const unsigned go0 = (unsigned)sr0 * K + sc0, go1 = (unsigned)sr1 * K + sc1;
#define G8P_STAGE(P, BASE, br) do { const u16* g_ = (BASE) + (size_t)(br) * K; \
    __builtin_amdgcn_global_load_lds((const unsigned*)(g_ + go0), (__attribute__((address_space(3))) unsigned*)((char*)(P) + tid * 16), 16, 0, 0); \
    __builtin_amdgcn_global_load_lds((const unsigned*)(g_ + go1), (__attribute__((address_space(3))) unsigned*)((char*)(P) + tid * 16 + 8192), 16, 0, 0); } while (0)
  G8P_STAGE(shm + 4 * G8_HT, Bt, bcol); G8P_STAGE(shm, A, brow);
  G8P_STAGE(shm + 5 * G8_HT, Bt, bcol + 128); G8P_STAGE(shm + G8_HT, A, brow + 128);
#undef G8P_STAGE
}

template <int EPI, bool GSCALE = false>
DI void gemm8_tile(const Params& p, int layer, const u16* __restrict__ A, const u16* __restrict__ Bt, int K, int brow, int bcol, char* smem,
                   bool next_valid, int next_brow, int next_bcol) {
  u16* shm = (u16*)smem;
  const int tid = opaque_tid();
  float* gfac = (float*)(smem + 8 * G8_HT * 2);
  if (GSCALE) {
    if (tid < 256) {
      const float* sq = (const float*)(p.ws + OFF_SSQ) + (size_t)(brow + tid) * 16;
      float rs[4];
#pragma unroll
      for (int g = 0; g < 4; ++g) { const f32x4 s4 = *(const f32x4*)(sq + 4 * g); rs[g] = rsqrtf((s4[0] + s4[1] + s4[2] + s4[3]) * (1.f / 256.f) + EPS); }
      gfac[tid] = rs[0] / rs[1]; gfac[256 + tid] = rs[1] / rs[2]; gfac[512 + tid] = rs[2] / rs[3]; gfac[768 + tid] = rs[3];
    }
  }
  const int wid = tid >> 6, lane = tid & 63, wr = wid >> 2, wc = wid & 3, fr = lane & 15, fq = lane >> 4;
  int sr0, sc0, sr1, sc1;
  stage_rc8(tid * 16, sr0, sc0);
  stage_rc8(tid * 16 + 8192, sr1, sc1);
  const unsigned go0 = (unsigned)sr0 * K + sc0, go1 = (unsigned)sr1 * K + sc1;
#define G8_SA(b, hh) (shm + ((b) * 2 + (hh)) * G8_HT)
#define G8_SB(b, hh) (shm + (4 + (b) * 2 + (hh)) * G8_HT)
#define G8_STAGE(P, BASE, br, kt) do { const u16* g_ = (BASE) + (size_t)(br) * K + (size_t)(kt) * 64; \
    __builtin_amdgcn_global_load_lds((const unsigned*)(g_ + go0), (__attribute__((address_space(3))) unsigned*)((char*)(P) + tid * 16), 16, 0, 0); \
    __builtin_amdgcn_global_load_lds((const unsigned*)(g_ + go1), (__attribute__((address_space(3))) unsigned*)((char*)(P) + tid * 16 + 8192), 16, 0, 0); } while (0)
#define G8_LDA(dst, b, hh) _Pragma("unroll") for (int m = 0; m < 4; ++m) _Pragma("unroll") for (int k = 0; k < 2; ++k) \
    dst[m][k] = *reinterpret_cast<const bf16x8*>((char*)G8_SA(b, hh) + lds_byte8(wr * 64 + m * 16 + fr, k * 32 + fq * 8))
#define G8_LDB(dst, b, hh) _Pragma("unroll") for (int n = 0; n < 2; ++n) _Pragma("unroll") for (int k = 0; k < 2; ++k) \
    dst[n][k] = *reinterpret_cast<const bf16x8*>((char*)G8_SB(b, hh) + lds_byte8(wc * 32 + n * 16 + fr, k * 32 + fq * 8))
#define G8_MMA(ai, bj, At_, Bt_) do { __builtin_amdgcn_s_setprio(1); \
    _Pragma("unroll") for (int m = 0; m < 4; ++m) _Pragma("unroll") for (int n = 0; n < 2; ++n) _Pragma("unroll") for (int k = 0; k < 2; ++k) \
      acc[ai][bj][m][n] = __builtin_amdgcn_mfma_f32_16x16x32_bf16(At_[m][k], Bt_[n][k], acc[ai][bj][m][n], 0, 0, 0); \
    __builtin_amdgcn_s_setprio(0); } while (0)
#define G8_WAIT_V(n) asm volatile("s_waitcnt vmcnt(" #n ")" ::: "memory")
#define G8_WAIT_L(n) asm volatile("s_waitcnt lgkmcnt(" #n ")" ::: "memory")
#define G8_BAR __builtin_amdgcn_s_barrier()
#define G8_SCHED __builtin_amdgcn_sched_barrier(0)
  f32x4v acc[2][2][4][2];
#pragma unroll
  for (int a = 0; a < 2; ++a)
#pragma unroll
    for (int b = 0; b < 2; ++b)
#pragma unroll
      for (int m = 0; m < 4; ++m)
#pragma unroll
        for (int n = 0; n < 2; ++n) acc[a][b][m][n] = (f32x4v){0.f, 0.f, 0.f, 0.f};
  bf16x8 At[4][2], B0[2][2], B1[2][2];
  const int nt = K / 64;
  if (wr == 1) G8_BAR;
  G8_WAIT_V(4); G8_BAR;
  G8_STAGE(G8_SB(1, 0), Bt, bcol, 1); G8_STAGE(G8_SA(1, 0), A, brow, 1); G8_STAGE(G8_SB(1, 1), Bt, bcol + 128, 1);
  G8_WAIT_V(6); G8_BAR;
  for (int t = 0; t < nt - 2; t += 2) {
    G8_LDB(B0, 0, 0); G8_SCHED; G8_LDA(At, 0, 0); G8_STAGE(G8_SA(1, 1), A, brow + 128, t + 1);
    G8_WAIT_L(8); G8_BAR; G8_WAIT_L(0); G8_MMA(0, 0, At, B0); G8_BAR; G8_SCHED;
    G8_LDB(B1, 0, 1); G8_STAGE(G8_SB(0, 0), Bt, bcol, t + 2);
    G8_BAR; G8_WAIT_L(0); G8_MMA(0, 1, At, B1); G8_BAR;
    G8_LDA(At, 0, 1); G8_STAGE(G8_SA(0, 0), A, brow, t + 2);
    G8_BAR; G8_WAIT_L(0); G8_MMA(1, 0, At, B0); G8_BAR; G8_SCHED;
    G8_STAGE(G8_SB(0, 1), Bt, bcol + 128, t + 2);
    G8_WAIT_V(6); G8_BAR; G8_MMA(1, 1, At, B1); G8_BAR;
    G8_LDB(B0, 1, 0); G8_SCHED; G8_LDA(At, 1, 0); G8_STAGE(G8_SA(0, 1), A, brow + 128, t + 2);
    G8_WAIT_L(8); G8_BAR; G8_WAIT_L(0); G8_MMA(0, 0, At, B0); G8_BAR; G8_SCHED;
    G8_LDB(B1, 1, 1); G8_STAGE(G8_SB(1, 0), Bt, bcol, t + 3);
    G8_BAR; G8_WAIT_L(0); G8_MMA(0, 1, At, B1); G8_BAR;
    G8_LDA(At, 1, 1); G8_STAGE(G8_SA(1, 0), A, brow, t + 3);
    G8_BAR; G8_WAIT_L(0); G8_MMA(1, 0, At, B0); G8_BAR; G8_SCHED;
    G8_STAGE(G8_SB(1, 1), Bt, bcol + 128, t + 3);
    G8_WAIT_V(6); G8_BAR; G8_MMA(1, 1, At, B1); G8_BAR;
    if (GSCALE && (t & 3) == 2) {
      const float* gf = gfac + (t >> 2) * 256 + wr * 64 + fq * 4;
#pragma unroll
      for (int ai = 0; ai < 2; ++ai)
#pragma unroll
        for (int m = 0; m < 4; ++m) {
          const f32x4 f4 = *(const f32x4*)(gf + ai * 128 + m * 16);
#pragma unroll
          for (int bj = 0; bj < 2; ++bj)
#pragma unroll
            for (int n = 0; n < 2; ++n)
#pragma unroll
              for (int j = 0; j < 4; ++j) acc[ai][bj][m][n][j] *= f4[j];
        }
    }
  }
  { G8_LDB(B0, 0, 0); G8_LDA(At, 0, 0); G8_STAGE(G8_SA(1, 1), A, brow + 128, nt - 1);
    G8_BAR; G8_WAIT_L(0); G8_MMA(0, 0, At, B0); G8_BAR;
    G8_LDB(B1, 0, 1); G8_BAR; G8_WAIT_L(0); G8_MMA(0, 1, At, B1); G8_BAR;
    G8_LDA(At, 0, 1); G8_WAIT_V(4); G8_BAR; G8_WAIT_L(0); G8_MMA(1, 0, At, B0); G8_MMA(1, 1, At, B1); G8_BAR; }
  { G8_LDB(B0, 1, 0); G8_LDA(At, 1, 0); G8_WAIT_V(2); G8_BAR; G8_WAIT_L(0); G8_MMA(0, 0, At, B0); G8_BAR;
    G8_LDB(B1, 1, 1); G8_WAIT_V(0); G8_BAR; G8_WAIT_L(0); G8_MMA(0, 1, At, B1); G8_BAR;
    G8_LDA(At, 1, 1); G8_BAR; G8_WAIT_L(0); G8_MMA(1, 0, At, B0); G8_MMA(1, 1, At, B1); G8_BAR; }
  if (wr == 0) G8_BAR;
  if (GSCALE) {
    const float* gf = gfac + 768 + wr * 64 + fq * 4;
#pragma unroll
    for (int ai = 0; ai < 2; ++ai)
#pragma unroll
      for (int m = 0; m < 4; ++m) {
        const f32x4 f4 = *(const f32x4*)(gf + ai * 128 + m * 16);
#pragma unroll
        for (int bj = 0; bj < 2; ++bj)
#pragma unroll
          for (int n = 0; n < 2; ++n)
#pragma unroll
            for (int j = 0; j < 4; ++j) acc[ai][bj][m][n][j] *= f4[j];
      }
  }
  if (next_valid) gemm8_prestage(A, Bt, K, next_brow, next_bcol, smem);
  const int wrs = __builtin_amdgcn_readfirstlane(wr), wcs = __builtin_amdgcn_readfirstlane(wc);
  if (EPI == EPI_RES) {
#pragma unroll
    for (int ai = 0; ai < 2; ++ai) {
      const int mrow0 = brow + ai * 128 + wrs * 64;
      const float* xw = (layer == 0 ? (brow < NPROMPT ? p.x_prompt + (size_t)mrow0 * DM : p.x_sample + (size_t)(mrow0 - NPROMPT) * DM) : p.out + (size_t)mrow0 * DM) + bcol + wcs * 32;
      float* ow = p.out + (size_t)mrow0 * DM + bcol + wcs * 32;
      const unsigned lo = (unsigned)(fq * 4) * DM + fr;
      float xv[4][4][4];
#pragma unroll
      for (int m = 0; m < 4; ++m)
#pragma unroll
        for (int j = 0; j < 4; ++j) {
          const float* xr = xw + (lo + (unsigned)((m * 16 + j) * DM));
#pragma unroll
          for (int c = 0; c < 4; ++c) xv[m][j][c] = xr[(c >> 1) * 128 + (c & 1) * 16];
        }
      __builtin_amdgcn_sched_barrier(0);
#pragma unroll
      for (int m = 0; m < 4; ++m)
#pragma unroll
        for (int j = 0; j < 4; ++j) {
          float* orow = ow + (lo + (unsigned)((m * 16 + j) * DM));
#pragma unroll
          for (int c = 0; c < 4; ++c) orow[(c >> 1) * 128 + (c & 1) * 16] = xv[m][j][c] + acc[ai][c >> 1][m][c & 1][j];
        }
      __builtin_amdgcn_sched_barrier(0);
    }
  }
#pragma unroll
  for (int ai = 0; ai < 2 && EPI != EPI_RES; ++ai) {
    const int mrow0 = brow + ai * 128 + wrs * 64;
#pragma unroll
    for (int bj = 0; bj < 2; ++bj) {
      const int ncol0 = bcol + bj * 128 + wcs * 32;
      if (EPI == EPI_SWIGLU) {
        u16* dw = (u16*)(p.ws + OFF_ACT) + (size_t)mrow0 * DFF + (ncol0 >> 1);
        const unsigned lo = (unsigned)(fq * 4) * DFF + fr;
#pragma unroll
        for (int m = 0; m < 4; ++m) {
#pragma unroll
          for (int j = 0; j < 4; ++j) {
            const float g = acc[ai][bj][m][0][j], u = acc[ai][bj][m][1][j];
            const float a = g * __builtin_amdgcn_rcpf(1.f + fexp2(-g * LOG2E)) * u;
            dw[lo + (unsigned)((m * 16 + j) * DFF)] = (u16)(pack2(a, 0.f) & 0xffff);
          }
        }
        __builtin_amdgcn_sched_barrier(0);
      } else if (EPI == EPI_RES) {
      } else {
#pragma unroll
        for (int n = 0; n < 2; ++n) {
          const int nb0 = ncol0 + n * 16;
          if (nb0 < DIN) {
            u16* dw = (u16*)(p.ws + OFF_PROJ) + (size_t)mrow0 * DIN + nb0;
            const unsigned lo = (unsigned)(fq * 4) * DIN + fr;
#pragma unroll
            for (int m = 0; m < 4; ++m)
#pragma unroll
              for (int j = 0; j < 4; ++j) dw[lo + (unsigned)((m * 16 + j) * DIN)] = (u16)(pack2(acc[ai][bj][m][n][j], 0.f) & 0xffff);
          }
          __builtin_amdgcn_sched_barrier(0);
        }
      }
    }
  }
  G8_WAIT_V(0);
  __syncthreads();
}

DI void e1_chunk(const Params& p, int layer, int chunk) {
  const int j = chunk & 7;
  const size_t tok = (size_t)(chunk >> 3) * NTHR + opaque_tid();
  if (j == 7) return;
  u16* proj = (u16*)(p.ws + OFF_PROJ);
  const int t = (int)(tok & 4095);
  if (j < 6) {
    u16* ptr = proj + tok * DIN + (j < 4 ? 768 + 64 * j : 1024 + 64 * (j - 4));
    const float* gain = (j < 4 ? p.b_q_gain : p.b_k_gain) + layer * 64;
    const float post = j < 4 ? QSCALE64 : 1.f;
    float x[64];
    float ss = 0.f;
#pragma unroll
    for (int c = 0; c < 8; ++c) {
      u32x4 w = *(const u32x4*)(ptr + c * 8);
#pragma unroll
      for (int e = 0; e < 4; ++e) { x[c * 8 + 2 * e] = bflo(w[e]); x[c * 8 + 2 * e + 1] = bfhi(w[e]); }
    }
#pragma unroll
    for (int d = 0; d < 64; ++d) ss += x[d] * x[d];
    const float rstd = rsqrtf(ss * (1.f / 64.f) + EPS);
    __builtin_amdgcn_sched_barrier(0);
#pragma unroll
    for (int c = 0; c < 4; ++c) {
#pragma unroll
      for (int d = 0; d < 16; ++d) x[c * 16 + d] = x[c * 16 + d] * rstd * gain[c * 16 + d];
      __builtin_amdgcn_sched_barrier(0);
    }
    const int prow = t >> 6, pcol = t & 63;
    { float* xa = x; float* xb = x + 16; ROPE16(p.ws, prow, xa, xb); }
    __builtin_amdgcn_sched_barrier(0);
    { float* xa = x + 32; float* xb = x + 48; ROPE16(p.ws, pcol, xa, xb); }
    __builtin_amdgcn_sched_barrier(0);
#pragma unroll
    for (int c = 0; c < 8; ++c) {
      u32x4 w;
#pragma unroll
      for (int e = 0; e < 4; ++e) w[e] = pack2(x[c * 8 + 2 * e] * post, x[c * 8 + 2 * e + 1] * post);
      *(u32x4*)(ptr + c * 8) = w;
    }
  } else {
    const u16* src = proj + tok * DIN + 2432;
    float x[32];
#pragma unroll
    for (int c = 0; c < 4; ++c) {
      u32x4 w = *(const u32x4*)(src + c * 8);
#pragma unroll
      for (int e = 0; e < 4; ++e) { x[c * 8 + 2 * e] = bflo(w[e]); x[c * 8 + 2 * e + 1] = bfhi(w[e]); }
    }
    { float* xa = x; float* xb = x + 16; ROPE16(p.ws, t, xa, xb); }
    u16* kd = (u16*)(p.ws + OFF_KD) + tok * 384 + 64;
#pragma unroll
    for (int c = 0; c < 4; ++c) {
      u32x4 w;
#pragma unroll
      for (int e = 0; e < 4; ++e) w[e] = pack2(x[c * 8 + 2 * e], x[c * 8 + 2 * e + 1]);
#pragma unroll
      for (int hh = 0; hh < 4; ++hh) *(u32x4*)(kd + hh * 96 + c * 8) = w;
    }
  }
}

template <int MODE>
DI void attn_tile(const Params& p, int layer, int tile, char* smem) {
  constexpr int DQK = (MODE == 3) ? 96 : 64;
  constexpr int NKQ = DQK / 16;
  constexpr int KROW = DQK + 8;
  constexpr int VROW = 72;
  constexpr int KCH = DQK / 8;
  constexpr int KLD = (64 * KCH + NTHR - 1) / NTHR;
  u16* Ks = (u16*)smem;
  u16* Vs = (u16*)(smem + 26624);
  float* tbl = (float*)(smem + 26624 + 18432);

  const int tid = opaque_tid(), lane = tid & 63, wave = tid >> 6, r = lane & 31, h = lane >> 5;
  const int qb = tile & 15, head = (tile >> 4) & 3, seq = tile >> 6;
  const size_t tok0 = (size_t)seq * SEQ;
  const u16* proj = (const u16*)(p.ws + OFF_PROJ);
  const u16 *Qp, *Kp, *Vp;
  int ldq, ldk, ldv;
  if (MODE == 0) { Qp = proj + 64 * head; Kp = proj + 256 + 64 * head; Vp = proj + 512 + 64 * head; ldq = ldk = ldv = DIN; }
  else if (MODE == 1) { Qp = proj + 768 + 64 * head; Kp = proj + 1024 + 64 * (head >> 1); Vp = proj + 1152 + 64 * (head >> 1); ldq = ldk = ldv = DIN; }
  else if (MODE == 2) { Qp = proj + 1280 + 64 * head; Kp = proj + 1536 + 64 * head; Vp = proj + 1792 + 64 * head; ldq = ldk = ldv = DIN; }
  else { Qp = (const u16*)(p.ws + OFF_QD) + 96 * head; Kp = (const u16*)(p.ws + OFF_KD) + 96 * head; Vp = (const u16*)(p.ws + OFF_VD) + 64 * head; ldq = ldk = 384; ldv = 256; }

  int kt0 = 0, kt1 = 64;
  if (MODE == 0) { kt0 = 4 * qb - 16; if (kt0 < 0) kt0 = 0; kt1 = 4 * qb + 20; if (kt1 > 64) kt1 = 64; }
  if (MODE == 2) { int r0 = 4 * qb - 4; r0 = r0 < 0 ? 0 : (r0 > 56 ? 56 : r0); int r1 = 4 * qb + 3 - 4; r1 = r1 < 0 ? 0 : (r1 > 56 ? 56 : r1); kt0 = r0; kt1 = r1 + 8; }

  if (MODE == 0) { const float* src = (const float*)(p.ws + OFF_TBLA) + head * 2560; for (int i = tid; i < 2560; i += NTHR) tbl[i] = src[i]; }
  if (MODE == 2) { const float* src = p.c_rpb + (size_t)(layer * 4 + head) * 465; for (int i = tid; i < 465; i += NTHR) tbl[i] = src[i] * LOG2E; }

  const int qpos = qb * 256 + wave * 32 + r;
  bf16x8 qf[NKQ];
  {
    const u16* qrow = Qp + (tok0 + qpos) * ldq + 8 * h;
#pragma unroll
    for (int d0 = 0; d0 < NKQ; ++d0) qf[d0] = *(const bf16x8*)(qrow + d0 * 16);
  }
  if (MODE == 3) {
    bf16x8 x1 = qf[NKQ - 2], x2 = qf[NKQ - 1];
    const f32x4* rt = (const f32x4*)(p.ws + OFF_ROPE) + (size_t)qpos * 8 + 4 * h;
#pragma unroll
    for (int j2 = 0; j2 < 4; ++j2) {
      const f32x4 cs4 = rt[j2];
#pragma unroll
      for (int e = 0; e < 2; ++e) {
        const int j = 2 * j2 + e;
        const float c = cs4[2 * e], sn = cs4[2 * e + 1];
        float a = __uint_as_float(((unsigned)(u16)x1[j]) << 16), b = __uint_as_float(((unsigned)(u16)x2[j]) << 16);
        unsigned w = pack2(a * c - b * sn, a * sn + b * c);
        x1[j] = (short)(w & 0xffff); x2[j] = (short)(w >> 16);
      }
    }
    qf[NKQ - 2] = x1; qf[NKQ - 1] = x2;
  }

  u32x4 rk0[KLD], rv0, rk1[KLD], rv1;
  const u16* Kt = Kp + tok0 * ldk;
  const u16* Vt = Vp + tok0 * ldv;
  unsigned koff[KLD];
#pragma unroll
  for (int pp = 0; pp < KLD; ++pp) { int c = tid + NTHR * pp; if (c >= 64 * KCH) c = tid; const int row = c / KCH, col = c % KCH; koff[pp] = (unsigned)row * ldk + col * 8; }
  const unsigned voff = (unsigned)(tid >> 3) * ldv + (tid & 7) * 8;
  const int ktl = kt1 - 1;
  auto gload = [&](u32x4 (&rk)[KLD], u32x4& rv, int kt) {
    kt = kt < ktl ? kt : ktl;
#pragma unroll
    for (int pp = 0; pp < KLD; ++pp) rk[pp] = *(const u32x4*)(Kt + (koff[pp] + (unsigned)(kt * 64) * ldk));
    rv = *(const u32x4*)(Vt + (voff + (unsigned)(kt * 64) * ldv));
  };
  auto lstore = [&](u32x4 (&rk)[KLD], u32x4& rv, int buf) {
#pragma unroll
    for (int pp = 0; pp < KLD; ++pp) { const int c = tid + NTHR * pp; if (c < 64 * KCH) { const int row = c / KCH, col = c % KCH; *(u32x4*)(Ks + (buf * 64 + row) * KROW + col * 8) = rk[pp]; } }
    *(u32x4*)(Vs + (buf * 64 + (tid >> 3)) * VROW + (tid & 7) * 8) = rv;
  };

  f32x16 o0, o1, negm;
#pragma unroll
  for (int i = 0; i < 16; ++i) { o0[i] = 0.f; o1[i] = 0.f; negm[i] = 0.f; }
  float mref = 0.f, lsum = 0.f;
  bool started = false;
  int qr = 0, qc = 0, cs = 0, rs = 0;
  if (MODE == 2) { qr = qpos >> 6; qc = qpos & 63; cs = qc - 8; cs = cs < 0 ? 0 : (cs > 48 ? 48 : cs); rs = qr - 4; rs = rs < 0 ? 0 : (rs > 56 ? 56 : rs); }
  const int i16 = lane & 15, qq = i16 >> 2, pp4 = i16 & 3, g16 = (lane >> 4) & 1;

  auto compute = [&](int buf, int kt) {
    bool active = true;
    if (MODE == 2) active = (kt >= rs) && (kt < rs + 8);
    if (active) {
      const u16* Kb = Ks + buf * 64 * KROW + r * KROW + 8 * h;
      const u16* Vb = Vs + buf * 64 * VROW;
      bf16x8 vf[8];
#pragma unroll
      for (int cs2 = 0; cs2 < 4; ++cs2) {
        const u16* vp = Vb + (16 * cs2 + 4 * h + qq) * VROW + 16 * g16 + 4 * pp4;
        { s16x4 lo = tr_read(vp), hi = tr_read(vp + 8 * VROW); vf[2 * cs2] = __builtin_shufflevector(lo, hi, 0, 1, 2, 3, 4, 5, 6, 7); }
        { s16x4 lo = tr_read(vp + 32), hi = tr_read(vp + 8 * VROW + 32); vf[2 * cs2 + 1] = __builtin_shufflevector(lo, hi, 0, 1, 2, 3, 4, 5, 6, 7); }
      }
      f32x16 s0 = negm, s1 = negm;
#pragma unroll
      for (int d0 = 0; d0 < NKQ; ++d0) {
        bf16x8 k0 = *(const bf16x8*)(Kb + d0 * 16);
        bf16x8 k1 = *(const bf16x8*)(Kb + 32 * KROW + d0 * 16);
        s0 = mfma(k0, qf[d0], s0);
        s1 = mfma(k1, qf[d0], s1);
      }
      if (MODE == 0) {
        const float* tb = tbl + (kt * 64 + 4 * h - qpos + 1280);
#pragma unroll
        for (int i = 0; i < 16; ++i) { s0[i] += tb[(i & 3) + 8 * (i >> 2)]; s1[i] += tb[32 + (i & 3) + 8 * (i >> 2)]; }
      }
      if (MODE == 2) {
        const float* tb = tbl + (kt - qr + 7) * 31 + (15 - qc);
#pragma unroll
        for (int i = 0; i < 16; ++i) {
          const int kc0 = 4 * h + (i & 3) + 8 * (i >> 2), kc1 = kc0 + 32;
          const bool v0 = (kc0 >= cs) && (kc0 < cs + 16), v1 = (kc1 >= cs) && (kc1 < cs + 16);
          const float b0 = tb[v0 ? kc0 : qc], b1 = tb[v1 ? kc1 : qc];
          s0[i] = v0 ? s0[i] + b0 : NEGBIG;
          s1[i] = v1 ? s1[i] + b1 : NEGBIG;
        }
      }
      float ma = __builtin_fmaxf(__builtin_fmaxf(s0[0], s0[1]), s0[2]), mb = __builtin_fmaxf(__builtin_fmaxf(s1[0], s1[1]), s1[2]);
#pragma unroll
      for (int i = 3; i < 15; i += 2) { ma = __builtin_fmaxf(__builtin_fmaxf(ma, s0[i]), s0[i + 1]); mb = __builtin_fmaxf(__builtin_fmaxf(mb, s1[i]), s1[i + 1]); }
      float mt = __builtin_fmaxf(__builtin_fmaxf(ma, s0[15]), s1[15]);
      mt = hmax(__builtin_fmaxf(mt, mb));
      const bool fresh = !started && (mt > -1e29f);
      if (__any(fresh || (started && mt > 8.f))) {
        float delta = 0.f, al = 1.f;
        if (fresh) { delta = mt; started = true; }
        else if (started) { delta = __builtin_fmaxf(mt, 0.f); al = fexp2(-delta); }
        mref += delta;
        lsum *= al;
#pragma unroll
        for (int i = 0; i < 16; ++i) { o0[i] *= al; o1[i] *= al; s0[i] -= delta; s1[i] -= delta; negm[i] = -mref; }
      }
      float ps = 0.f;
#pragma unroll
      for (int i = 0; i < 16; ++i) { s0[i] = fexp2(s0[i]); s1[i] = fexp2(s1[i]); ps += s0[i] + s1[i]; }
      lsum += ps;
#pragma unroll
      for (int c = 0; c < 2; ++c) {
#pragma unroll
        for (int s = 0; s < 2; ++s) {
          u32x4 pw;
          if (c == 0) pw = (u32x4){pack2(s0[8 * s], s0[8 * s + 1]), pack2(s0[8 * s + 2], s0[8 * s + 3]), pack2(s0[8 * s + 4], s0[8 * s + 5]), pack2(s0[8 * s + 6], s0[8 * s + 7])};
          else pw = (u32x4){pack2(s1[8 * s], s1[8 * s + 1]), pack2(s1[8 * s + 2], s1[8 * s + 3]), pack2(s1[8 * s + 4], s1[8 * s + 5]), pack2(s1[8 * s + 6], s1[8 * s + 7])};
          const bf16x8 pf = __builtin_bit_cast(bf16x8, pw);
          o0 = mfma(vf[2 * (2 * c + s)], pf, o0);
          o1 = mfma(vf[2 * (2 * c + s) + 1], pf, o1);
        }
      }
    }
  };

  const int ntile = kt1 - kt0;
  gload(rk0, rv0, kt0);
  lstore(rk0, rv0, 0);
  gload(rk0, rv0, kt0 + 1);
  gload(rk1, rv1, kt0 + 2);
  __syncthreads();
  for (int j = 0; j < ntile; j += 2) {
    compute(0, kt0 + j);
    lstore(rk0, rv0, 1);
    gload(rk0, rv0, kt0 + j + 3);
    __syncthreads();
    if (j + 1 >= ntile) break;
    compute(1, kt0 + j + 1);
    lstore(rk1, rv1, 0);
    gload(rk1, rv1, kt0 + j + 4);
    __syncthreads();
  }
  lsum = hsum(lsum);
  const float inv = 1.f / lsum;
  float sq = 0.f;
#pragma unroll
  for (int i = 0; i < 16; ++i) { o0[i] *= inv; o1[i] *= inv; sq += o0[i] * o0[i] + o1[i] * o1[i]; }
  sq = hsum(sq);
  if (h == 0) ((float*)(p.ws + OFF_SSQ))[(tok0 + qpos) * 16 + MODE * 4 + head] = sq;
  u16* op = (u16*)(p.ws + OFF_ACTB) + (tok0 + qpos) * DM + MODE * 256 + head * 64 + 4 * h;
#pragma unroll
  for (int g4 = 0; g4 < 4; ++g4) {
    u32x2 w0 = {pack2(o0[4 * g4], o0[4 * g4 + 1]), pack2(o0[4 * g4 + 2], o0[4 * g4 + 3])};
    u32x2 w1 = {pack2(o1[4 * g4], o1[4 * g4 + 1]), pack2(o1[4 * g4 + 2], o1[4 * g4 + 3])};
    *(u32x2*)(op + 8 * g4) = w0;
    *(u32x2*)(op + 32 + 8 * g4) = w1;
  }
}


DI bool sb_tile(int bid, int nb, int it, int NT, int& mt, int& nt) {
  const int G = nb >> 3, x = bid & 7, l = bid >> 3;
  const int s = l + it * G;
  const int sb = (s >> 5) * 8 + x, w = s & 31;
  if (NT == 4) {
    if (sb >= 48) return false;
    mt = sb * 8 + (w >> 2); nt = w & 3;
    return true;
  }
  const int NG = NT >> 1;
  if (sb >= 24 * NG) return false;
  const int mg = sb / NG, ng = sb - mg * NG;
  mt = mg * 16 + (w >> 1); nt = ng * 2 + (w & 1);
  return true;
}

DI bool att_tile_index(int bid, int nb, int it, int& tile) {
  if (nb != 256) { tile = bid + it * nb; return tile < 1536; }
  const int x = bid & 7, l = bid >> 3;
  const int pair = 2 * (it * 8 + x) + (l >> 4);
  tile = pair * 16 + ((l + 3 * it) & 15);
  return pair < 96;
}

template <int EPI, bool GSCALE = false>
DI void gemm8_phase(const Params& p, int layer, const u16* A, const u16* Bt, int K, int NT, char* smem) {
  const int bid = blockIdx.x, nb = gridDim.x;
  int mt, nt;
  bool have = sb_tile(bid, nb, 0, NT, mt, nt);
  if (have) gemm8_prestage(A, Bt, K, mt * 256, nt * 256, smem);
  for (int it = 0; have; ++it) {
    int mt2 = 0, nt2 = 0;
    const bool have2 = sb_tile(bid, nb, it + 1, NT, mt2, nt2);
    gemm8_tile<EPI, GSCALE>(p, layer, A, Bt, K, mt * 256, nt * 256, smem, have2, mt2 * 256, nt2 * 256);
    have = have2; mt = mt2; nt = nt2;
  }
}

constexpr int NPHASE = 17;
constexpr int MT = T_TOK / 256;

DI void run_phase(const Params& p, int ph, char* smem) {
  const int bid = blockIdx.x, nb = gridDim.x;
  u16* wtb = (u16*)(p.ws + OFF_WT);
  const u16* actb = (const u16*)(p.ws + OFF_ACTB);
  if (ph == 0) {
    for (int j = bid; j < 128; j += nb) rope_tab_build(p.ws, j * NTHR + opaque_tid());
    for (int j = bid; j < WJ_TOTAL; j += nb) wprep_job(p, j, smem);
    for (int rb = bid; rb < T_TOK / 8; rb += nb) norm_rows(p, 0, rb, 0);
    return;
  }
  if (ph == 16) { for (int rb = bid; rb < T_TOK / 8; rb += nb) norm_rows(p, 1, rb, 1); return; }
  const int layer = (ph - 1) >> 3, sub = (ph - 1) & 7;
  const u16* wl = wtb + (size_t)layer * WT_LAYER;
  switch (sub) {
    case 0:
      gemm8_phase<EPI_PROJ>(p, layer, actb, wl + WT_IN, 1024, 10, smem);
      break;
    case 1:
      for (int c = bid; c < (T_TOK / NTHR) * 8; c += nb) e1_chunk(p, layer, c);
      for (int t = bid; t < MT * 2; t += nb) { const int nt = t & 1, mt = t >> 1; gemm_tile<EPI_UQ, false, true>(p, layer, (const u16*)(p.ws + OFF_PROJ) + 2048, DIN, wl + WT_UQ, 256, mt * 256, nt * 256, smem); }
      for (int t = bid; t < MT * 2; t += nb) { const int nt = t & 1, mt = t >> 1; gemm_tile<EPI_UKV, false, true>(p, layer, (const u16*)(p.ws + OFF_PROJ) + 2304, DIN, wl + WT_UKV, 128, mt * 256, nt * 256, smem); }
      break;
    case 2:
      for (int it = 0, t; att_tile_index(bid, nb, it, t); ++it) attn_tile<3>(p, layer, t, smem);
      for (int it = 0, t; att_tile_index(bid, nb, it, t); ++it) attn_tile<1>(p, layer, t, smem);
      for (int it = 0, t; att_tile_index(bid, nb, it, t); ++it) attn_tile<0>(p, layer, t, smem);
      for (int it = 0, t; att_tile_index(bid, nb, it, t); ++it) attn_tile<2>(p, layer, t, smem);
      break;
    case 3:
      gemm8_phase<EPI_RES, true>(p, layer, actb, wl + WT_OUT, 1024, 4, smem);
      break;
    case 4:
      for (int rb = bid; rb < T_TOK / 8; rb += nb) norm_rows(p, 1, rb, 0);
      break;
    case 5:
      gemm8_phase<EPI_SWIGLU>(p, layer, actb, wl + WT_GU, 1024, 22, smem);
      break;
    case 6:
      gemm8_phase<EPI_RES>(p, 1, (const u16*)(p.ws + OFF_ACT), wl + WT_DN, DFF, 4, smem);
      break;
    case 7:
      for (int rb = bid; rb < T_TOK / 8; rb += nb) norm_rows(p, 1, rb, 0);
      break;
  }
}

__global__ void __launch_bounds__(NTHR, 2) mega(Params p, int ph_lo, int ph_hi) {
  __shared__ __attribute__((aligned(16))) char smem[SMEM_BYTES];
  cg::grid_group grid = cg::this_grid();
  for (int ph = ph_lo; ph < ph_hi; ++ph) {
    if (ph > ph_lo) grid.sync();
    run_phase(p, ph, smem);
#ifdef DUPMASK
    if (ph >= 1 && ph < 16 && ((DUPMASK >> ((ph - 1) & 7)) & 1)) { grid.sync(); run_phase(p, ph, smem); }
#endif
  }
}

extern "C" void kernel_launch(void* const* d_in, const int* in_sizes, int n_in, void* d_out, int out_size, void* d_ws, size_t ws_size, hipStream_t stream) {
  Params p{};
  p.x_prompt = (const float*)d_in[0]; p.x_sample = (const float*)d_in[1]; p.t5_bias = (const float*)d_in[2]; p.norm_mix = (const float*)d_in[3];
  p.w_in = (const float*)d_in[4]; p.b_q_gain = (const float*)d_in[5]; p.b_k_gain = (const float*)d_in[6]; p.c_rpb = (const float*)d_in[7];
  p.d_q_gain = (const float*)d_in[8]; p.d_w_uq = (const float*)d_in[9]; p.d_kv_gain = (const float*)d_in[10]; p.d_w_ukv = (const float*)d_in[11];
  p.out_gain = (const float*)d_in[12]; p.w_out = (const float*)d_in[13]; p.norm_ffn = (const float*)d_in[14]; p.w_gate = (const float*)d_in[15];
  p.w_up = (const float*)d_in[16]; p.w_down = (const float*)d_in[17]; p.final_norm = (const float*)d_in[18];
  p.out = (float*)d_out; p.ws = (char*)d_ws;
  if (ws_size < WS_NEED) { fprintf(stderr, "workspace too small: %zu < %zu\n", ws_size, (size_t)WS_NEED); return; }
  static int grid_blocks = 0;
  if (!grid_blocks) {
    int dev = 0, cus = 0, per_cu = 0;
    hipGetDevice(&dev);
    hipDeviceGetAttribute(&cus, hipDeviceAttributeMultiprocessorCount, dev);
    hipOccupancyMaxActiveBlocksPerMultiprocessor(&per_cu, mega, NTHR, 0);
    if (per_cu < 1) per_cu = 1;
    if (per_cu > 1) per_cu = 1;
    grid_blocks = cus * per_cu;
  }
#if ONE_LAUNCH
  int lo = 0, hi = NPHASE;
  void* args[] = {&p, &lo, &hi};
  hipError_t e = hipLaunchCooperativeKernel((void*)mega, dim3(grid_blocks), dim3(NTHR), args, 0, stream);
  if (e != hipSuccess) fprintf(stderr, "cooperative launch failed: %s (grid %d)\n", hipGetErrorString(e), grid_blocks);
#else
  for (int ph = 0; ph < NPHASE; ++ph) hipLaunchKernelGGL(mega, dim3(grid_blocks), dim3(NTHR), 0, stream, p, ph, ph + 1);
#endif
}
```

```cpp
#include <hip/hip_runtime.h>
#include <hip/hip_cooperative_groups.h>
#include <cstdio>
#include <cstdint>
namespace cg = cooperative_groups;

#ifndef ONE_LAUNCH
#define ONE_LAUNCH 1
#endif

#define DI __device__ __forceinline__
typedef short bf16x8 __attribute__((ext_vector_type(8)));
typedef short s16x4 __attribute__((ext_vector_type(4)));
typedef float f32x16 __attribute__((ext_vector_type(16)));
typedef float f32x4 __attribute__((ext_vector_type(4)));
typedef float f32x2 __attribute__((ext_vector_type(2)));
typedef unsigned u32x4 __attribute__((ext_vector_type(4)));
typedef unsigned u32x2 __attribute__((ext_vector_type(2)));
typedef __bf16 bf16v2 __attribute__((ext_vector_type(2)));
typedef unsigned short u16;

constexpr int T_TOK = 98304, SEQ = 4096, DM = 1024, DIN = 2464, DINP = 2560, DFF = 2816;
constexpr int NPROMPT = 8 * 4096;
constexpr int NTHR = 512;
constexpr float LOG2E = 1.4426950408889634f;
constexpr float QSCALE64 = 0.125f * LOG2E;
constexpr float QSCALE96 = 0.10206207261596575f * LOG2E;
constexpr float NEGBIG = -1e30f;
constexpr float EPS = 1e-6f;

constexpr size_t al256(size_t x) { return (x + 255) & ~(size_t)255; }
constexpr size_t WT_IN = 0;
constexpr size_t WT_UQ = WT_IN + (size_t)DINP * 1024;
constexpr size_t WT_UKV = WT_UQ + 512 * 256;
constexpr size_t WT_OUT = WT_UKV + 512 * 128;
constexpr size_t WT_GU = WT_OUT + 1024 * 1024;
constexpr size_t WT_DN = WT_GU + (size_t)5632 * 1024;
constexpr size_t WT_LAYER = WT_DN + (size_t)1024 * 2816;
constexpr size_t OFF_WT = 0;
constexpr size_t OFF_TBLA = al256(OFF_WT + 2 * WT_LAYER * 2);
constexpr size_t OFF_ROPE = al256(OFF_TBLA + 4 * 2560 * 4);
constexpr size_t OFF_ACTB = al256(OFF_ROPE + 4096 * 16 * 8);
constexpr size_t OFF_PROJ = al256(OFF_ACTB + (size_t)T_TOK * 1024 * 2);
constexpr size_t OFF_QD = al256(OFF_PROJ + (size_t)T_TOK * DIN * 2);
constexpr size_t OFF_KD = al256(OFF_QD + (size_t)T_TOK * 384 * 2);
constexpr size_t OFF_VD = al256(OFF_KD + (size_t)T_TOK * 384 * 2);
constexpr size_t OFF_SSQ = al256(OFF_VD + (size_t)T_TOK * 256 * 2);
constexpr size_t WS_NEED = al256(OFF_SSQ + (size_t)T_TOK * 16 * 4);
constexpr size_t OFF_ACT = OFF_PROJ;
static_assert(OFF_ACT + (size_t)T_TOK * DFF * 2 <= OFF_KD, "act alias overflow");

struct Params {
  const float *x_prompt, *x_sample, *t5_bias, *norm_mix, *w_in, *b_q_gain, *b_k_gain, *c_rpb, *d_q_gain, *d_w_uq,
      *d_kv_gain, *d_w_ukv, *out_gain, *w_out, *norm_ffn, *w_gate, *w_up, *w_down, *final_norm;
  float* out;
  char* ws;
};

constexpr int SMEM_BYTES = 2 * (256 + 256) * 72 * 2 + 1024;

DI unsigned pack2(float a, float b) { f32x2 v = {a, b}; bf16v2 r = __builtin_convertvector(v, bf16v2); return __builtin_bit_cast(unsigned, r); }
DI float bflo(unsigned w) { return __uint_as_float(w << 16); }
DI float bfhi(unsigned w) { return __uint_as_float(w & 0xffff0000u); }
DI f32x16 mfma(bf16x8 a, bf16x8 b, f32x16 c) { return __builtin_amdgcn_mfma_f32_32x32x16_bf16(a, b, c, 0, 0, 0); }
DI float hmax(float v) {
  auto rr = __builtin_amdgcn_permlane32_swap(__float_as_uint(v), __float_as_uint(v), false, false);
  return __builtin_fmaxf(__uint_as_float(rr[0]), __uint_as_float(rr[1]));
}
DI float hsum(float v) {
  auto rr = __builtin_amdgcn_permlane32_swap(__float_as_uint(v), __float_as_uint(v), false, false);
  return __uint_as_float(rr[0]) + __uint_as_float(rr[1]);
}
DI float fexp2(float x) { return __builtin_amdgcn_exp2f(x); }
DI int crow(int i, int h) { return (i & 3) + 8 * (i >> 2) + 4 * h; }
typedef short v4i16_t __attribute__((ext_vector_type(4)));
DI s16x4 tr_read(const u16* p) {
  return __builtin_bit_cast(s16x4, __builtin_amdgcn_ds_read_tr16_b64_v4i16((__attribute__((address_space(3))) v4i16_t*)p));
}
constexpr double inv_rev_c(int i) {
  constexpr double b[4] = {1.0, 0.5623413251903491, 0.31622776601683794, 0.1778279410038923};
  double v = b[i & 3];
  for (int k = 0; k < (i >> 2); ++k) v *= 0.1;
  return v * 0.15915494309189535;
}
DI void rope_tab_build(char* ws, int idx) {
  const int pos = idx >> 4, i = idx & 15;
  double invrev = inv_rev_c(0);
#pragma unroll
  for (int k = 1; k < 16; ++k) if (i == k) invrev = inv_rev_c(k);
  double rev = (double)pos * invrev;
  float f = (float)(rev - (double)(int)rev);
  f32x2 cs = {__builtin_amdgcn_cosf(f), __builtin_amdgcn_sinf(f)};
  ((f32x2*)(ws + OFF_ROPE))[idx] = cs;
}
#define ROPE16(ws_, pos_, A_, B_)                                                              \
  {                                                                                            \
    const f32x4* rt_ = (const f32x4*)((ws_) + OFF_ROPE) + (size_t)(pos_) * 8;                  \
    _Pragma("unroll") for (int i2_ = 0; i2_ < 8; ++i2_) {                                      \
      const f32x4 cs_ = rt_[i2_];                                                              \
      float a_ = A_[2 * i2_], b_ = B_[2 * i2_];                                                \
      A_[2 * i2_] = a_ * cs_[0] - b_ * cs_[1]; B_[2 * i2_] = a_ * cs_[1] + b_ * cs_[0];        \
      a_ = A_[2 * i2_ + 1]; b_ = B_[2 * i2_ + 1];                                              \
      A_[2 * i2_ + 1] = a_ * cs_[2] - b_ * cs_[3]; B_[2 * i2_ + 1] = a_ * cs_[3] + b_ * cs_[2]; \
    }                                                                                          \
  }
DI const float* xrow(const Params& p, int layer, size_t tok) {
  if (layer == 0) return tok < (size_t)NPROMPT ? p.x_prompt + tok * DM : p.x_sample + (tok - NPROMPT) * DM;
  return p.out + tok * DM;
}

DI int opaque_tid() { int t = threadIdx.x; asm volatile("" : "+v"(t)); return t; }
DI void wt_tile(const float* __restrict__ W, int K, int N, const float* __restrict__ g, u16* __restrict__ Wt, int k0, int n0, int mapmode, float* tile) {
  const int tid = opaque_tid();
  for (int i = tid; i < 4096; i += NTHR) {
    int kk = i >> 6, nn = i & 63, n = n0 + nn;
    float v = 0.f;
    if (n < N) { v = W[(size_t)(k0 + kk) * N + n]; if (g) v *= g[k0 + kk]; }
    tile[kk * 65 + nn] = v;
  }
  __syncthreads();
  for (int i = tid; i < 2048; i += NTHR) {
    int nn = i >> 5, kp = i & 31, n = n0 + nn;
    float cs = 1.f; int drow = n;
    if (mapmode == 1) { if (n < 256 || (n >= 1280 && n < 1536)) cs = QSCALE64; }
    else if (mapmode == 2) cs = QSCALE96;
    else if (mapmode == 3) drow = 32 * (n >> 4) + (n & 15);
    else if (mapmode == 4) drow = 32 * (n >> 4) + 16 + (n & 15);
    unsigned w = pack2(tile[(2 * kp) * 65 + nn] * cs, tile[(2 * kp + 1) * 65 + nn] * cs);
    *(unsigned*)(Wt + (size_t)drow * K + k0 + 2 * kp) = w;
  }
  __syncthreads();
}

constexpr int WJ_IN = 640, WJ_UQ = 32, WJ_UKV = 16, WJ_OUT = 256, WJ_G = 704, WJ_U = 704, WJ_D = 704;
constexpr int WJ_LAYER = WJ_IN + WJ_UQ + WJ_UKV + WJ_OUT + WJ_G + WJ_U + WJ_D;
constexpr int WJ_TOTAL = 2 * WJ_LAYER + 20;

DI void wprep_job(const Params& p, int job, char* smem) {
  float* tile = (float*)smem;
  u16* wtb = (u16*)(p.ws + OFF_WT);
  if (job >= 2 * WJ_LAYER) {
    int idx = (job - 2 * WJ_LAYER) * NTHR + opaque_tid();
    int head = idx / 2560, e = idx % 2560, d = e - 1280, n = d < 0 ? -d : d;
    int mult = (n <= 64 ? 1 : 0) + (((n & 3) == 0 && n <= 256) ? 1 : 0) + (((n & 15) == 0 && n <= 1024) ? 1 : 0);
    float v = NEGBIG;
    if (mult > 0) {
      int bk;
      if (n < 8) bk = n;
      else { float nf = (float)n; int lg = 8 + (int)(__logf(nf * 0.125f) / 4.852030263919617f * 8.0f); bk = lg < 15 ? lg : 15; }
      if (d > 0) bk += 16;
      v = (p.t5_bias[bk * 4 + head] + __logf((float)mult)) * LOG2E;
    }
    ((float*)(p.ws + OFF_TBLA))[idx] = v;
    return;
  }
  int layer = job / WJ_LAYER, j = job % WJ_LAYER;
  u16* wl = wtb + (size_t)layer * WT_LAYER;
  if (j < WJ_IN) { int kt = j & 15, nt = j >> 4; wt_tile(p.w_in + (size_t)layer * 1024 * DIN, 1024, DIN, p.norm_mix + layer * 1024, wl + WT_IN, kt * 64, nt * 64, 1, tile); return; }
  j -= WJ_IN;
  if (j < WJ_UQ) { int kt = j & 3, nt = j >> 2; wt_tile(p.d_w_uq + (size_t)layer * 256 * 384, 256, 384, p.d_q_gain + layer * 256, wl + WT_UQ, kt * 64, nt * 64, 2, tile); return; }
  j -= WJ_UQ;
  if (j < WJ_UKV) { int kt = j & 1, nt = j >> 1; wt_tile(p.d_w_ukv + (size_t)layer * 128 * 512, 128, 512, p.d_kv_gain + layer * 128, wl + WT_UKV, kt * 64, nt * 64, 0, tile); return; }
  j -= WJ_UKV;
  if (j < WJ_OUT) { int kt = j & 15, nt = j >> 4; wt_tile(p.w_out + (size_t)layer * 1024 * 1024, 1024, 1024, p.out_gain + layer * 1024, wl + WT_OUT, kt * 64, nt * 64, 0, tile); return; }
  j -= WJ_OUT;
  if (j < WJ_G) { int kt = j & 15, nt = j >> 4; wt_tile(p.w_gate + (size_t)layer * 1024 * DFF, 1024, DFF, p.norm_ffn + layer * 1024, wl + WT_GU, kt * 64, nt * 64, 3, tile); return; }
  j -= WJ_G;
  if (j < WJ_U) { int kt = j & 15, nt = j >> 4; wt_tile(p.w_up + (size_t)layer * 1024 * DFF, 1024, DFF, p.norm_ffn + layer * 1024, wl + WT_GU, kt * 64, nt * 64, 4, tile); return; }
  j -= WJ_U;
  { int kt = j % 44, nt = j / 44; wt_tile(p.w_down + (size_t)layer * DFF * 1024, DFF, 1024, nullptr, wl + WT_DN, kt * 64, nt * 64, 0, tile); }
}

DI void norm_rows(const Params& p, int layer, int rb, int mode) {
  const int tid = opaque_tid();
  const int lane = tid & 63, wave = tid >> 6;
  const size_t row0 = (size_t)rb * 16 + wave, row1 = row0 + 8;
  const float* src0 = xrow(p, layer, row0);
  const float* src1 = xrow(p, layer, row1);
  f32x4 v[2][4];
#pragma unroll
  for (int i = 0; i < 4; ++i) v[0][i] = __builtin_nontemporal_load((const f32x4*)(src0 + lane * 4 + 256 * i));
#pragma unroll
  for (int i = 0; i < 4; ++i) v[1][i] = __builtin_nontemporal_load((const f32x4*)(src1 + lane * 4 + 256 * i));
#pragma unroll
  for (int rr = 0; rr < 2; ++rr) {
    float ss = 0.f;
#pragma unroll
    for (int i = 0; i < 4; ++i) ss += v[rr][i][0] * v[rr][i][0] + v[rr][i][1] * v[rr][i][1] + v[rr][i][2] * v[rr][i][2] + v[rr][i][3] * v[rr][i][3];
#pragma unroll
    for (int o = 1; o < 64; o <<= 1) ss += __shfl_xor(ss, o);
    const float rstd = rsqrtf(ss * (1.f / 1024.f) + EPS);
    const size_t row = rr ? row1 : row0;
    if (mode == 0) {
      u16* dst = (u16*)(p.ws + OFF_ACTB) + row * DM;
#pragma unroll
      for (int i = 0; i < 4; ++i) { u32x2 w = {pack2(v[rr][i][0] * rstd, v[rr][i][1] * rstd), pack2(v[rr][i][2] * rstd, v[rr][i][3] * rstd)}; *(u32x2*)(dst + lane * 4 + 256 * i) = w; }
    } else {
      float* dst = p.out + row * DM;
#pragma unroll
      for (int i = 0; i < 4; ++i) { f32x4 g = *(const f32x4*)(p.final_norm + lane * 4 + 256 * i); f32x4 o = {v[rr][i][0] * rstd * g[0], v[rr][i][1] * rstd * g[1], v[rr][i][2] * rstd * g[2], v[rr][i][3] * rstd * g[3]}; __builtin_nontemporal_store(o, (f32x4*)(dst + lane * 4 + 256 * i)); }
    }
  }
}

enum { EPI_PROJ = 0, EPI_UQ = 1, EPI_UKV = 2, EPI_RES = 3, EPI_SWIGLU = 4 };
constexpr int GS = 72;
constexpr int BM = 256;
constexpr int TMW = 4;

template <int EPI, bool ASCALE, bool ROWNORM>
DI void gemm_tile(const Params& p, int layer, const u16* __restrict__ A, int lda, const u16* __restrict__ Wt, int K, int m0, int n0, char* smem) {
  u16* As = (u16*)smem;
  u16* Bs = As + 2 * BM * GS;
  float* rowscale = (float*)(Bs + 2 * 256 * GS);
  const int tid = opaque_tid(), lane = tid & 63, wave = tid >> 6, r = lane & 31, h = lane >> 5;
  const int wm = wave >> 2, wn = wave & 3;
  const int lrow = tid >> 3, kc = tid & 7;
  const u16* At = A + (size_t)m0 * lda;
  const u16* Bt = Wt + (size_t)n0 * K;
  const unsigned aoff = (unsigned)lrow * lda + kc * 8, boff = (unsigned)lrow * K + kc * 8;
  const float* ssq = (const float*)(p.ws + OFF_SSQ);

  if (ROWNORM) {
    const int rr = tid >> 1, half = tid & 1;
    const u16* src = A + (size_t)(m0 + rr) * lda + half * (K / 2);
    float ss = 0.f;
    for (int i = 0; i < K / 16; ++i) {
      u32x4 w = *(const u32x4*)(src + i * 8);
#pragma unroll
      for (int e = 0; e < 4; ++e) { float a = bflo(w[e]), b = bfhi(w[e]); ss += a * a + b * b; }
    }
    ss += __shfl_xor(ss, 1);
    if (half == 0) rowscale[rr] = rsqrtf(ss / (float)K + EPS);
  }

  f32x16 acc[TMW][2];
#pragma unroll
  for (int a = 0; a < TMW; ++a)
#pragma unroll
    for (int b = 0; b < 2; ++b)
#pragma unroll
      for (int i = 0; i < 16; ++i) acc[a][b][i] = 0.f;

  u32x4 ra[4], rb[4];
  float sc[4] = {1.f, 1.f, 1.f, 1.f};
  const int KT = K / 64;
  auto gload = [&](int kt) {
#pragma unroll
    for (int pp = 0; pp < 4; ++pp) ra[pp] = *(const u32x4*)(At + (size_t)(64 * pp) * lda + (aoff + (unsigned)kt * 64));
#pragma unroll
    for (int pp = 0; pp < 4; ++pp) rb[pp] = *(const u32x4*)(Bt + (size_t)(64 * pp) * K + (boff + (unsigned)kt * 64));
  };
  auto lstore = [&](int buf, int kt) {
    if (ASCALE) {
      if ((kt & 3) == 0) {
        const int g = kt >> 2;
#pragma unroll
        for (int pp = 0; pp < 4; ++pp) {
          f32x4 s4 = *(const f32x4*)(ssq + (size_t)(m0 + lrow + 64 * pp) * 16 + 4 * g);
          sc[pp] = rsqrtf((s4[0] + s4[1] + s4[2] + s4[3]) * (1.f / 256.f) + EPS);
        }
      }
#pragma unroll
      for (int pp = 0; pp < 4; ++pp)
#pragma unroll
        for (int e = 0; e < 4; ++e) ra[pp][e] = pack2(bflo(ra[pp][e]) * sc[pp], bfhi(ra[pp][e]) * sc[pp]);
    }
#pragma unroll
    for (int pp = 0; pp < 4; ++pp) *(u32x4*)(As + (buf * BM + lrow + 64 * pp) * GS + kc * 8) = ra[pp];
#pragma unroll
    for (int pp = 0; pp < 4; ++pp) *(u32x4*)(Bs + (buf * 256 + lrow + 64 * pp) * GS + kc * 8) = rb[pp];
  };
  auto compute = [&](int buf) {
    const u16* Ab = As + (buf * BM + wm * 128 + r) * GS + 8 * h;
    const u16* Bb = Bs + (buf * 256 + wn * 64 + r) * GS + 8 * h;
#pragma unroll
    for (int ks = 0; ks < 4; ++ks) {
      bf16x8 b0 = *(const bf16x8*)(Bb + ks * 16);
      bf16x8 b1 = *(const bf16x8*)(Bb + 32 * GS + ks * 16);
#pragma unroll
      for (int tm = 0; tm < TMW; ++tm) {
        bf16x8 a = *(const bf16x8*)(Ab + tm * 32 * GS + ks * 16);
        acc[tm][0] = mfma(a, b0, acc[tm][0]);
        acc[tm][1] = mfma(a, b1, acc[tm][1]);
      }
    }
  };
  gload(0);
  lstore(0, 0);
  if (KT > 1) gload(1);
  __syncthreads();
  for (int kt = 0; kt < KT; ++kt) {
    compute(kt & 1);
    if (kt + 1 < KT) lstore((kt + 1) & 1, kt + 1);
    if (kt + 2 < KT) gload(kt + 2);
    __syncthreads();
  }

  const int wms = __builtin_amdgcn_readfirstlane(wm), wns = __builtin_amdgcn_readfirstlane(wn);
  const int mrow0 = m0 + wms * 128;
  const int nwb = n0 + wns * 64;
  if (ROWNORM) {
#pragma unroll
    for (int tm = 0; tm < TMW; ++tm) {
#pragma unroll
      for (int i = 0; i < 16; ++i) {
        const float rs = rowscale[wms * 128 + 4 * h + 32 * tm + (i & 3) + 8 * (i >> 2)];
        acc[tm][0][i] *= rs; acc[tm][1][i] *= rs;
      }
    }
  }
  if (EPI == EPI_SWIGLU) {
    u16* dw = (u16*)(p.ws + OFF_ACT) + (size_t)mrow0 * DFF + (nwb >> 1);
    const unsigned lo = (unsigned)(4 * h) * DFF + r;
#pragma unroll
    for (int tm = 0; tm < TMW; ++tm) {
#pragma unroll
      for (int i = 0; i < 16; ++i) {
        const float g = acc[tm][0][i], u = acc[tm][1][i];
        const float a = g * __builtin_amdgcn_rcpf(1.f + fexp2(-g * LOG2E)) * u;
        dw[lo + (unsigned)((32 * tm + (i & 3) + 8 * (i >> 2)) * DFF)] = (u16)(pack2(a, 0.f) & 0xffff);
      }
      __builtin_amdgcn_sched_barrier(0);
    }
  } else {
#pragma unroll
    for (int tn = 0; tn < 2; ++tn) {
      const int nb0 = nwb + 32 * tn;
      if (EPI == EPI_RES) {
        const float* xw = (layer == 0 ? (m0 < NPROMPT ? p.x_prompt + (size_t)mrow0 * DM : p.x_sample + (size_t)(mrow0 - NPROMPT) * DM) : p.out + (size_t)mrow0 * DM) + nb0;
        float* ow = p.out + (size_t)mrow0 * DM + nb0;
        const unsigned lo = (unsigned)(4 * h) * DM + r;
#pragma unroll
        for (int tm = 0; tm < TMW; ++tm) {
#pragma unroll
          for (int g4 = 0; g4 < 4; ++g4) {
            float xv[4];
#pragma unroll
            for (int e = 0; e < 4; ++e) xv[e] = xw[lo + (unsigned)((32 * tm + 8 * g4 + e) * DM)];
#pragma unroll
            for (int e = 0; e < 4; ++e) ow[lo + (unsigned)((32 * tm + 8 * g4 + e) * DM)] = xv[e] + acc[tm][tn][4 * g4 + e];
          }
          __builtin_amdgcn_sched_barrier(0);
        }
      } else {
        u16* dw; int ld; bool ok = true;
        if (EPI == EPI_PROJ) { dw = (u16*)(p.ws + OFF_PROJ) + (size_t)mrow0 * DIN + nb0; ld = DIN; ok = (nb0 + r) < DIN; }
        else if (EPI == EPI_UQ) { dw = (u16*)(p.ws + OFF_QD) + (size_t)mrow0 * 384 + nb0; ld = 384; ok = nb0 < 384; }
        else {
          const int head = nb0 >> 7, w = nb0 & 127;
          if (w < 64) { dw = (u16*)(p.ws + OFF_KD) + (size_t)mrow0 * 384 + head * 96 + w; ld = 384; }
          else { dw = (u16*)(p.ws + OFF_VD) + (size_t)mrow0 * 256 + head * 64 + (w - 64); ld = 256; }
        }
        const unsigned lo = (unsigned)(4 * h) * ld + r;
        if (ok) {
#pragma unroll
          for (int tm = 0; tm < TMW; ++tm) {
#pragma unroll
            for (int i = 0; i < 16; ++i) dw[lo + (unsigned)((32 * tm + (i & 3) + 8 * (i >> 2)) * ld)] = (u16)(pack2(acc[tm][tn][i], 0.f) & 0xffff);
            __builtin_amdgcn_sched_barrier(0);
          }
        }
      }
    }
  }
  if (ROWNORM) __syncthreads();
}


typedef float f32x4v __attribute__((ext_vector_type(4)));
constexpr int G8_HT = 128 * 64;
DI int lds_byte8(int r, int c) { const int st = (r >> 4) * 2 + (c >> 5), ob = (r & 15) * 64 + (c & 31) * 2; return st * 1024 + (ob ^ (((ob >> 9) & 1) << 5)); }
DI void stage_rc8(int b, int& R, int& C) { const int st = b >> 10, sb = b & 1023, swz = sb ^ (((sb >> 9) & 1) << 5); R = (st >> 1) * 16 + (swz >> 6); C = (st & 1) * 32 + ((swz & 63) >> 1); }

DI void gemm8_prestage(const u16* __restrict__ A, const u16* __restrict__ Bt, int K, int brow, int bcol, char* smem) {
  u16* shm = (u16*)smem;
  const int tid = opaque_tid();
  int sr0, sc0, sr1, sc1;
  stage_rc8(tid * 16, sr0, sc0);
  stage_rc8(tid * 16 + 8192, sr1, sc1);
  const unsigned go0 = (unsigned)sr0 * K + sc0, go1 = (unsigned)sr1 * K + sc1;
#define G8P_STAGE(P, BASE, br) do { const u16* g_ = (BASE) + (size_t)(br) * K; \
    __builtin_amdgcn_global_load_lds((const unsigned*)(g_ + go0), (__attribute__((address_space(3))) unsigned*)((char*)(P) + tid * 16), 16, 0, 0); \
    __builtin_amdgcn_global_load_lds((const unsigned*)(g_ + go1), (__attribute__((address_space(3))) unsigned*)((char*)(P) + tid * 16 + 8192), 16, 0, 0); } while (0)
  G8P_STAGE(shm + 4 * G8_HT, Bt, bcol); G8P_STAGE(shm, A, brow);
  G8P_STAGE(shm + 5 * G8_HT, Bt, bcol + 128); G8P_STAGE(shm + G8_HT, A, brow + 128);
#undef G8P_STAGE
}

template <int EPI, bool GSCALE = false>
DI void gemm8_tile(const Params& p, int layer, const u16* __restrict__ A, const u16* __restrict__ Bt, int K, int brow, int bcol, char* smem,
                   bool next_valid, int next_brow, int next_bcol) {
  u16* shm = (u16*)smem;
  const int tid = opaque_tid();
  float* gfac = (float*)(smem + 8 * G8_HT * 2);
  if (GSCALE) {
    if (tid < 256) {
      const float* sq = (const float*)(p.ws + OFF_SSQ) + (size_t)(brow + tid) * 16;
      float rs[4];
#pragma unroll
      for (int g = 0; g < 4; ++g) { const f32x4 s4 = *(const f32x4*)(sq + 4 * g); rs[g] = rsqrtf((s4[0] + s4[1] + s4[2] + s4[3]) * (1.f / 256.f) + EPS); }
      gfac[tid] = rs[0] / rs[1]; gfac[256 + tid] = rs[1] / rs[2]; gfac[512 + tid] = rs[2] / rs[3]; gfac[768 + tid] = rs[3];
    }
  }
  const int wid = tid >> 6, lane = tid & 63, wr = wid >> 2, wc = wid & 3, fr = lane & 15, fq = lane >> 4;
  int sr0, sc0, sr1, sc1;
  stage_rc8(tid * 16, sr0, sc0);
  stage_rc8(tid * 16 + 8192, sr1, sc1);
  const unsigned go0 = (unsigned)sr0 * K + sc0, go1 = (unsigned)sr1 * K + sc1;
#define G8_SA(b, hh) (shm + ((b) * 2 + (hh)) * G8_HT)
#define G8_SB(b, hh) (shm + (4 + (b) * 2 + (hh)) * G8_HT)
#define G8_STAGE(P, BASE, br, kt) do { const u16* g_ = (BASE) + (size_t)(br) * K + (size_t)(kt) * 64; \
    __builtin_amdgcn_global_load_lds((const unsigned*)(g_ + go0), (__attribute__((address_space(3))) unsigned*)((char*)(P) + tid * 16), 16, 0, 0); \
    __builtin_amdgcn_global_load_lds((const unsigned*)(g_ + go1), (__attribute__((address_space(3))) unsigned*)((char*)(P) + tid * 16 + 8192), 16, 0, 0); } while (0)
#define G8_LDA(dst, b, hh) _Pragma("unroll") for (int m = 0; m < 4; ++m) _Pragma("unroll") for (int k = 0; k < 2; ++k) \
    dst[m][k] = *reinterpret_cast<const bf16x8*>((char*)G8_SA(b, hh) + lds_byte8(wr * 64 + m * 16 + fr, k * 32 + fq * 8))
#define G8_LDB(dst, b, hh) _Pragma("unroll") for (int n = 0; n < 2; ++n) _Pragma("unroll") for (int k = 0; k < 2; ++k) \
    dst[n][k] = *reinterpret_cast<const bf16x8*>((char*)G8_SB(b, hh) + lds_byte8(wc * 32 + n * 16 + fr, k * 32 + fq * 8))
#define G8_MMA(ai, bj, At_, Bt_) do { __builtin_amdgcn_s_setprio(1); \
    _Pragma("unroll") for (int m = 0; m < 4; ++m) _Pragma("unroll") for (int n = 0; n < 2; ++n) _Pragma("unroll") for (int k = 0; k < 2; ++k) \
      acc[ai][bj][m][n] = __builtin_amdgcn_mfma_f32_16x16x32_bf16(At_[m][k], Bt_[n][k], acc[ai][bj][m][n], 0, 0, 0); \
    __builtin_amdgcn_s_setprio(0); } while (0)
#define G8_WAIT_V(n) asm volatile("s_waitcnt vmcnt(" #n ")" ::: "memory")
#define G8_WAIT_L(n) asm volatile("s_waitcnt lgkmcnt(" #n ")" ::: "memory")
#define G8_BAR __builtin_amdgcn_s_barrier()
#define G8_SCHED __builtin_amdgcn_sched_barrier(0)
  f32x4v acc[2][2][4][2];
#pragma unroll
  for (int a = 0; a < 2; ++a)
#pragma unroll
    for (int b = 0; b < 2; ++b)
#pragma unroll
      for (int m = 0; m < 4; ++m)
#pragma unroll
        for (int n = 0; n < 2; ++n) acc[a][b][m][n] = (f32x4v){0.f, 0.f, 0.f, 0.f};
  bf16x8 At[4][2], B0[2][2], B1[2][2];
  const int nt = K / 64;
  if (wr == 1) G8_BAR;
  G8_WAIT_V(4); G8_BAR;
  G8_STAGE(G8_SB(1, 0), Bt, bcol, 1); G8_STAGE(G8_SA(1, 0), A, brow, 1); G8_STAGE(G8_SB(1, 1), Bt, bcol + 128, 1);
  G8_WAIT_V(6); G8_BAR;
  for (int t = 0; t < nt - 2; t += 2) {
    G8_LDB(B0, 0, 0); G8_SCHED; G8_LDA(At, 0, 0); G8_STAGE(G8_SA(1, 1), A, brow + 128, t + 1);
    G8_WAIT_L(8); G8_BAR; G8_WAIT_L(0); G8_MMA(0, 0, At, B0); G8_BAR; G8_SCHED;
    G8_LDB(B1, 0, 1); G8_STAGE(G8_SB(0, 0), Bt, bcol, t + 2);
    G8_BAR; G8_WAIT_L(0); G8_MMA(0, 1, At, B1); G8_BAR;
    G8_LDA(At, 0, 1); G8_STAGE(G8_SA(0, 0), A, brow, t + 2);
    G8_BAR; G8_WAIT_L(0); G8_MMA(1, 0, At, B0); G8_BAR; G8_SCHED;
    G8_STAGE(G8_SB(0, 1), Bt, bcol + 128, t + 2);
    G8_WAIT_V(6); G8_BAR; G8_MMA(1, 1, At, B1); G8_BAR;
    G8_LDB(B0, 1, 0); G8_SCHED; G8_LDA(At, 1, 0); G8_STAGE(G8_SA(0, 1), A, brow + 128, t + 2);
    G8_WAIT_L(8); G8_BAR; G8_WAIT_L(0); G8_MMA(0, 0, At, B0); G8_BAR; G8_SCHED;
    G8_LDB(B1, 1, 1); G8_STAGE(G8_SB(1, 0), Bt, bcol, t + 3);
    G8_BAR; G8_WAIT_L(0); G8_MMA(0, 1, At, B1); G8_BAR;
    G8_LDA(At, 1, 1); G8_STAGE(G8_SA(1, 0), A, brow, t + 3);
    G8_BAR; G8_WAIT_L(0); G8_MMA(1, 0, At, B0); G8_BAR; G8_SCHED;
    G8_STAGE(G8_SB(1, 1), Bt, bcol + 128, t + 3);
    G8_WAIT_V(6); G8_BAR; G8_MMA(1, 1, At, B1); G8_BAR;
    if (GSCALE && (t & 3) == 2) {
      const float* gf = gfac + (t >> 2) * 256 + wr * 64 + fq * 4;
#pragma unroll
      for (int ai = 0; ai < 2; ++ai)
#pragma unroll
        for (int m = 0; m < 4; ++m) {
          const f32x4 f4 = *(const f32x4*)(gf + ai * 128 + m * 16);
#pragma unroll
          for (int bj = 0; bj < 2; ++bj)
#pragma unroll
            for (int n = 0; n < 2; ++n)
#pragma unroll
              for (int j = 0; j < 4; ++j) acc[ai][bj][m][n][j] *= f4[j];
        }
    }
  }
  { G8_LDB(B0, 0, 0); G8_LDA(At, 0, 0); G8_STAGE(G8_SA(1, 1), A, brow + 128, nt - 1);
    G8_BAR; G8_WAIT_L(0); G8_MMA(0, 0, At, B0); G8_BAR;
    G8_LDB(B1, 0, 1); G8_BAR; G8_WAIT_L(0); G8_MMA(0, 1, At, B1); G8_BAR;
    G8_LDA(At, 0, 1); G8_WAIT_V(4); G8_BAR; G8_WAIT_L(0); G8_MMA(1, 0, At, B0); G8_MMA(1, 1, At, B1); G8_BAR; }
  { G8_LDB(B0, 1, 0); G8_LDA(At, 1, 0); G8_WAIT_V(2); G8_BAR; G8_WAIT_L(0); G8_MMA(0, 0, At, B0); G8_BAR;
    G8_LDB(B1, 1, 1); G8_WAIT_V(0); G8_BAR; G8_WAIT_L(0); G8_MMA(0, 1, At, B1); G8_BAR;
    G8_LDA(At, 1, 1); G8_BAR; G8_WAIT_L(0); G8_MMA(1, 0, At, B0); G8_MMA(1, 1, At, B1); G8_BAR; }
  if (wr == 0) G8_BAR;
  if (GSCALE) {
    const float* gf = gfac + 768 + wr * 64 + fq * 4;
#pragma unroll
    for (int ai = 0; ai < 2; ++ai)
#pragma unroll
      for (int m = 0; m < 4; ++m) {
        const f32x4 f4 = *(const f32x4*)(gf + ai * 128 + m * 16);
#pragma unroll
        for (int bj = 0; bj < 2; ++bj)
#pragma unroll
          for (int n = 0; n < 2; ++n)
#pragma unroll
            for (int j = 0; j < 4; ++j) acc[ai][bj][m][n][j] *= f4[j];
      }
  }
  if (next_valid) gemm8_prestage(A, Bt, K, next_brow, next_bcol, smem);
  const int wrs = __builtin_amdgcn_readfirstlane(wr), wcs = __builtin_amdgcn_readfirstlane(wc);
  if (EPI == EPI_RES) {
#pragma unroll
    for (int ai = 0; ai < 2; ++ai) {
      const int mrow0 = brow + ai * 128 + wrs * 64;
      const float* xw = (layer == 0 ? (brow < NPROMPT ? p.x_prompt + (size_t)mrow0 * DM : p.x_sample + (size_t)(mrow0 - NPROMPT) * DM) : p.out + (size_t)mrow0 * DM) + bcol + wcs * 32;
      float* ow = p.out + (size_t)mrow0 * DM + bcol + wcs * 32;
      const unsigned lo = (unsigned)(fq * 4) * DM + fr;
      float xv[4][4][4];
#pragma unroll
      for (int m = 0; m < 4; ++m)
#pragma unroll
        for (int j = 0; j < 4; ++j) {
          const float* xr = xw + (lo + (unsigned)((m * 16 + j) * DM));
#pragma unroll
          for (int c = 0; c < 4; ++c) xv[m][j][c] = xr[(c >> 1) * 128 + (c & 1) * 16];
        }
      __builtin_amdgcn_sched_barrier(0);
#pragma unroll
      for (int m = 0; m < 4; ++m)
#pragma unroll
        for (int j = 0; j < 4; ++j) {
          float* orow = ow + (lo + (unsigned)((m * 16 + j) * DM));
#pragma unroll
          for (int c = 0; c < 4; ++c) orow[(c >> 1) * 128 + (c & 1) * 16] = xv[m][j][c] + acc[ai][c >> 1][m][c & 1][j];
        }
      __builtin_amdgcn_sched_barrier(0);
    }
  }
#pragma unroll
  for (int ai = 0; ai < 2 && EPI != EPI_RES; ++ai) {
    const int mrow0 = brow + ai * 128 + wrs * 64;
#pragma unroll
    for (int bj = 0; bj < 2; ++bj) {
      const int ncol0 = bcol + bj * 128 + wcs * 32;
      if (EPI == EPI_SWIGLU) {
        u16* dw = (u16*)(p.ws + OFF_ACT) + (size_t)mrow0 * DFF + (ncol0 >> 1);
        const unsigned lo = (unsigned)(fq * 4) * DFF + fr;
#pragma unroll
        for (int m = 0; m < 4; ++m) {
#pragma unroll
          for (int j = 0; j < 4; ++j) {
            const float g = acc[ai][bj][m][0][j], u = acc[ai][bj][m][1][j];
            const float a = g * __builtin_amdgcn_rcpf(1.f + fexp2(-g * LOG2E)) * u;
            dw[lo + (unsigned)((m * 16 + j) * DFF)] = (u16)(pack2(a, 0.f) & 0xffff);
          }
        }
        __builtin_amdgcn_sched_barrier(0);
      } else if (EPI == EPI_RES) {
      } else {
#pragma unroll
        for (int n = 0; n < 2; ++n) {
          const int nb0 = ncol0 + n * 16;
          if (nb0 < DIN) {
            u16* dw = (u16*)(p.ws + OFF_PROJ) + (size_t)mrow0 * DIN + nb0;
            const unsigned lo = (unsigned)(fq * 4) * DIN + fr;
#pragma unroll
            for (int m = 0; m < 4; ++m)
#pragma unroll
              for (int j = 0; j < 4; ++j) dw[lo + (unsigned)((m * 16 + j) * DIN)] = (u16)(pack2(acc[ai][bj][m][n][j], 0.f) & 0xffff);
          }
          __builtin_amdgcn_sched_barrier(0);
        }
      }
    }
  }
  G8_WAIT_V(0);
  __syncthreads();
}

DI void e1_chunk(const Params& p, int layer, int chunk) {
  const int j = chunk & 7;
  const size_t tok = (size_t)(chunk >> 3) * NTHR + opaque_tid();
  if (j == 7) return;
  u16* proj = (u16*)(p.ws + OFF_PROJ);
  const int t = (int)(tok & 4095);
  if (j < 6) {
    u16* ptr = proj + tok * DIN + (j < 4 ? 768 + 64 * j : 1024 + 64 * (j - 4));
    const float* gain = (j < 4 ? p.b_q_gain : p.b_k_gain) + layer * 64;
    const float post = j < 4 ? QSCALE64 : 1.f;
    float x[64];
    float ss = 0.f;
#pragma unroll
    for (int c = 0; c < 8; ++c) {
      u32x4 w = *(const u32x4*)(ptr + c * 8);
#pragma unroll
      for (int e = 0; e < 4; ++e) { x[c * 8 + 2 * e] = bflo(w[e]); x[c * 8 + 2 * e + 1] = bfhi(w[e]); }
    }
#pragma unroll
    for (int d = 0; d < 64; ++d) ss += x[d] * x[d];
    const float rstd = rsqrtf(ss * (1.f / 64.f) + EPS);
    __builtin_amdgcn_sched_barrier(0);
#pragma unroll
    for (int c = 0; c < 4; ++c) {
#pragma unroll
      for (int d = 0; d < 16; ++d) x[c * 16 + d] = x[c * 16 + d] * rstd * gain[c * 16 + d];
      __builtin_amdgcn_sched_barrier(0);
    }
    const int prow = t >> 6, pcol = t & 63;
    { float* xa = x; float* xb = x + 16; ROPE16(p.ws, prow, xa, xb); }
    __builtin_amdgcn_sched_barrier(0);
    { float* xa = x + 32; float* xb = x + 48; ROPE16(p.ws, pcol, xa, xb); }
    __builtin_amdgcn_sched_barrier(0);
#pragma unroll
    for (int c = 0; c < 8; ++c) {
      u32x4 w;
#pragma unroll
      for (int e = 0; e < 4; ++e) w[e] = pack2(x[c * 8 + 2 * e] * post, x[c * 8 + 2 * e + 1] * post);
      *(u32x4*)(ptr + c * 8) = w;
    }
  } else {
    const u16* src = proj + tok * DIN + 2432;
    float x[32];
#pragma unroll
    for (int c = 0; c < 4; ++c) {
      u32x4 w = *(const u32x4*)(src + c * 8);
#pragma unroll
      for (int e = 0; e < 4; ++e) { x[c * 8 + 2 * e] = bflo(w[e]); x[c * 8 + 2 * e + 1] = bfhi(w[e]); }
    }
    { float* xa = x; float* xb = x + 16; ROPE16(p.ws, t, xa, xb); }
    u16* kd = (u16*)(p.ws + OFF_KD) + tok * 384 + 64;
#pragma unroll
    for (int c = 0; c < 4; ++c) {
      u32x4 w;
#pragma unroll
      for (int e = 0; e < 4; ++e) w[e] = pack2(x[c * 8 + 2 * e], x[c * 8 + 2 * e + 1]);
#pragma unroll
      for (int hh = 0; hh < 4; ++hh) *(u32x4*)(kd + hh * 96 + c * 8) = w;
    }
  }
}

template <int MODE>
DI void attn_tile(const Params& p, int layer, int tile, char* smem) {
  constexpr int DQK = (MODE == 3) ? 96 : 64;
  constexpr int NKQ = DQK / 16;
  constexpr int KROW = DQK + 8;
  constexpr int VROW = 72;
  constexpr int KCH = DQK / 8;
  constexpr int KLD = (64 * KCH + NTHR - 1) / NTHR;
  u16* Ks = (u16*)smem;
  u16* Vs = (u16*)(smem + 26624);
  float* tbl = (float*)(smem + 26624 + 18432);

  const int tid = opaque_tid(), lane = tid & 63, wave = tid >> 6, r = lane & 31, h = lane >> 5;
  const int qb = tile & 15, head = (tile >> 4) & 3, seq = tile >> 6;
  const size_t tok0 = (size_t)seq * SEQ;
  const u16* proj = (const u16*)(p.ws + OFF_PROJ);
  const u16 *Qp, *Kp, *Vp;
  int ldq, ldk, ldv;
  if (MODE == 0) { Qp = proj + 64 * head; Kp = proj + 256 + 64 * head; Vp = proj + 512 + 64 * head; ldq = ldk = ldv = DIN; }
  else if (MODE == 1) { Qp = proj + 768 + 64 * head; Kp = proj + 1024 + 64 * (head >> 1); Vp = proj + 1152 + 64 * (head >> 1); ldq = ldk = ldv = DIN; }
  else if (MODE == 2) { Qp = proj + 1280 + 64 * head; Kp = proj + 1536 + 64 * head; Vp = proj + 1792 + 64 * head; ldq = ldk = ldv = DIN; }
  else { Qp = (const u16*)(p.ws + OFF_QD) + 96 * head; Kp = (const u16*)(p.ws + OFF_KD) + 96 * head; Vp = (const u16*)(p.ws + OFF_VD) + 64 * head; ldq = ldk = 384; ldv = 256; }

  int kt0 = 0, kt1 = 64;
  if (MODE == 0) { kt0 = 4 * qb - 16; if (kt0 < 0) kt0 = 0; kt1 = 4 * qb + 20; if (kt1 > 64) kt1 = 64; }
  if (MODE == 2) { int r0 = 4 * qb - 4; r0 = r0 < 0 ? 0 : (r0 > 56 ? 56 : r0); int r1 = 4 * qb + 3 - 4; r1 = r1 < 0 ? 0 : (r1 > 56 ? 56 : r1); kt0 = r0; kt1 = r1 + 8; }

  if (MODE == 0) { const float* src = (const float*)(p.ws + OFF_TBLA) + head * 2560; for (int i = tid; i < 2560; i += NTHR) tbl[i] = src[i]; }
  if (MODE == 2) { const float* src = p.c_rpb + (size_t)(layer * 4 + head) * 465; for (int i = tid; i < 465; i += NTHR) tbl[i] = src[i] * LOG2E; }

  const int qpos = qb * 256 + wave * 32 + r;
  bf16x8 qf[NKQ];
  {
    const u16* qrow = Qp + (tok0 + qpos) * ldq + 8 * h;
#pragma unroll
    for (int d0 = 0; d0 < NKQ; ++d0) qf[d0] = *(const bf16x8*)(qrow + d0 * 16);
  }
  if (MODE == 3) {
    bf16x8 x1 = qf[NKQ - 2], x2 = qf[NKQ - 1];
    const f32x4* rt = (const f32x4*)(p.ws + OFF_ROPE) + (size_t)qpos * 8 + 4 * h;
#pragma unroll
    for (int j2 = 0; j2 < 4; ++j2) {
      const f32x4 cs4 = rt[j2];
#pragma unroll
      for (int e = 0; e < 2; ++e) {
        const int j = 2 * j2 + e;
        const float c = cs4[2 * e], sn = cs4[2 * e + 1];
        float a = __uint_as_float(((unsigned)(u16)x1[j]) << 16), b = __uint_as_float(((unsigned)(u16)x2[j]) << 16);
        unsigned w = pack2(a * c - b * sn, a * sn + b * c);
        x1[j] = (short)(w & 0xffff); x2[j] = (short)(w >> 16);
      }
    }
    qf[NKQ - 2] = x1; qf[NKQ - 1] = x2;
  }

  u32x4 rk0[KLD], rv0, rk1[KLD], rv1;
  const u16* Kt = Kp + tok0 * ldk;
  const u16* Vt = Vp + tok0 * ldv;
  unsigned koff[KLD];
#pragma unroll
  for (int pp = 0; pp < KLD; ++pp) { int c = tid + NTHR * pp; if (c >= 64 * KCH) c = tid; const int row = c / KCH, col = c % KCH; koff[pp] = (unsigned)row * ldk + col * 8; }
  const unsigned voff = (unsigned)(tid >> 3) * ldv + (tid & 7) * 8;
  const int ktl = kt1 - 1;
  auto gload = [&](u32x4 (&rk)[KLD], u32x4& rv, int kt) {
    kt = kt < ktl ? kt : ktl;
#pragma unroll
    for (int pp = 0; pp < KLD; ++pp) rk[pp] = *(const u32x4*)(Kt + (koff[pp] + (unsigned)(kt * 64) * ldk));
    rv = *(const u32x4*)(Vt + (voff + (unsigned)(kt * 64) * ldv));
  };
  auto lstore = [&](u32x4 (&rk)[KLD], u32x4& rv, int buf) {
#pragma unroll
    for (int pp = 0; pp < KLD; ++pp) { const int c = tid + NTHR * pp; if (c < 64 * KCH) { const int row = c / KCH, col = c % KCH; *(u32x4*)(Ks + (buf * 64 + row) * KROW + col * 8) = rk[pp]; } }
    *(u32x4*)(Vs + (buf * 64 + (tid >> 3)) * VROW + (tid & 7) * 8) = rv;
  };

  f32x16 o0, o1, negm;
#pragma unroll
  for (int i = 0; i < 16; ++i) { o0[i] = 0.f; o1[i] = 0.f; negm[i] = 0.f; }
  float mref = 0.f, lsum = 0.f;
  bool started = false;
  int qr = 0, qc = 0, cs = 0, rs = 0;
  if (MODE == 2) { qr = qpos >> 6; qc = qpos & 63; cs = qc - 8; cs = cs < 0 ? 0 : (cs > 48 ? 48 : cs); rs = qr - 4; rs = rs < 0 ? 0 : (rs > 56 ? 56 : rs); }
  const int i16 = lane & 15, qq = i16 >> 2, pp4 = i16 & 3, g16 = (lane >> 4) & 1;

  auto compute = [&](int buf, int kt) {
    bool active = true;
    if (MODE == 2) active = (kt >= rs) && (kt < rs + 8);
    if (active) {
      const u16* Kb = Ks + buf * 64 * KROW + r * KROW + 8 * h;
      const u16* Vb = Vs + buf * 64 * VROW;
      bf16x8 vf[8];
#pragma unroll
      for (int cs2 = 0; cs2 < 4; ++cs2) {
        const u16* vp = Vb + (16 * cs2 + 4 * h + qq) * VROW + 16 * g16 + 4 * pp4;
        { s16x4 lo = tr_read(vp), hi = tr_read(vp + 8 * VROW); vf[2 * cs2] = __builtin_shufflevector(lo, hi, 0, 1, 2, 3, 4, 5, 6, 7); }
        { s16x4 lo = tr_read(vp + 32), hi = tr_read(vp + 8 * VROW + 32); vf[2 * cs2 + 1] = __builtin_shufflevector(lo, hi, 0, 1, 2, 3, 4, 5, 6, 7); }
      }
      f32x16 s0 = negm, s1 = negm;
#pragma unroll
      for (int d0 = 0; d0 < NKQ; ++d0) {
        bf16x8 k0 = *(const bf16x8*)(Kb + d0 * 16);
        bf16x8 k1 = *(const bf16x8*)(Kb + 32 * KROW + d0 * 16);
        s0 = mfma(k0, qf[d0], s0);
        s1 = mfma(k1, qf[d0], s1);
      }
      if (MODE == 0) {
        const float* tb = tbl + (kt * 64 + 4 * h - qpos + 1280);
#pragma unroll
        for (int i = 0; i < 16; ++i) { s0[i] += tb[(i & 3) + 8 * (i >> 2)]; s1[i] += tb[32 + (i & 3) + 8 * (i >> 2)]; }
      }
      if (MODE == 2) {
        const float* tb = tbl + (kt - qr + 7) * 31 + (15 - qc);
#pragma unroll
        for (int i = 0; i < 16; ++i) {
          const int kc0 = 4 * h + (i & 3) + 8 * (i >> 2), kc1 = kc0 + 32;
          const bool v0 = (kc0 >= cs) && (kc0 < cs + 16), v1 = (kc1 >= cs) && (kc1 < cs + 16);
          const float b0 = tb[v0 ? kc0 : qc], b1 = tb[v1 ? kc1 : qc];
          s0[i] = v0 ? s0[i] + b0 : NEGBIG;
          s1[i] = v1 ? s1[i] + b1 : NEGBIG;
        }
      }
      float ma = __builtin_fmaxf(__builtin_fmaxf(s0[0], s0[1]), s0[2]), mb = __builtin_fmaxf(__builtin_fmaxf(s1[0], s1[1]), s1[2]);
#pragma unroll
      for (int i = 3; i < 15; i += 2) { ma = __builtin_fmaxf(__builtin_fmaxf(ma, s0[i]), s0[i + 1]); mb = __builtin_fmaxf(__builtin_fmaxf(mb, s1[i]), s1[i + 1]); }
      float mt = __builtin_fmaxf(__builtin_fmaxf(ma, s0[15]), s1[15]);
      mt = hmax(__builtin_fmaxf(mt, mb));
      const bool fresh = !started && (mt > -1e29f);
      if (__any(fresh || (started && mt > 8.f))) {
        float delta = 0.f, al = 1.f;
        if (fresh) { delta = mt; started = true; }
        else if (started) { delta = __builtin_fmaxf(mt, 0.f); al = fexp2(-delta); }
        mref += delta;
        lsum *= al;
#pragma unroll
        for (int i = 0; i < 16; ++i) { o0[i] *= al; o1[i] *= al; s0[i] -= delta; s1[i] -= delta; negm[i] = -mref; }
      }
      float ps = 0.f;
#pragma unroll
      for (int i = 0; i < 16; ++i) { s0[i] = fexp2(s0[i]); s1[i] = fexp2(s1[i]); ps += s0[i] + s1[i]; }
      lsum += ps;
#pragma unroll
      for (int c = 0; c < 2; ++c) {
#pragma unroll
        for (int s = 0; s < 2; ++s) {
          u32x4 pw;
          if (c == 0) pw = (u32x4){pack2(s0[8 * s], s0[8 * s + 1]), pack2(s0[8 * s + 2], s0[8 * s + 3]), pack2(s0[8 * s + 4], s0[8 * s + 5]), pack2(s0[8 * s + 6], s0[8 * s + 7])};
          else pw = (u32x4){pack2(s1[8 * s], s1[8 * s + 1]), pack2(s1[8 * s + 2], s1[8 * s + 3]), pack2(s1[8 * s + 4], s1[8 * s + 5]), pack2(s1[8 * s + 6], s1[8 * s + 7])};
          const bf16x8 pf = __builtin_bit_cast(bf16x8, pw);
          o0 = mfma(vf[2 * (2 * c + s)], pf, o0);
          o1 = mfma(vf[2 * (2 * c + s) + 1], pf, o1);
        }
      }
    }
  };

  const int ntile = kt1 - kt0;
  gload(rk0, rv0, kt0);
  lstore(rk0, rv0, 0);
  gload(rk0, rv0, kt0 + 1);
  gload(rk1, rv1, kt0 + 2);
  __syncthreads();
  for (int j = 0; j < ntile; j += 2) {
    compute(0, kt0 + j);
    lstore(rk0, rv0, 1);
    gload(rk0, rv0, kt0 + j + 3);
    __syncthreads();
    if (j + 1 >= ntile) break;
    compute(1, kt0 + j + 1);
    lstore(rk1, rv1, 0);
    gload(rk1, rv1, kt0 + j + 4);
    __syncthreads();
  }
  lsum = hsum(lsum);
  const float inv = 1.f / lsum;
  float sq = 0.f;
#pragma unroll
  for (int i = 0; i < 16; ++i) { o0[i] *= inv; o1[i] *= inv; sq += o0[i] * o0[i] + o1[i] * o1[i]; }
  sq = hsum(sq);
  if (h == 0) ((float*)(p.ws + OFF_SSQ))[(tok0 + qpos) * 16 + MODE * 4 + head] = sq;
  u16* op = (u16*)(p.ws + OFF_ACTB) + (tok0 + qpos) * DM + MODE * 256 + head * 64 + 4 * h;
#pragma unroll
  for (int g4 = 0; g4 < 4; ++g4) {
    u32x2 w0 = {pack2(o0[4 * g4], o0[4 * g4 + 1]), pack2(o0[4 * g4 + 2], o0[4 * g4 + 3])};
    u32x2 w1 = {pack2(o1[4 * g4], o1[4 * g4 + 1]), pack2(o1[4 * g4 + 2], o1[4 * g4 + 3])};
    *(u32x2*)(op + 8 * g4) = w0;
    *(u32x2*)(op + 32 + 8 * g4) = w1;
  }
}


DI bool sb_tile(int bid, int nb, int it, int NT, int& mt, int& nt) {
  const int G = nb >> 3, x = bid & 7, l = bid >> 3;
  const int s = l + it * G;
  const int sb = (s >> 5) * 8 + x, w = s & 31;
  if (NT == 4) {
    if (sb >= 48) return false;
    mt = sb * 8 + (w >> 2); nt = w & 3;
    return true;
  }
  const int NG = NT >> 1;
  if (sb >= 24 * NG) return false;
  const int mg = sb / NG, ng = sb - mg * NG;
  mt = mg * 16 + (w >> 1); nt = ng * 2 + (w & 1);
  return true;
}

DI bool att_tile_index(int bid, int nb, int it, int& tile) {
  if (nb != 256) { tile = bid + it * nb; return tile < 1536; }
  const int x = bid & 7, l = bid >> 3;
  const int pair = 2 * (it * 8 + x) + (l >> 4);
  tile = pair * 16 + ((l + 3 * it) & 15);
  return pair < 96;
}

template <int EPI, bool GSCALE = false>
DI void gemm8_phase(const Params& p, int layer, const u16* A, const u16* Bt, int K, int NT, char* smem) {
  const int bid = blockIdx.x, nb = gridDim.x;
  int mt, nt;
  bool have = sb_tile(bid, nb, 0, NT, mt, nt);
  if (have) gemm8_prestage(A, Bt, K, mt * 256, nt * 256, smem);
  for (int it = 0; have; ++it) {
    int mt2 = 0, nt2 = 0;
    const bool have2 = sb_tile(bid, nb, it + 1, NT, mt2, nt2);
    gemm8_tile<EPI, GSCALE>(p, layer, A, Bt, K, mt * 256, nt * 256, smem, have2, mt2 * 256, nt2 * 256);
    have = have2; mt = mt2; nt = nt2;
  }
}

constexpr int NPHASE = 17;
constexpr int MT = T_TOK / 256;

DI void run_phase(const Params& p, int ph, char* smem) {
  const int bid = blockIdx.x, nb = gridDim.x;
  u16* wtb = (u16*)(p.ws + OFF_WT);
  const u16* actb = (const u16*)(p.ws + OFF_ACTB);
  if (ph == 0) {
    for (int j = bid; j < 128; j += nb) rope_tab_build(p.ws, j * NTHR + opaque_tid());
    for (int j = bid; j < WJ_TOTAL; j += nb) wprep_job(p, j, smem);
    for (int rb = bid; rb < T_TOK / 16; rb += nb) norm_rows(p, 0, rb, 0);
    return;
  }
  if (ph == 16) { for (int rb = bid; rb < T_TOK / 16; rb += nb) norm_rows(p, 1, rb, 1); return; }
  const int layer = (ph - 1) >> 3, sub = (ph - 1) & 7;
  const u16* wl = wtb + (size_t)layer * WT_LAYER;
  switch (sub) {
    case 0:
      gemm8_phase<EPI_PROJ>(p, layer, actb, wl + WT_IN, 1024, 10, smem);
      break;
    case 1:
      for (int c = bid; c < (T_TOK / NTHR) * 8; c += nb) e1_chunk(p, layer, c);
      for (int t = bid; t < MT * 2; t += nb) { const int nt = t & 1, mt = t >> 1; gemm_tile<EPI_UQ, false, true>(p, layer, (const u16*)(p.ws + OFF_PROJ) + 2048, DIN, wl + WT_UQ, 256, mt * 256, nt * 256, smem); }
      for (int t = bid; t < MT * 2; t += nb) { const int nt = t & 1, mt = t >> 1; gemm_tile<EPI_UKV, false, true>(p, layer, (const u16*)(p.ws + OFF_PROJ) + 2304, DIN, wl + WT_UKV, 128, mt * 256, nt * 256, smem); }
      break;
    case 2:
      for (int it = 0, t; att_tile_index(bid, nb, it, t); ++it) attn_tile<3>(p, layer, t, smem);
      for (int it = 0, t; att_tile_index(bid, nb, it, t); ++it) attn_tile<1>(p, layer, t, smem);
      for (int it = 0, t; att_tile_index(bid, nb, it, t); ++it) attn_tile<0>(p, layer, t, smem);
      for (int it = 0, t; att_tile_index(bid, nb, it, t); ++it) attn_tile<2>(p, layer, t, smem);
      break;
    case 3:
      gemm8_phase<EPI_RES, true>(p, layer, actb, wl + WT_OUT, 1024, 4, smem);
      break;
    case 4:
      for (int rb = bid; rb < T_TOK / 16; rb += nb) norm_rows(p, 1, rb, 0);
      break;
    case 5:
      gemm8_phase<EPI_SWIGLU>(p, layer, actb, wl + WT_GU, 1024, 22, smem);
      break;
    case 6:
      gemm8_phase<EPI_RES>(p, 1, (const u16*)(p.ws + OFF_ACT), wl + WT_DN, DFF, 4, smem);
      break;
    case 7:
      for (int rb = bid; rb < T_TOK / 16; rb += nb) norm_rows(p, 1, rb, 0);
      break;
  }
}

__global__ void __launch_bounds__(NTHR, 2) mega(Params p, int ph_lo, int ph_hi) {
  __shared__ __attribute__((aligned(16))) char smem[SMEM_BYTES];
  cg::grid_group grid = cg::this_grid();
  for (int ph = ph_lo; ph < ph_hi; ++ph) {
    if (ph > ph_lo) grid.sync();
    run_phase(p, ph, smem);
#ifdef DUPMASK
    if (ph >= 1 && ph < 16 && ((DUPMASK >> ((ph - 1) & 7)) & 1)) { grid.sync(); run_phase(p, ph, smem); }
#endif
  }
}

extern "C" void kernel_launch(void* const* d_in, const int* in_sizes, int n_in, void* d_out, int out_size, void* d_ws, size_t ws_size, hipStream_t stream) {
  Params p{};
  p.x_prompt = (const float*)d_in[0]; p.x_sample = (const float*)d_in[1]; p.t5_bias = (const float*)d_in[2]; p.norm_mix = (const float*)d_in[3];
  p.w_in = (const float*)d_in[4]; p.b_q_gain = (const float*)d_in[5]; p.b_k_gain = (const float*)d_in[6]; p.c_rpb = (const float*)d_in[7];
  p.d_q_gain = (const float*)d_in[8]; p.d_w_uq = (const float*)d_in[9]; p.d_kv_gain = (const float*)d_in[10]; p.d_w_ukv = (const float*)d_in[11];
  p.out_gain = (const float*)d_in[12]; p.w_out = (const float*)d_in[13]; p.norm_ffn = (const float*)d_in[14]; p.w_gate = (const float*)d_in[15];
  p.w_up = (const float*)d_in[16]; p.w_down = (const float*)d_in[17]; p.final_norm = (const float*)d_in[18];
  p.out = (float*)d_out; p.ws = (char*)d_ws;
  if (ws_size < WS_NEED) { fprintf(stderr, "workspace too small: %zu < %zu\n", ws_size, (size_t)WS_NEED); return; }
  static int grid_blocks = 0;
  if (!grid_blocks) {
    int dev = 0, cus = 0, per_cu = 0;
    hipGetDevice(&dev);
    hipDeviceGetAttribute(&cus, hipDeviceAttributeMultiprocessorCount, dev);
    hipOccupancyMaxActiveBlocksPerMultiprocessor(&per_cu, mega, NTHR, 0);
    if (per_cu < 1) per_cu = 1;
    if (per_cu > 1) per_cu = 1;
    grid_blocks = cus * per_cu;
  }
#if ONE_LAUNCH
  int lo = 0, hi = NPHASE;
  void* args[] = {&p, &lo, &hi};
  hipError_t e = hipLaunchCooperativeKernel((void*)mega, dim3(grid_blocks), dim3(NTHR), args, 0, stream);
  if (e != hipSuccess) fprintf(stderr, "cooperative launch failed: %s (grid %d)\n", hipGetErrorString(e), grid_blocks);
#else
  for (int ph = 0; ph < NPHASE; ++ph) hipLaunchKernelGGL(mega, dim3(grid_blocks), dim3(NTHR), 0, stream, p, ph, ph + 1);
#endif
}
```

```cpp
#include <hip/hip_runtime.h>
#include <hip/hip_cooperative_groups.h>
#include <cstdio>
#include <cstdint>
namespace cg = cooperative_groups;

#ifndef ONE_LAUNCH
#define ONE_LAUNCH 1
#endif

#define DI __device__ __forceinline__
typedef short bf16x8 __attribute__((ext_vector_type(8)));
typedef short s16x4 __attribute__((ext_vector_type(4)));
typedef float f32x16 __attribute__((ext_vector_type(16)));
typedef float f32x4 __attribute__((ext_vector_type(4)));
typedef float f32x2 __attribute__((ext_vector_type(2)));
typedef unsigned u32x4 __attribute__((ext_vector_type(4)));
typedef unsigned u32x2 __attribute__((ext_vector_type(2)));
typedef __bf16 bf16v2 __attribute__((ext_vector_type(2)));
typedef unsigned short u16;

constexpr int T_TOK = 98304, SEQ = 4096, DM = 1024, DIN = 2464, DINP = 2560, DFF = 2816;
constexpr int NPROMPT = 8 * 4096;
constexpr int NTHR = 512;
constexpr float LOG2E = 1.4426950408889634f;
constexpr float QSCALE64 = 0.125f * LOG2E;
constexpr float QSCALE96 = 0.10206207261596575f * LOG2E;
constexpr float NEGBIG = -1e30f;
constexpr float EPS = 1e-6f;

constexpr size_t al256(size_t x) { return (x + 255) & ~(size_t)255; }
constexpr size_t WT_IN = 0;
constexpr size_t WT_UQ = WT_IN + (size_t)DINP * 1024;
constexpr size_t WT_UKV = WT_UQ + 512 * 256;
constexpr size_t WT_OUT = WT_UKV + 512 * 128;
constexpr size_t WT_GU = WT_OUT + 1024 * 1024;
constexpr size_t WT_DN = WT_GU + (size_t)5632 * 1024;
constexpr size_t WT_LAYER = WT_DN + (size_t)1024 * 2816;
constexpr size_t OFF_WT = 0;
constexpr size_t OFF_TBLA = al256(OFF_WT + 2 * WT_LAYER * 2);
constexpr size_t OFF_ROPE = al256(OFF_TBLA + 4 * 2560 * 4);
constexpr size_t OFF_ACTB = al256(OFF_ROPE + 4096 * 16 * 8);
constexpr size_t OFF_PROJ = al256(OFF_ACTB + (size_t)T_TOK * 1024 * 2);
constexpr size_t OFF_QD = al256(OFF_PROJ + (size_t)T_TOK * DIN * 2);
constexpr size_t OFF_KD = al256(OFF_QD + (size_t)T_TOK * 384 * 2);
constexpr size_t OFF_VD = al256(OFF_KD + (size_t)T_TOK * 384 * 2);
constexpr size_t OFF_SSQ = al256(OFF_VD + (size_t)T_TOK * 256 * 2);
constexpr size_t WS_NEED = al256(OFF_SSQ + (size_t)T_TOK * 16 * 4);
constexpr size_t OFF_ACT = OFF_PROJ;
static_assert(OFF_ACT + (size_t)T_TOK * DFF * 2 <= OFF_KD, "act alias overflow");

struct Params {
  const float *x_prompt, *x_sample, *t5_bias, *norm_mix, *w_in, *b_q_gain, *b_k_gain, *c_rpb, *d_q_gain, *d_w_uq,
      *d_kv_gain, *d_w_ukv, *out_gain, *w_out, *norm_ffn, *w_gate, *w_up, *w_down, *final_norm;
  float* out;
  char* ws;
};

constexpr int SMEM_BYTES = 2 * (256 + 256) * 72 * 2 + 1024;

DI unsigned pack2(float a, float b) { f32x2 v = {a, b}; bf16v2 r = __builtin_convertvector(v, bf16v2); return __builtin_bit_cast(unsigned, r); }
DI float bflo(unsigned w) { return __uint_as_float(w << 16); }
DI float bfhi(unsigned w) { return __uint_as_float(w & 0xffff0000u); }
DI f32x16 mfma(bf16x8 a, bf16x8 b, f32x16 c) { return __builtin_amdgcn_mfma_f32_32x32x16_bf16(a, b, c, 0, 0, 0); }
DI float hmax(float v) {
  auto rr = __builtin_amdgcn_permlane32_swap(__float_as_uint(v), __float_as_uint(v), false, false);
  return __builtin_fmaxf(__uint_as_float(rr[0]), __uint_as_float(rr[1]));
}
DI float hsum(float v) {
  auto rr = __builtin_amdgcn_permlane32_swap(__float_as_uint(v), __float_as_uint(v), false, false);
  return __uint_as_float(rr[0]) + __uint_as_float(rr[1]);
}
DI float fexp2(float x) { return __builtin_amdgcn_exp2f(x); }
DI int crow(int i, int h) { return (i & 3) + 8 * (i >> 2) + 4 * h; }
typedef short v4i16_t __attribute__((ext_vector_type(4)));
DI s16x4 tr_read(const u16* p) {
  return __builtin_bit_cast(s16x4, __builtin_amdgcn_ds_read_tr16_b64_v4i16((__attribute__((address_space(3))) v4i16_t*)p));
}
constexpr double inv_rev_c(int i) {
  constexpr double b[4] = {1.0, 0.5623413251903491, 0.31622776601683794, 0.1778279410038923};
  double v = b[i & 3];
  for (int k = 0; k < (i >> 2); ++k) v *= 0.1;
  return v * 0.15915494309189535;
}
DI void rope_tab_build(char* ws, int idx) {
  const int pos = idx >> 4, i = idx & 15;
  double invrev = inv_rev_c(0);
#pragma unroll
  for (int k = 1; k < 16; ++k) if (i == k) invrev = inv_rev_c(k);
  double rev = (double)pos * invrev;
  float f = (float)(rev - (double)(int)rev);
  f32x2 cs = {__builtin_amdgcn_cosf(f), __builtin_amdgcn_sinf(f)};
  ((f32x2*)(ws + OFF_ROPE))[idx] = cs;
}
#define ROPE16(ws_, pos_, A_, B_)                                                              \
  {                                                                                            \
    const f32x4* rt_ = (const f32x4*)((ws_) + OFF_ROPE) + (size_t)(pos_) * 8;                  \
    _Pragma("unroll") for (int i2_ = 0; i2_ < 8; ++i2_) {                                      \
      const f32x4 cs_ = rt_[i2_];                                                              \
      float a_ = A_[2 * i2_], b_ = B_[2 * i2_];                                                \
      A_[2 * i2_] = a_ * cs_[0] - b_ * cs_[1]; B_[2 * i2_] = a_ * cs_[1] + b_ * cs_[0];        \
      a_ = A_[2 * i2_ + 1]; b_ = B_[2 * i2_ + 1];                                              \
      A_[2 * i2_ + 1] = a_ * cs_[2] - b_ * cs_[3]; B_[2 * i2_ + 1] = a_ * cs_[3] + b_ * cs_[2]; \
    }                                                                                          \
  }
DI const float* xrow(const Params& p, int layer, size_t tok) {
  if (layer == 0) return tok < (size_t)NPROMPT ? p.x_prompt + tok * DM : p.x_sample + (tok - NPROMPT) * DM;
  return p.out + tok * DM;
}

DI int opaque_tid() { int t = threadIdx.x; asm volatile("" : "+v"(t)); return t; }
DI void wt_tile(const float* __restrict__ W, int K, int N, const float* __restrict__ g, u16* __restrict__ Wt, int k0, int n0, int mapmode, float* tile) {
  const int tid = opaque_tid();
  for (int i = tid; i < 4096; i += NTHR) {
    int kk = i >> 6, nn = i & 63, n = n0 + nn;
    float v = 0.f;
    if (n < N) { v = W[(size_t)(k0 + kk) * N + n]; if (g) v *= g[k0 + kk]; }
    tile[kk * 65 + nn] = v;
  }
  __syncthreads();
  for (int i = tid; i < 2048; i += NTHR) {
    int nn = i >> 5, kp = i & 31, n = n0 + nn;
    float cs = 1.f; int drow = n;
    if (mapmode == 1) { if (n < 256 || (n >= 1280 && n < 1536)) cs = QSCALE64; }
    else if (mapmode == 2) cs = QSCALE96;
    else if (mapmode == 3) drow = 32 * (n >> 4) + (n & 15);
    else if (mapmode == 4) drow = 32 * (n >> 4) + 16 + (n & 15);
    unsigned w = pack2(tile[(2 * kp) * 65 + nn] * cs, tile[(2 * kp + 1) * 65 + nn] * cs);
    *(unsigned*)(Wt + (size_t)drow * K + k0 + 2 * kp) = w;
  }
  __syncthreads();
}

constexpr int WJ_IN = 640, WJ_UQ = 32, WJ_UKV = 16, WJ_OUT = 256, WJ_G = 704, WJ_U = 704, WJ_D = 704;
constexpr int WJ_LAYER = WJ_IN + WJ_UQ + WJ_UKV + WJ_OUT + WJ_G + WJ_U + WJ_D;
constexpr int WJ_TOTAL = 2 * WJ_LAYER + 20;

DI void wprep_job(const Params& p, int job, char* smem) {
  float* tile = (float*)smem;
  u16* wtb = (u16*)(p.ws + OFF_WT);
  if (job >= 2 * WJ_LAYER) {
    int idx = (job - 2 * WJ_LAYER) * NTHR + opaque_tid();
    int head = idx / 2560, e = idx % 2560, d = e - 1280, n = d < 0 ? -d : d;
    int mult = (n <= 64 ? 1 : 0) + (((n & 3) == 0 && n <= 256) ? 1 : 0) + (((n & 15) == 0 && n <= 1024) ? 1 : 0);
    float v = NEGBIG;
    if (mult > 0) {
      int bk;
      if (n < 8) bk = n;
      else { float nf = (float)n; int lg = 8 + (int)(__logf(nf * 0.125f) / 4.852030263919617f * 8.0f); bk = lg < 15 ? lg : 15; }
      if (d > 0) bk += 16;
      v = (p.t5_bias[bk * 4 + head] + __logf((float)mult)) * LOG2E;
    }
    ((float*)(p.ws + OFF_TBLA))[idx] = v;
    return;
  }
  int layer = job / WJ_LAYER, j = job % WJ_LAYER;
  u16* wl = wtb + (size_t)layer * WT_LAYER;
  if (j < WJ_IN) { int kt = j & 15, nt = j >> 4; wt_tile(p.w_in + (size_t)layer * 1024 * DIN, 1024, DIN, p.norm_mix + layer * 1024, wl + WT_IN, kt * 64, nt * 64, 1, tile); return; }
  j -= WJ_IN;
  if (j < WJ_UQ) { int kt = j & 3, nt = j >> 2; wt_tile(p.d_w_uq + (size_t)layer * 256 * 384, 256, 384, p.d_q_gain + layer * 256, wl + WT_UQ, kt * 64, nt * 64, 2, tile); return; }
  j -= WJ_UQ;
  if (j < WJ_UKV) { int kt = j & 1, nt = j >> 1; wt_tile(p.d_w_ukv + (size_t)layer * 128 * 512, 128, 512, p.d_kv_gain + layer * 128, wl + WT_UKV, kt * 64, nt * 64, 0, tile); return; }
  j -= WJ_UKV;
  if (j < WJ_OUT) { int kt = j & 15, nt = j >> 4; wt_tile(p.w_out + (size_t)layer * 1024 * 1024, 1024, 1024, p.out_gain + layer * 1024, wl + WT_OUT, kt * 64, nt * 64, 0, tile); return; }
  j -= WJ_OUT;
  if (j < WJ_G) { int kt = j & 15, nt = j >> 4; wt_tile(p.w_gate + (size_t)layer * 1024 * DFF, 1024, DFF, p.norm_ffn + layer * 1024, wl + WT_GU, kt * 64, nt * 64, 3, tile); return; }
  j -= WJ_G;
  if (j < WJ_U) { int kt = j & 15, nt = j >> 4; wt_tile(p.w_up + (size_t)layer * 1024 * DFF, 1024, DFF, p.norm_ffn + layer * 1024, wl + WT_GU, kt * 64, nt * 64, 4, tile); return; }
  j -= WJ_U;
  { int kt = j % 44, nt = j / 44; wt_tile(p.w_down + (size_t)layer * DFF * 1024, DFF, 1024, nullptr, wl + WT_DN, kt * 64, nt * 64, 0, tile); }
}

constexpr int NRW = 4;
DI void norm_rows(const Params& p, int layer, int rb, int mode) {
  const int tid = opaque_tid();
  const int lane = tid & 63, wave = tid >> 6;
  const size_t rowb = (size_t)rb * (8 * NRW) + wave;
  f32x4 v[NRW][4];
#pragma unroll
  for (int rr = 0; rr < NRW; ++rr) {
    const float* src = xrow(p, layer, rowb + 8 * rr);
#pragma unroll
    for (int i = 0; i < 4; ++i) v[rr][i] = __builtin_nontemporal_load((const f32x4*)(src + lane * 4 + 256 * i));
  }
#pragma unroll
  for (int rr = 0; rr < NRW; ++rr) {
    float ss = 0.f;
#pragma unroll
    for (int i = 0; i < 4; ++i) ss += v[rr][i][0] * v[rr][i][0] + v[rr][i][1] * v[rr][i][1] + v[rr][i][2] * v[rr][i][2] + v[rr][i][3] * v[rr][i][3];
#pragma unroll
    for (int o = 1; o < 64; o <<= 1) ss += __shfl_xor(ss, o);
    const float rstd = rsqrtf(ss * (1.f / 1024.f) + EPS);
    const size_t row = rowb + 8 * rr;
    if (mode == 0) {
      u16* dst = (u16*)(p.ws + OFF_ACTB) + row * DM;
#pragma unroll
      for (int i = 0; i < 4; ++i) { u32x2 w = {pack2(v[rr][i][0] * rstd, v[rr][i][1] * rstd), pack2(v[rr][i][2] * rstd, v[rr][i][3] * rstd)}; *(u32x2*)(dst + lane * 4 + 256 * i) = w; }
    } else {
      float* dst = p.out + row * DM;
#pragma unroll
      for (int i = 0; i < 4; ++i) { f32x4 g = *(const f32x4*)(p.final_norm + lane * 4 + 256 * i); f32x4 o = {v[rr][i][0] * rstd * g[0], v[rr][i][1] * rstd * g[1], v[rr][i][2] * rstd * g[2], v[rr][i][3] * rstd * g[3]}; __builtin_nontemporal_store(o, (f32x4*)(dst + lane * 4 + 256 * i)); }
    }
  }
}

enum { EPI_PROJ = 0, EPI_UQ = 1, EPI_UKV = 2, EPI_RES = 3, EPI_SWIGLU = 4 };
constexpr int GS = 72;
constexpr int BM = 256;
constexpr int TMW = 4;

template <int EPI, bool ASCALE, bool ROWNORM>
DI void gemm_tile(const Params& p, int layer, const u16* __restrict__ A, int lda, const u16* __restrict__ Wt, int K, int m0, int n0, char* smem) {
  u16* As = (u16*)smem;
  u16* Bs = As + 2 * BM * GS;
  float* rowscale = (float*)(Bs + 2 * 256 * GS);
  const int tid = opaque_tid(), lane = tid & 63, wave = tid >> 6, r = lane & 31, h = lane >> 5;
  const int wm = wave >> 2, wn = wave & 3;
  const int lrow = tid >> 3, kc = tid & 7;
  const u16* At = A + (size_t)m0 * lda;
  const u16* Bt = Wt + (size_t)n0 * K;
  const unsigned aoff = (unsigned)lrow * lda + kc * 8, boff = (unsigned)lrow * K + kc * 8;
  const float* ssq = (const float*)(p.ws + OFF_SSQ);

  if (ROWNORM) {
    const int rr = tid >> 1, half = tid & 1;
    const u16* src = A + (size_t)(m0 + rr) * lda + half * (K / 2);
    float ss = 0.f;
    for (int i = 0; i < K / 16; ++i) {
      u32x4 w = *(const u32x4*)(src + i * 8);
#pragma unroll
      for (int e = 0; e < 4; ++e) { float a = bflo(w[e]), b = bfhi(w[e]); ss += a * a + b * b; }
    }
    ss += __shfl_xor(ss, 1);
    if (half == 0) rowscale[rr] = rsqrtf(ss / (float)K + EPS);
  }

  f32x16 acc[TMW][2];
#pragma unroll
  for (int a = 0; a < TMW; ++a)
#pragma unroll
    for (int b = 0; b < 2; ++b)
#pragma unroll
      for (int i = 0; i < 16; ++i) acc[a][b][i] = 0.f;

  u32x4 ra[4], rb[4];
  float sc[4] = {1.f, 1.f, 1.f, 1.f};
  const int KT = K / 64;
  auto gload = [&](int kt) {
#pragma unroll
    for (int pp = 0; pp < 4; ++pp) ra[pp] = *(const u32x4*)(At + (size_t)(64 * pp) * lda + (aoff + (unsigned)kt * 64));
#pragma unroll
    for (int pp = 0; pp < 4; ++pp) rb[pp] = *(const u32x4*)(Bt + (size_t)(64 * pp) * K + (boff + (unsigned)kt * 64));
  };
  auto lstore = [&](int buf, int kt) {
    if (ASCALE) {
      if ((kt & 3) == 0) {
        const int g = kt >> 2;
#pragma unroll
        for (int pp = 0; pp < 4; ++pp) {
          f32x4 s4 = *(const f32x4*)(ssq + (size_t)(m0 + lrow + 64 * pp) * 16 + 4 * g);
          sc[pp] = rsqrtf((s4[0] + s4[1] + s4[2] + s4[3]) * (1.f / 256.f) + EPS);
        }
      }
#pragma unroll
      for (int pp = 0; pp < 4; ++pp)
#pragma unroll
        for (int e = 0; e < 4; ++e) ra[pp][e] = pack2(bflo(ra[pp][e]) * sc[pp], bfhi(ra[pp][e]) * sc[pp]);
    }
#pragma unroll
    for (int pp = 0; pp < 4; ++pp) *(u32x4*)(As + (buf * BM + lrow + 64 * pp) * GS + kc * 8) = ra[pp];
#pragma unroll
    for (int pp = 0; pp < 4; ++pp) *(u32x4*)(Bs + (buf * 256 + lrow + 64 * pp) * GS + kc * 8) = rb[pp];
  };
  auto compute = [&](int buf) {
    const u16* Ab = As + (buf * BM + wm * 128 + r) * GS + 8 * h;
    const u16* Bb = Bs + (buf * 256 + wn * 64 + r) * GS + 8 * h;
#pragma unroll
    for (int ks = 0; ks < 4; ++ks) {
      bf16x8 b0 = *(const bf16x8*)(Bb + ks * 16);
      bf16x8 b1 = *(const bf16x8*)(Bb + 32 * GS + ks * 16);
#pragma unroll
      for (int tm = 0; tm < TMW; ++tm) {
        bf16x8 a = *(const bf16x8*)(Ab + tm * 32 * GS + ks * 16);
        acc[tm][0] = mfma(a, b0, acc[tm][0]);
        acc[tm][1] = mfma(a, b1, acc[tm][1]);
      }
    }
  };
  gload(0);
  lstore(0, 0);
  if (KT > 1) gload(1);
  __syncthreads();
  for (int kt = 0; kt < KT; ++kt) {
    compute(kt & 1);
    if (kt + 1 < KT) lstore((kt + 1) & 1, kt + 1);
    if (kt + 2 < KT) gload(kt + 2);
    __syncthreads();
  }

  const int wms = __builtin_amdgcn_readfirstlane(wm), wns = __builtin_amdgcn_readfirstlane(wn);
  const int mrow0 = m0 + wms * 128;
  const int nwb = n0 + wns * 64;
  if (ROWNORM) {
#pragma unroll
    for (int tm = 0; tm < TMW; ++tm) {
#pragma unroll
      for (int i = 0; i < 16; ++i) {
        const float rs = rowscale[wms * 128 + 4 * h + 32 * tm + (i & 3) + 8 * (i >> 2)];
        acc[tm][0][i] *= rs; acc[tm][1][i] *= rs;
      }
    }
  }
  if (EPI == EPI_SWIGLU) {
    u16* dw = (u16*)(p.ws + OFF_ACT) + (size_t)mrow0 * DFF + (nwb >> 1);
    const unsigned lo = (unsigned)(4 * h) * DFF + r;
#pragma unroll
    for (int tm = 0; tm < TMW; ++tm) {
#pragma unroll
      for (int i = 0; i < 16; ++i) {
        const float g = acc[tm][0][i], u = acc[tm][1][i];
        const float a = g * __builtin_amdgcn_rcpf(1.f + fexp2(-g * LOG2E)) * u;
        dw[lo + (unsigned)((32 * tm + (i & 3) + 8 * (i >> 2)) * DFF)] = (u16)(pack2(a, 0.f) & 0xffff);
      }
      __builtin_amdgcn_sched_barrier(0);
    }
  } else {
#pragma unroll
    for (int tn = 0; tn < 2; ++tn) {
      const int nb0 = nwb + 32 * tn;
      if (EPI == EPI_RES) {
        const float* xw = (layer == 0 ? (m0 < NPROMPT ? p.x_prompt + (size_t)mrow0 * DM : p.x_sample + (size_t)(mrow0 - NPROMPT) * DM) : p.out + (size_t)mrow0 * DM) + nb0;
        float* ow = p.out + (size_t)mrow0 * DM + nb0;
        const unsigned lo = (unsigned)(4 * h) * DM + r;
#pragma unroll
        for (int tm = 0; tm < TMW; ++tm) {
#pragma unroll
          for (int g4 = 0; g4 < 4; ++g4) {
            float xv[4];
#pragma unroll
            for (int e = 0; e < 4; ++e) xv[e] = xw[lo + (unsigned)((32 * tm + 8 * g4 + e) * DM)];
#pragma unroll
            for (int e = 0; e < 4; ++e) ow[lo + (unsigned)((32 * tm + 8 * g4 + e) * DM)] = xv[e] + acc[tm][tn][4 * g4 + e];
          }
          __builtin_amdgcn_sched_barrier(0);
        }
      } else {
        u16* dw; int ld; bool ok = true;
        if (EPI == EPI_PROJ) { dw = (u16*)(p.ws + OFF_PROJ) + (size_t)mrow0 * DIN + nb0; ld = DIN; ok = (nb0 + r) < DIN; }
        else if (EPI == EPI_UQ) { dw = (u16*)(p.ws + OFF_QD) + (size_t)mrow0 * 384 + nb0; ld = 384; ok = nb0 < 384; }
        else {
          const int head = nb0 >> 7, w = nb0 & 127;
          if (w < 64) { dw = (u16*)(p.ws + OFF_KD) + (size_t)mrow0 * 384 + head * 96 + w; ld = 384; }
          else { dw = (u16*)(p.ws + OFF_VD) + (size_t)mrow0 * 256 + head * 64 + (w - 64); ld = 256; }
        }
        const unsigned lo = (unsigned)(4 * h) * ld + r;
        if (ok) {
#pragma unroll
          for (int tm = 0; tm < TMW; ++tm) {
#pragma unroll
            for (int i = 0; i < 16; ++i) dw[lo + (unsigned)((32 * tm + (i & 3) + 8 * (i >> 2)) * ld)] = (u16)(pack2(acc[tm][tn][i], 0.f) & 0xffff);
            __builtin_amdgcn_sched_barrier(0);
          }
        }
      }
    }
  }
  if (ROWNORM) __syncthreads();
}


typedef float f32x4v __attribute__((ext_vector_type(4)));
constexpr int G8_HT = 128 * 64;
DI int lds_byte8(int r, int c) { const int st = (r >> 4) * 2 + (c >> 5), ob = (r & 15) * 64 + (c & 31) * 2; return st * 1024 + (ob ^ (((ob >> 9) & 1) << 5)); }
DI void stage_rc8(int b, int& R, int& C) { const int st = b >> 10, sb = b & 1023, swz = sb ^ (((sb >> 9) & 1) << 5); R = (st >> 1) * 16 + (swz >> 6); C = (st & 1) * 32 + ((swz & 63) >> 1); }

DI void gemm8_prestage(const u16* __restrict__ A, const u16* __restrict__ Bt, int K, int brow, int bcol, char* smem) {
  u16* shm = (u16*)smem;
  const int tid = opaque_tid();
  int sr0, sc0, sr1, sc1;
  stage_rc8(tid * 16, sr0, sc0);
  stage_rc8(tid * 16 + 8192, sr1, sc1);
  const unsigned go0 = (unsigned)sr0 * K + sc0, go1 = (unsigned)sr1 * K + sc1;
#define G8P_STAGE(P, BASE, br) do { const u16* g_ = (BASE) + (size_t)(br) * K; \
    __builtin_amdgcn_global_load_lds((const unsigned*)(g_ + go0), (__attribute__((address_space(3))) unsigned*)((char*)(P) + tid * 16), 16, 0, 0); \
    __builtin_amdgcn_global_load_lds((const unsigned*)(g_ + go1), (__attribute__((address_space(3))) unsigned*)((char*)(P) + tid * 16 + 8192), 16, 0, 0); } while (0)
  G8P_STAGE(shm + 4 * G8_HT, Bt, bcol); G8P_STAGE(shm, A, brow);
  G8P_STAGE(shm + 5 * G8_HT, Bt, bcol + 128); G8P_STAGE(shm + G8_HT, A, brow + 128);
#undef G8P_STAGE
}

template <int EPI, bool GSCALE = false>
DI void gemm8_tile(const Params& p, int layer, const u16* __restrict__ A, const u16* __restrict__ Bt, int K, int brow, int bcol, char* smem,
                   bool next_valid, int next_brow, int next_bcol) {
  u16* shm = (u16*)smem;
  const int tid = opaque_tid();
  float* gfac = (float*)(smem + 8 * G8_HT * 2);
  if (GSCALE) {
    if (tid < 256) {
      const float* sq = (const float*)(p.ws + OFF_SSQ) + (size_t)(brow + tid) * 16;
      float rs[4];
#pragma unroll
      for (int g = 0; g < 4; ++g) { const f32x4 s4 = *(const f32x4*)(sq + 4 * g); rs[g] = rsqrtf((s4[0] + s4[1] + s4[2] + s4[3]) * (1.f / 256.f) + EPS); }
      gfac[tid] = rs[0] / rs[1]; gfac[256 + tid] = rs[1] / rs[2]; gfac[512 + tid] = rs[2] / rs[3]; gfac[768 + tid] = rs[3];
    }
  }
  const int wid = tid >> 6, lane = tid & 63, wr = wid >> 2, wc = wid & 3, fr = lane & 15, fq = lane >> 4;
  int sr0, sc0, sr1, sc1;
  stage_rc8(tid * 16, sr0, sc0);
  stage_rc8(tid * 16 + 8192, sr1, sc1);
  const unsigned go0 = (unsigned)sr0 * K + sc0, go1 = (unsigned)sr1 * K + sc1;
#define G8_SA(b, hh) (shm + ((b) * 2 + (hh)) * G8_HT)
#define G8_SB(b, hh) (shm + (4 + (b) * 2 + (hh)) * G8_HT)
#define G8_STAGE(P, BASE, br, kt) do { const u16* g_ = (BASE) + (size_t)(br) * K + (size_t)(kt) * 64; \
    __builtin_amdgcn_global_load_lds((const unsigned*)(g_ + go0), (__attribute__((address_space(3))) unsigned*)((char*)(P) + tid * 16), 16, 0, 0); \
    __builtin_amdgcn_global_load_lds((const unsigned*)(g_ + go1), (__attribute__((address_space(3))) unsigned*)((char*)(P) + tid * 16 + 8192), 16, 0, 0); } while (0)
#define G8_LDA(dst, b, hh) _Pragma("unroll") for (int m = 0; m < 4; ++m) _Pragma("unroll") for (int k = 0; k < 2; ++k) \
    dst[m][k] = *reinterpret_cast<const bf16x8*>((char*)G8_SA(b, hh) + lds_byte8(wr * 64 + m * 16 + fr, k * 32 + fq * 8))
#define G8_LDB(dst, b, hh) _Pragma("unroll") for (int n = 0; n < 2; ++n) _Pragma("unroll") for (int k = 0; k < 2; ++k) \
    dst[n][k] = *reinterpret_cast<const bf16x8*>((char*)G8_SB(b, hh) + lds_byte8(wc * 32 + n * 16 + fr, k * 32 + fq * 8))
#define G8_MMA(ai, bj, At_, Bt_) do { __builtin_amdgcn_s_setprio(1); \
    _Pragma("unroll") for (int m = 0; m < 4; ++m) _Pragma("unroll") for (int n = 0; n < 2; ++n) _Pragma("unroll") for (int k = 0; k < 2; ++k) \
      acc[ai][bj][m][n] = __builtin_amdgcn_mfma_f32_16x16x32_bf16(At_[m][k], Bt_[n][k], acc[ai][bj][m][n], 0, 0, 0); \
    __builtin_amdgcn_s_setprio(0); } while (0)
#define G8_WAIT_V(n) asm volatile("s_waitcnt vmcnt(" #n ")" ::: "memory")
#define G8_WAIT_L(n) asm volatile("s_waitcnt lgkmcnt(" #n ")" ::: "memory")
#define G8_BAR __builtin_amdgcn_s_barrier()
#define G8_SCHED __builtin_amdgcn_sched_barrier(0)
  f32x4v acc[2][2][4][2];
#pragma unroll
  for (int a = 0; a < 2; ++a)
#pragma unroll
    for (int b = 0; b < 2; ++b)
#pragma unroll
      for (int m = 0; m < 4; ++m)
#pragma unroll
        for (int n = 0; n < 2; ++n) acc[a][b][m][n] = (f32x4v){0.f, 0.f, 0.f, 0.f};
  bf16x8 At[4][2], B0[2][2], B1[2][2];
  const int nt = K / 64;
  if (wr == 1) G8_BAR;
  G8_WAIT_V(4); G8_BAR;
  G8_STAGE(G8_SB(1, 0), Bt, bcol, 1); G8_STAGE(G8_SA(1, 0), A, brow, 1); G8_STAGE(G8_SB(1, 1), Bt, bcol + 128, 1);
  G8_WAIT_V(6); G8_BAR;
  for (int t = 0; t < nt - 2; t += 2) {
    G8_LDB(B0, 0, 0); G8_SCHED; G8_LDA(At, 0, 0); G8_STAGE(G8_SA(1, 1), A, brow + 128, t + 1);
    G8_WAIT_L(8); G8_BAR; G8_WAIT_L(0); G8_MMA(0, 0, At, B0); G8_BAR; G8_SCHED;
    G8_LDB(B1, 0, 1); G8_STAGE(G8_SB(0, 0), Bt, bcol, t + 2);
    G8_BAR; G8_WAIT_L(0); G8_MMA(0, 1, At, B1); G8_BAR;
    G8_LDA(At, 0, 1); G8_STAGE(G8_SA(0, 0), A, brow, t + 2);
    G8_BAR; G8_WAIT_L(0); G8_MMA(1, 0, At, B0); G8_BAR; G8_SCHED;
    G8_STAGE(G8_SB(0, 1), Bt, bcol + 128, t + 2);
    G8_WAIT_V(6); G8_BAR; G8_MMA(1, 1, At, B1); G8_BAR;
    G8_LDB(B0, 1, 0); G8_SCHED; G8_LDA(At, 1, 0); G8_STAGE(G8_SA(0, 1), A, brow + 128, t + 2);
    G8_WAIT_L(8); G8_BAR; G8_WAIT_L(0); G8_MMA(0, 0, At, B0); G8_BAR; G8_SCHED;
    G8_LDB(B1, 1, 1); G8_STAGE(G8_SB(1, 0), Bt, bcol, t + 3);
    G8_BAR; G8_WAIT_L(0); G8_MMA(0, 1, At, B1); G8_BAR;
    G8_LDA(At, 1, 1); G8_STAGE(G8_SA(1, 0), A, brow, t + 3);
    G8_BAR; G8_WAIT_L(0); G8_MMA(1, 0, At, B0); G8_BAR; G8_SCHED;
    G8_STAGE(G8_SB(1, 1), Bt, bcol + 128, t + 3);
    G8_WAIT_V(6); G8_BAR; G8_MMA(1, 1, At, B1); G8_BAR;
    if (GSCALE && (t & 3) == 2) {
      const float* gf = gfac + (t >> 2) * 256 + wr * 64 + fq * 4;
#pragma unroll
      for (int ai = 0; ai < 2; ++ai)
#pragma unroll
        for (int m = 0; m < 4; ++m) {
          const f32x4 f4 = *(const f32x4*)(gf + ai * 128 + m * 16);
#pragma unroll
          for (int bj = 0; bj < 2; ++bj)
#pragma unroll
            for (int n = 0; n < 2; ++n)
#pragma unroll
              for (int j = 0; j < 4; ++j) acc[ai][bj][m][n][j] *= f4[j];
        }
    }
  }
  { G8_LDB(B0, 0, 0); G8_LDA(At, 0, 0); G8_STAGE(G8_SA(1, 1), A, brow + 128, nt - 1);
    G8_BAR; G8_WAIT_L(0); G8_MMA(0, 0, At, B0); G8_BAR;
    G8_LDB(B1, 0, 1); G8_BAR; G8_WAIT_L(0); G8_MMA(0, 1, At, B1); G8_BAR;
    G8_LDA(At, 0, 1); G8_WAIT_V(4); G8_BAR; G8_WAIT_L(0); G8_MMA(1, 0, At, B0); G8_MMA(1, 1, At, B1); G8_BAR; }
  { G8_LDB(B0, 1, 0); G8_LDA(At, 1, 0); G8_WAIT_V(2); G8_BAR; G8_WAIT_L(0); G8_MMA(0, 0, At, B0); G8_BAR;
    G8_LDB(B1, 1, 1); G8_WAIT_V(0); G8_BAR; G8_WAIT_L(0); G8_MMA(0, 1, At, B1); G8_BAR;
    G8_LDA(At, 1, 1); G8_BAR; G8_WAIT_L(0); G8_MMA(1, 0, At, B0); G8_MMA(1, 1, At, B1); G8_BAR; }
  if (wr == 0) G8_BAR;
  if (GSCALE) {
    const float* gf = gfac + 768 + wr * 64 + fq * 4;
#pragma unroll
    for (int ai = 0; ai < 2; ++ai)
#pragma unroll
      for (int m = 0; m < 4; ++m) {
        const f32x4 f4 = *(const f32x4*)(gf + ai * 128 + m * 16);
#pragma unroll
        for (int bj = 0; bj < 2; ++bj)
#pragma unroll
          for (int n = 0; n < 2; ++n)
#pragma unroll
            for (int j = 0; j < 4; ++j) acc[ai][bj][m][n][j] *= f4[j];
      }
  }
  if (next_valid) gemm8_prestage(A, Bt, K, next_brow, next_bcol, smem);
  const int wrs = __builtin_amdgcn_readfirstlane(wr), wcs = __builtin_amdgcn_readfirstlane(wc);
  if (EPI == EPI_RES) {
#pragma unroll
    for (int ai = 0; ai < 2; ++ai) {
      const int mrow0 = brow + ai * 128 + wrs * 64;
      const float* xw = (layer == 0 ? (brow < NPROMPT ? p.x_prompt + (size_t)mrow0 * DM : p.x_sample + (size_t)(mrow0 - NPROMPT) * DM) : p.out + (size_t)mrow0 * DM) + bcol + wcs * 32;
      float* ow = p.out + (size_t)mrow0 * DM + bcol + wcs * 32;
      const unsigned lo = (unsigned)(fq * 4) * DM + fr;
      float xv[4][4][4];
#pragma unroll
      for (int m = 0; m < 4; ++m)
#pragma unroll
        for (int j = 0; j < 4; ++j) {
          const float* xr = xw + (lo + (unsigned)((m * 16 + j) * DM));
#pragma unroll
          for (int c = 0; c < 4; ++c) xv[m][j][c] = xr[(c >> 1) * 128 + (c & 1) * 16];
        }
      __builtin_amdgcn_sched_barrier(0);
#pragma unroll
      for (int m = 0; m < 4; ++m)
#pragma unroll
        for (int j = 0; j < 4; ++j) {
          float* orow = ow + (lo + (unsigned)((m * 16 + j) * DM));
#pragma unroll
          for (int c = 0; c < 4; ++c) orow[(c >> 1) * 128 + (c & 1) * 16] = xv[m][j][c] + acc[ai][c >> 1][m][c & 1][j];
        }
      __builtin_amdgcn_sched_barrier(0);
    }
  }
#pragma unroll
  for (int ai = 0; ai < 2 && EPI != EPI_RES; ++ai) {
    const int mrow0 = brow + ai * 128 + wrs * 64;
#pragma unroll
    for (int bj = 0; bj < 2; ++bj) {
      const int ncol0 = bcol + bj * 128 + wcs * 32;
      if (EPI == EPI_SWIGLU) {
        u16* dw = (u16*)(p.ws + OFF_ACT) + (size_t)mrow0 * DFF + (ncol0 >> 1);
        const unsigned lo = (unsigned)(fq * 4) * DFF + fr;
#pragma unroll
        for (int m = 0; m < 4; ++m) {
#pragma unroll
          for (int j = 0; j < 4; ++j) {
            const float g = acc[ai][bj][m][0][j], u = acc[ai][bj][m][1][j];
            const float a = g * __builtin_amdgcn_rcpf(1.f + fexp2(-g * LOG2E)) * u;
            dw[lo + (unsigned)((m * 16 + j) * DFF)] = (u16)(pack2(a, 0.f) & 0xffff);
          }
        }
        __builtin_amdgcn_sched_barrier(0);
      } else if (EPI == EPI_RES) {
      } else {
#pragma unroll
        for (int n = 0; n < 2; ++n) {
          const int nb0 = ncol0 + n * 16;
          if (nb0 < DIN) {
            u16* dw = (u16*)(p.ws + OFF_PROJ) + (size_t)mrow0 * DIN + nb0;
            const unsigned lo = (unsigned)(fq * 4) * DIN + fr;
#pragma unroll
            for (int m = 0; m < 4; ++m)
#pragma unroll
              for (int j = 0; j < 4; ++j) dw[lo + (unsigned)((m * 16 + j) * DIN)] = (u16)(pack2(acc[ai][bj][m][n][j], 0.f) & 0xffff);
          }
          __builtin_amdgcn_sched_barrier(0);
        }
      }
    }
  }
  G8_WAIT_V(0);
  __syncthreads();
}

DI void e1_chunk(const Params& p, int layer, int chunk) {
  const int j = chunk & 7;
  const size_t tok = (size_t)(chunk >> 3) * NTHR + opaque_tid();
  if (j == 7) return;
  u16* proj = (u16*)(p.ws + OFF_PROJ);
  const int t = (int)(tok & 4095);
  if (j < 6) {
    u16* ptr = proj + tok * DIN + (j < 4 ? 768 + 64 * j : 1024 + 64 * (j - 4));
    const float* gain = (j < 4 ? p.b_q_gain : p.b_k_gain) + layer * 64;
    const float post = j < 4 ? QSCALE64 : 1.f;
    float x[64];
    float ss = 0.f;
#pragma unroll
    for (int c = 0; c < 8; ++c) {
      u32x4 w = *(const u32x4*)(ptr + c * 8);
#pragma unroll
      for (int e = 0; e < 4; ++e) { x[c * 8 + 2 * e] = bflo(w[e]); x[c * 8 + 2 * e + 1] = bfhi(w[e]); }
    }
#pragma unroll
    for (int d = 0; d < 64; ++d) ss += x[d] * x[d];
    const float rstd = rsqrtf(ss * (1.f / 64.f) + EPS);
    __builtin_amdgcn_sched_barrier(0);
#pragma unroll
    for (int c = 0; c < 4; ++c) {
#pragma unroll
      for (int d = 0; d < 16; ++d) x[c * 16 + d] = x[c * 16 + d] * rstd * gain[c * 16 + d];
      __builtin_amdgcn_sched_barrier(0);
    }
    const int prow = t >> 6, pcol = t & 63;
    { float* xa = x; float* xb = x + 16; ROPE16(p.ws, prow, xa, xb); }
    __builtin_amdgcn_sched_barrier(0);
    { float* xa = x + 32; float* xb = x + 48; ROPE16(p.ws, pcol, xa, xb); }
    __builtin_amdgcn_sched_barrier(0);
#pragma unroll
    for (int c = 0; c < 8; ++c) {
      u32x4 w;
#pragma unroll
      for (int e = 0; e < 4; ++e) w[e] = pack2(x[c * 8 + 2 * e] * post, x[c * 8 + 2 * e + 1] * post);
      *(u32x4*)(ptr + c * 8) = w;
    }
  } else {
    const u16* src = proj + tok * DIN + 2432;
    float x[32];
#pragma unroll
    for (int c = 0; c < 4; ++c) {
      u32x4 w = *(const u32x4*)(src + c * 8);
#pragma unroll
      for (int e = 0; e < 4; ++e) { x[c * 8 + 2 * e] = bflo(w[e]); x[c * 8 + 2 * e + 1] = bfhi(w[e]); }
    }
    { float* xa = x; float* xb = x + 16; ROPE16(p.ws, t, xa, xb); }
    u16* kd = (u16*)(p.ws + OFF_KD) + tok * 384 + 64;
#pragma unroll
    for (int c = 0; c < 4; ++c) {
      u32x4 w;
#pragma unroll
      for (int e = 0; e < 4; ++e) w[e] = pack2(x[c * 8 + 2 * e], x[c * 8 + 2 * e + 1]);
#pragma unroll
      for (int hh = 0; hh < 4; ++hh) *(u32x4*)(kd + hh * 96 + c * 8) = w;
    }
  }
}

template <int MODE>
DI void attn_tile(const Params& p, int layer, int tile, char* smem) {
  constexpr int DQK = (MODE == 3) ? 96 : 64;
  constexpr int NKQ = DQK / 16;
  constexpr int KROW = DQK + 8;
  constexpr int VROW = 72;
  constexpr int KCH = DQK / 8;
  constexpr int KLD = (64 * KCH + NTHR - 1) / NTHR;
  u16* Ks = (u16*)smem;
  u16* Vs = (u16*)(smem + 26624);
  float* tbl = (float*)(smem + 26624 + 18432);

  const int tid = opaque_tid(), lane = tid & 63, wave = tid >> 6, r = lane & 31, h = lane >> 5;
  const int qb = tile & 15, head = (tile >> 4) & 3, seq = tile >> 6;
  const size_t tok0 = (size_t)seq * SEQ;
  const u16* proj = (const u16*)(p.ws + OFF_PROJ);
  const u16 *Qp, *Kp, *Vp;
  int ldq, ldk, ldv;
  if (MODE == 0) { Qp = proj + 64 * head; Kp = proj + 256 + 64 * head; Vp = proj + 512 + 64 * head; ldq = ldk = ldv = DIN; }
  else if (MODE == 1) { Qp = proj + 768 + 64 * head; Kp = proj + 1024 + 64 * (head >> 1); Vp = proj + 1152 + 64 * (head >> 1); ldq = ldk = ldv = DIN; }
  else if (MODE == 2) { Qp = proj + 1280 + 64 * head; Kp = proj + 1536 + 64 * head; Vp = proj + 1792 + 64 * head; ldq = ldk = ldv = DIN; }
  else { Qp = (const u16*)(p.ws + OFF_QD) + 96 * head; Kp = (const u16*)(p.ws + OFF_KD) + 96 * head; Vp = (const u16*)(p.ws + OFF_VD) + 64 * head; ldq = ldk = 384; ldv = 256; }

  int kt0 = 0, kt1 = 64;
  if (MODE == 0) { kt0 = 4 * qb - 16; if (kt0 < 0) kt0 = 0; kt1 = 4 * qb + 20; if (kt1 > 64) kt1 = 64; }
  if (MODE == 2) { int r0 = 4 * qb - 4; r0 = r0 < 0 ? 0 : (r0 > 56 ? 56 : r0); int r1 = 4 * qb + 3 - 4; r1 = r1 < 0 ? 0 : (r1 > 56 ? 56 : r1); kt0 = r0; kt1 = r1 + 8; }

  if (MODE == 0) { const float* src = (const float*)(p.ws + OFF_TBLA) + head * 2560; for (int i = tid; i < 2560; i += NTHR) tbl[i] = src[i]; }
  if (MODE == 2) { const float* src = p.c_rpb + (size_t)(layer * 4 + head) * 465; for (int i = tid; i < 465; i += NTHR) tbl[i] = src[i] * LOG2E; }

  const int qpos = qb * 256 + wave * 32 + r;
  bf16x8 qf[NKQ];
  {
    const u16* qrow = Qp + (tok0 + qpos) * ldq + 8 * h;
#pragma unroll
    for (int d0 = 0; d0 < NKQ; ++d0) qf[d0] = *(const bf16x8*)(qrow + d0 * 16);
  }
  if (MODE == 3) {
    bf16x8 x1 = qf[NKQ - 2], x2 = qf[NKQ - 1];
    const f32x4* rt = (const f32x4*)(p.ws + OFF_ROPE) + (size_t)qpos * 8 + 4 * h;
#pragma unroll
    for (int j2 = 0; j2 < 4; ++j2) {
      const f32x4 cs4 = rt[j2];
#pragma unroll
      for (int e = 0; e < 2; ++e) {
        const int j = 2 * j2 + e;
        const float c = cs4[2 * e], sn = cs4[2 * e + 1];
        float a = __uint_as_float(((unsigned)(u16)x1[j]) << 16), b = __uint_as_float(((unsigned)(u16)x2[j]) << 16);
        unsigned w = pack2(a * c - b * sn, a * sn + b * c);
        x1[j] = (short)(w & 0xffff); x2[j] = (short)(w >> 16);
      }
    }
    qf[NKQ - 2] = x1; qf[NKQ - 1] = x2;
  }

  u32x4 rk0[KLD], rv0, rk1[KLD], rv1;
  const u16* Kt = Kp + tok0 * ldk;
  const u16* Vt = Vp + tok0 * ldv;
  unsigned koff[KLD];
#pragma unroll
  for (int pp = 0; pp < KLD; ++pp) { int c = tid + NTHR * pp; if (c >= 64 * KCH) c = tid; const int row = c / KCH, col = c % KCH; koff[pp] = (unsigned)row * ldk + col * 8; }
  const unsigned voff = (unsigned)(tid >> 3) * ldv + (tid & 7) * 8;
  const int ktl = kt1 - 1;
  auto gload = [&](u32x4 (&rk)[KLD], u32x4& rv, int kt) {
    kt = kt < ktl ? kt : ktl;
#pragma unroll
    for (int pp = 0; pp < KLD; ++pp) rk[pp] = *(const u32x4*)(Kt + (koff[pp] + (unsigned)(kt * 64) * ldk));
    rv = *(const u32x4*)(Vt + (voff + (unsigned)(kt * 64) * ldv));
  };
  auto lstore = [&](u32x4 (&rk)[KLD], u32x4& rv, int buf) {
#pragma unroll
    for (int pp = 0; pp < KLD; ++pp) { const int c = tid + NTHR * pp; if (c < 64 * KCH) { const int row = c / KCH, col = c % KCH; *(u32x4*)(Ks + (buf * 64 + row) * KROW + col * 8) = rk[pp]; } }
    *(u32x4*)(Vs + (buf * 64 + (tid >> 3)) * VROW + (tid & 7) * 8) = rv;
  };

  f32x16 o0, o1, negm;
#pragma unroll
  for (int i = 0; i < 16; ++i) { o0[i] = 0.f; o1[i] = 0.f; negm[i] = 0.f; }
  float mref = 0.f, lsum = 0.f;
  bool started = false;
  int qr = 0, qc = 0, cs = 0, rs = 0;
  if (MODE == 2) { qr = qpos >> 6; qc = qpos & 63; cs = qc - 8; cs = cs < 0 ? 0 : (cs > 48 ? 48 : cs); rs = qr - 4; rs = rs < 0 ? 0 : (rs > 56 ? 56 : rs); }
  const int i16 = lane & 15, qq = i16 >> 2, pp4 = i16 & 3, g16 = (lane >> 4) & 1;

  auto compute = [&](int buf, int kt) {
    bool active = true;
    if (MODE == 2) active = (kt >= rs) && (kt < rs + 8);
    if (active) {
      const u16* Kb = Ks + buf * 64 * KROW + r * KROW + 8 * h;
      const u16* Vb = Vs + buf * 64 * VROW;
      bf16x8 vf[8];
#pragma unroll
      for (int cs2 = 0; cs2 < 4; ++cs2) {
        const u16* vp = Vb + (16 * cs2 + 4 * h + qq) * VROW + 16 * g16 + 4 * pp4;
        { s16x4 lo = tr_read(vp), hi = tr_read(vp + 8 * VROW); vf[2 * cs2] = __builtin_shufflevector(lo, hi, 0, 1, 2, 3, 4, 5, 6, 7); }
        { s16x4 lo = tr_read(vp + 32), hi = tr_read(vp + 8 * VROW + 32); vf[2 * cs2 + 1] = __builtin_shufflevector(lo, hi, 0, 1, 2, 3, 4, 5, 6, 7); }
      }
      f32x16 s0 = negm, s1 = negm;
#pragma unroll
      for (int d0 = 0; d0 < NKQ; ++d0) {
        bf16x8 k0 = *(const bf16x8*)(Kb + d0 * 16);
        bf16x8 k1 = *(const bf16x8*)(Kb + 32 * KROW + d0 * 16);
        s0 = mfma(k0, qf[d0], s0);
        s1 = mfma(k1, qf[d0], s1);
      }
      if (MODE == 0) {
        const float* tb = tbl + (kt * 64 + 4 * h - qpos + 1280);
#pragma unroll
        for (int i = 0; i < 16; ++i) { s0[i] += tb[(i & 3) + 8 * (i >> 2)]; s1[i] += tb[32 + (i & 3) + 8 * (i >> 2)]; }
      }
      if (MODE == 2) {
        const float* tb = tbl + (kt - qr + 7) * 31 + (15 - qc);
#pragma unroll
        for (int i = 0; i < 16; ++i) {
          const int kc0 = 4 * h + (i & 3) + 8 * (i >> 2), kc1 = kc0 + 32;
          const bool v0 = (kc0 >= cs) && (kc0 < cs + 16), v1 = (kc1 >= cs) && (kc1 < cs + 16);
          const float b0 = tb[v0 ? kc0 : qc], b1 = tb[v1 ? kc1 : qc];
          s0[i] = v0 ? s0[i] + b0 : NEGBIG;
          s1[i] = v1 ? s1[i] + b1 : NEGBIG;
        }
      }
      float ma = __builtin_fmaxf(__builtin_fmaxf(s0[0], s0[1]), s0[2]), mb = __builtin_fmaxf(__builtin_fmaxf(s1[0], s1[1]), s1[2]);
#pragma unroll
      for (int i = 3; i < 15; i += 2) { ma = __builtin_fmaxf(__builtin_fmaxf(ma, s0[i]), s0[i + 1]); mb = __builtin_fmaxf(__builtin_fmaxf(mb, s1[i]), s1[i + 1]); }
      float mt = __builtin_fmaxf(__builtin_fmaxf(ma, s0[15]), s1[15]);
      mt = hmax(__builtin_fmaxf(mt, mb));
      const bool fresh = !started && (mt > -1e29f);
      if (__any(fresh || (started && mt > 8.f))) {
        float delta = 0.f, al = 1.f;
        if (fresh) { delta = mt; started = true; }
        else if (started) { delta = __builtin_fmaxf(mt, 0.f); al = fexp2(-delta); }
        mref += delta;
        lsum *= al;
#pragma unroll
        for (int i = 0; i < 16; ++i) { o0[i] *= al; o1[i] *= al; s0[i] -= delta; s1[i] -= delta; negm[i] = -mref; }
      }
      float ps = 0.f;
#pragma unroll
      for (int i = 0; i < 16; ++i) { s0[i] = fexp2(s0[i]); s1[i] = fexp2(s1[i]); ps += s0[i] + s1[i]; }
      lsum += ps;
#pragma unroll
      for (int c = 0; c < 2; ++c) {
#pragma unroll
        for (int s = 0; s < 2; ++s) {
          u32x4 pw;
          if (c == 0) pw = (u32x4){pack2(s0[8 * s], s0[8 * s + 1]), pack2(s0[8 * s + 2], s0[8 * s + 3]), pack2(s0[8 * s + 4], s0[8 * s + 5]), pack2(s0[8 * s + 6], s0[8 * s + 7])};
          else pw = (u32x4){pack2(s1[8 * s], s1[8 * s + 1]), pack2(s1[8 * s + 2], s1[8 * s + 3]), pack2(s1[8 * s + 4], s1[8 * s + 5]), pack2(s1[8 * s + 6], s1[8 * s + 7])};
          const bf16x8 pf = __builtin_bit_cast(bf16x8, pw);
          o0 = mfma(vf[2 * (2 * c + s)], pf, o0);
          o1 = mfma(vf[2 * (2 * c + s) + 1], pf, o1);
        }
      }
    }
  };

  const int ntile = kt1 - kt0;
  gload(rk0, rv0, kt0);
  lstore(rk0, rv0, 0);
  gload(rk0, rv0, kt0 + 1);
  gload(rk1, rv1, kt0 + 2);
  __syncthreads();
  for (int j = 0; j < ntile; j += 2) {
    compute(0, kt0 + j);
    lstore(rk0, rv0, 1);
    gload(rk0, rv0, kt0 + j + 3);
    __syncthreads();
    if (j + 1 >= ntile) break;
    compute(1, kt0 + j + 1);
    lstore(rk1, rv1, 0);
    gload(rk1, rv1, kt0 + j + 4);
    __syncthreads();
  }
  lsum = hsum(lsum);
  const float inv = 1.f / lsum;
  float sq = 0.f;
#pragma unroll
  for (int i = 0; i < 16; ++i) { o0[i] *= inv; o1[i] *= inv; sq += o0[i] * o0[i] + o1[i] * o1[i]; }
  sq = hsum(sq);
  if (h == 0) ((float*)(p.ws + OFF_SSQ))[(tok0 + qpos) * 16 + MODE * 4 + head] = sq;
  u16* op = (u16*)(p.ws + OFF_ACTB) + (tok0 + qpos) * DM + MODE * 256 + head * 64 + 4 * h;
#pragma unroll
  for (int g4 = 0; g4 < 4; ++g4) {
    u32x2 w0 = {pack2(o0[4 * g4], o0[4 * g4 + 1]), pack2(o0[4 * g4 + 2], o0[4 * g4 + 3])};
    u32x2 w1 = {pack2(o1[4 * g4], o1[4 * g4 + 1]), pack2(o1[4 * g4 + 2], o1[4 * g4 + 3])};
    *(u32x2*)(op + 8 * g4) = w0;
    *(u32x2*)(op + 32 + 8 * g4) = w1;
  }
}


DI bool sb_tile(int bid, int nb, int it, int NT, int& mt, int& nt) {
  const int G = nb >> 3, x = bid & 7, l = bid >> 3;
  const int s = l + it * G;
  const int sb = (s >> 5) * 8 + x, w = s & 31;
  if (NT == 4) {
    if (sb >= 48) return false;
    mt = sb * 8 + (w >> 2); nt = w & 3;
    return true;
  }
  const int NG = NT >> 1;
  if (sb >= 24 * NG) return false;
  const int mg = sb / NG, ng = sb - mg * NG;
  mt = mg * 16 + (w >> 1); nt = ng * 2 + (w & 1);
  return true;
}

DI bool att_tile_index(int bid, int nb, int it, int& tile) {
  if (nb != 256) { tile = bid + it * nb; return tile < 1536; }
  const int x = bid & 7, l = bid >> 3;
  const int pair = 2 * (it * 8 + x) + (l >> 4);
  tile = pair * 16 + ((l + 3 * it) & 15);
  return pair < 96;
}

template <int EPI, bool GSCALE = false>
DI void gemm8_phase(const Params& p, int layer, const u16* A, const u16* Bt, int K, int NT, char* smem) {
  const int bid = blockIdx.x, nb = gridDim.x;
  int mt, nt;
  bool have = sb_tile(bid, nb, 0, NT, mt, nt);
  if (have) gemm8_prestage(A, Bt, K, mt * 256, nt * 256, smem);
  for (int it = 0; have; ++it) {
    int mt2 = 0, nt2 = 0;
    const bool have2 = sb_tile(bid, nb, it + 1, NT, mt2, nt2);
    gemm8_tile<EPI, GSCALE>(p, layer, A, Bt, K, mt * 256, nt * 256, smem, have2, mt2 * 256, nt2 * 256);
    have = have2; mt = mt2; nt = nt2;
  }
}

constexpr int NPHASE = 17;
constexpr int MT = T_TOK / 256;

DI void run_phase(const Params& p, int ph, char* smem) {
  const int bid = blockIdx.x, nb = gridDim.x;
  u16* wtb = (u16*)(p.ws + OFF_WT);
  const u16* actb = (const u16*)(p.ws + OFF_ACTB);
  if (ph == 0) {
    for (int j = bid; j < 128; j += nb) rope_tab_build(p.ws, j * NTHR + opaque_tid());
    for (int j = bid; j < WJ_TOTAL; j += nb) wprep_job(p, j, smem);
    for (int rb = bid; rb < T_TOK / (8 * NRW); rb += nb) norm_rows(p, 0, rb, 0);
    return;
  }
  if (ph == 16) { for (int rb = bid; rb < T_TOK / (8 * NRW); rb += nb) norm_rows(p, 1, rb, 1); return; }
  const int layer = (ph - 1) >> 3, sub = (ph - 1) & 7;
  const u16* wl = wtb + (size_t)layer * WT_LAYER;
  switch (sub) {
    case 0:
      gemm8_phase<EPI_PROJ>(p, layer, actb, wl + WT_IN, 1024, 10, smem);
      break;
    case 1:
      for (int c = bid; c < (T_TOK / NTHR) * 8; c += nb) e1_chunk(p, layer, c);
      for (int t = bid; t < MT * 2; t += nb) { const int nt = t & 1, mt = t >> 1; gemm_tile<EPI_UQ, false, true>(p, layer, (const u16*)(p.ws + OFF_PROJ) + 2048, DIN, wl + WT_UQ, 256, mt * 256, nt * 256, smem); }
      for (int t = bid; t < MT * 2; t += nb) { const int nt = t & 1, mt = t >> 1; gemm_tile<EPI_UKV, false, true>(p, layer, (const u16*)(p.ws + OFF_PROJ) + 2304, DIN, wl + WT_UKV, 128, mt * 256, nt * 256, smem); }
      break;
    case 2:
      for (int it = 0, t; att_tile_index(bid, nb, it, t); ++it) attn_tile<3>(p, layer, t, smem);
      for (int it = 0, t; att_tile_index(bid, nb, it, t); ++it) attn_tile<1>(p, layer, t, smem);
      for (int it = 0, t; att_tile_index(bid, nb, it, t); ++it) attn_tile<0>(p, layer, t, smem);
      for (int it = 0, t; att_tile_index(bid, nb, it, t); ++it) attn_tile<2>(p, layer, t, smem);
      break;
    case 3:
      gemm8_phase<EPI_RES, true>(p, layer, actb, wl + WT_OUT, 1024, 4, smem);
      break;
    case 4:
      for (int rb = bid; rb < T_TOK / (8 * NRW); rb += nb) norm_rows(p, 1, rb, 0);
      break;
    case 5:
      gemm8_phase<EPI_SWIGLU>(p, layer, actb, wl + WT_GU, 1024, 22, smem);
      break;
    case 6:
      gemm8_phase<EPI_RES>(p, 1, (const u16*)(p.ws + OFF_ACT), wl + WT_DN, DFF, 4, smem);
      break;
    case 7:
      for (int rb = bid; rb < T_TOK / (8 * NRW); rb += nb) norm_rows(p, 1, rb, 0);
      break;
  }
}

__global__ void __launch_bounds__(NTHR, 2) mega(Params p, int ph_lo, int ph_hi) {
  __shared__ __attribute__((aligned(16))) char smem[SMEM_BYTES];
  cg::grid_group grid = cg::this_grid();
  for (int ph = ph_lo; ph < ph_hi; ++ph) {
    if (ph > ph_lo) grid.sync();
    run_phase(p, ph, smem);
#ifdef DUPMASK
    if (ph >= 1 && ph < 16 && ((DUPMASK >> ((ph - 1) & 7)) & 1)) { grid.sync(); run_phase(p, ph, smem); }
#endif
  }
}

extern "C" void kernel_launch(void* const* d_in, const int* in_sizes, int n_in, void* d_out, int out_size, void* d_ws, size_t ws_size, hipStream_t stream) {
  Params p{};
  p.x_prompt = (const float*)d_in[0]; p.x_sample = (const float*)d_in[1]; p.t5_bias = (const float*)d_in[2]; p.norm_mix = (const float*)d_in[3];
  p.w_in = (const float*)d_in[4]; p.b_q_gain = (const float*)d_in[5]; p.b_k_gain = (const float*)d_in[6]; p.c_rpb = (const float*)d_in[7];
  p.d_q_gain = (const float*)d_in[8]; p.d_w_uq = (const float*)d_in[9]; p.d_kv_gain = (const float*)d_in[10]; p.d_w_ukv = (const float*)d_in[11];
  p.out_gain = (const float*)d_in[12]; p.w_out = (const float*)d_in[13]; p.norm_ffn = (const float*)d_in[14]; p.w_gate = (const float*)d_in[15];
  p.w_up = (const float*)d_in[16]; p.w_down = (const float*)d_in[17]; p.final_norm = (const float*)d_in[18];
  p.out = (float*)d_out; p.ws = (char*)d_ws;
  if (ws_size < WS_NEED) { fprintf(stderr, "workspace too small: %zu < %zu\n", ws_size, (size_t)WS_NEED); return; }
  static int grid_blocks = 0;
  if (!grid_blocks) {
    int dev = 0, cus = 0, per_cu = 0;
    hipGetDevice(&dev);
    hipDeviceGetAttribute(&cus, hipDeviceAttributeMultiprocessorCount, dev);
    hipOccupancyMaxActiveBlocksPerMultiprocessor(&per_cu, mega, NTHR, 0);
    if (per_cu < 1) per_cu = 1;
    if (per_cu > 1) per_cu = 1;
    grid_blocks = cus * per_cu;
  }
#if ONE_LAUNCH
  int lo = 0, hi = NPHASE;
  void* args[] = {&p, &lo, &hi};
  hipError_t e = hipLaunchCooperativeKernel((void*)mega, dim3(grid_blocks), dim3(NTHR), args, 0, stream);
  if (e != hipSuccess) fprintf(stderr, "cooperative launch failed: %s (grid %d)\n", hipGetErrorString(e), grid_blocks);
#else
  for (int ph = 0; ph < NPHASE; ++ph) hipLaunchKernelGGL(mega, dim3(grid_blocks), dim3(NTHR), 0, stream, p, ph, ph + 1);
#endif
}
```

```cpp
#include <hip/hip_runtime.h>
#include <hip/hip_cooperative_groups.h>
#include <cstdio>
#include <cstdint>
namespace cg = cooperative_groups;

#ifndef ONE_LAUNCH
#define ONE_LAUNCH 1
#endif

#define DI __device__ __forceinline__
typedef short bf16x8 __attribute__((ext_vector_type(8)));
typedef short s16x4 __attribute__((ext_vector_type(4)));
typedef float f32x16 __attribute__((ext_vector_type(16)));
typedef float f32x4 __attribute__((ext_vector_type(4)));
typedef float f32x2 __attribute__((ext_vector_type(2)));
typedef unsigned u32x4 __attribute__((ext_vector_type(4)));
typedef unsigned u32x2 __attribute__((ext_vector_type(2)));
typedef __bf16 bf16v2 __attribute__((ext_vector_type(2)));
typedef unsigned short u16;

constexpr int T_TOK = 98304, SEQ = 4096, DM = 1024, DIN = 2464, DINP = 2560, DFF = 2816;
constexpr int NPROMPT = 8 * 4096;
constexpr int NTHR = 512;
constexpr float LOG2E = 1.4426950408889634f;
constexpr float QSCALE64 = 0.125f * LOG2E;
constexpr float QSCALE96 = 0.10206207261596575f * LOG2E;
constexpr float NEGBIG = -1e30f;
constexpr float EPS = 1e-6f;

constexpr size_t al256(size_t x) { return (x + 255) & ~(size_t)255; }
constexpr size_t WT_IN = 0;
constexpr size_t WT_UQ = WT_IN + (size_t)DINP * 1024;
constexpr size_t WT_UKV = WT_UQ + 512 * 256;
constexpr size_t WT_OUT = WT_UKV + 512 * 128;
constexpr size_t WT_GU = WT_OUT + 1024 * 1024;
constexpr size_t WT_DN = WT_GU + (size_t)5632 * 1024;
constexpr size_t WT_LAYER = WT_DN + (size_t)1024 * 2816;
constexpr size_t OFF_WT = 0;
constexpr size_t OFF_TBLA = al256(OFF_WT + 2 * WT_LAYER * 2);
constexpr size_t OFF_ROPE = al256(OFF_TBLA + 4 * 2560 * 4);
constexpr size_t OFF_ACTB = al256(OFF_ROPE + 4096 * 16 * 8);
constexpr size_t OFF_PROJ = al256(OFF_ACTB + (size_t)T_TOK * 1024 * 2);
constexpr size_t OFF_QD = al256(OFF_PROJ + (size_t)T_TOK * DIN * 2);
constexpr size_t OFF_KD = al256(OFF_QD + (size_t)T_TOK * 384 * 2);
constexpr size_t OFF_VD = al256(OFF_KD + (size_t)T_TOK * 384 * 2);
constexpr size_t OFF_SSQ = al256(OFF_VD + (size_t)T_TOK * 256 * 2);
constexpr size_t WS_NEED = al256(OFF_SSQ + (size_t)T_TOK * 16 * 4);
constexpr size_t OFF_ACT = OFF_PROJ;
static_assert(OFF_ACT + (size_t)T_TOK * DFF * 2 <= OFF_KD, "act alias overflow");

struct Params {
  const float *x_prompt, *x_sample, *t5_bias, *norm_mix, *w_in, *b_q_gain, *b_k_gain, *c_rpb, *d_q_gain, *d_w_uq,
      *d_kv_gain, *d_w_ukv, *out_gain, *w_out, *norm_ffn, *w_gate, *w_up, *w_down, *final_norm;
  float* out;
  char* ws;
};

constexpr int SMEM_BYTES = 2 * (256 + 256) * 72 * 2 + 1024;

DI unsigned pack2(float a, float b) { f32x2 v = {a, b}; bf16v2 r = __builtin_convertvector(v, bf16v2); return __builtin_bit_cast(unsigned, r); }
DI float bflo(unsigned w) { return __uint_as_float(w << 16); }
DI float bfhi(unsigned w) { return __uint_as_float(w & 0xffff0000u); }
DI f32x16 mfma(bf16x8 a, bf16x8 b, f32x16 c) { return __builtin_amdgcn_mfma_f32_32x32x16_bf16(a, b, c, 0, 0, 0); }
DI float hmax(float v) {
  auto rr = __builtin_amdgcn_permlane32_swap(__float_as_uint(v), __float_as_uint(v), false, false);
  return __builtin_fmaxf(__uint_as_float(rr[0]), __uint_as_float(rr[1]));
}
DI float hsum(float v) {
  auto rr = __builtin_amdgcn_permlane32_swap(__float_as_uint(v), __float_as_uint(v), false, false);
  return __uint_as_float(rr[0]) + __uint_as_float(rr[1]);
}
DI float fexp2(float x) { return __builtin_amdgcn_exp2f(x); }
DI int crow(int i, int h) { return (i & 3) + 8 * (i >> 2) + 4 * h; }
typedef short v4i16_t __attribute__((ext_vector_type(4)));
DI s16x4 tr_read(const u16* p) {
  return __builtin_bit_cast(s16x4, __builtin_amdgcn_ds_read_tr16_b64_v4i16((__attribute__((address_space(3))) v4i16_t*)p));
}
constexpr double inv_rev_c(int i) {
  constexpr double b[4] = {1.0, 0.5623413251903491, 0.31622776601683794, 0.1778279410038923};
  double v = b[i & 3];
  for (int k = 0; k < (i >> 2); ++k) v *= 0.1;
  return v * 0.15915494309189535;
}
DI void rope_tab_build(char* ws, int idx) {
  const int pos = idx >> 4, i = idx & 15;
  double invrev = inv_rev_c(0);
#pragma unroll
  for (int k = 1; k < 16; ++k) if (i == k) invrev = inv_rev_c(k);
  double rev = (double)pos * invrev;
  float f = (float)(rev - (double)(int)rev);
  f32x2 cs = {__builtin_amdgcn_cosf(f), __builtin_amdgcn_sinf(f)};
  ((f32x2*)(ws + OFF_ROPE))[idx] = cs;
}
#define ROPE16(ws_, pos_, A_, B_)                                                              \
  {                                                                                            \
    const f32x4* rt_ = (const f32x4*)((ws_) + OFF_ROPE) + (size_t)(pos_) * 8;                  \
    _Pragma("unroll") for (int i2_ = 0; i2_ < 8; ++i2_) {                                      \
      const f32x4 cs_ = rt_[i2_];                                                              \
      float a_ = A_[2 * i2_], b_ = B_[2 * i2_];                                                \
      A_[2 * i2_] = a_ * cs_[0] - b_ * cs_[1]; B_[2 * i2_] = a_ * cs_[1] + b_ * cs_[0];        \
      a_ = A_[2 * i2_ + 1]; b_ = B_[2 * i2_ + 1];                                              \
      A_[2 * i2_ + 1] = a_ * cs_[2] - b_ * cs_[3]; B_[2 * i2_ + 1] = a_ * cs_[3] + b_ * cs_[2]; \
    }                                                                                          \
  }
DI const float* xrow(const Params& p, int layer, size_t tok) {
  if (layer == 0) return tok < (size_t)NPROMPT ? p.x_prompt + tok * DM : p.x_sample + (tok - NPROMPT) * DM;
  return p.out + tok * DM;
}

DI int opaque_tid() { int t = threadIdx.x; asm volatile("" : "+v"(t)); return t; }
DI void wt_tile(const float* __restrict__ W, int K, int N, const float* __restrict__ g, u16* __restrict__ Wt, int k0, int n0, int mapmode, float* tile) {
  const int tid = opaque_tid();
  for (int i = tid; i < 4096; i += NTHR) {
    int kk = i >> 6, nn = i & 63, n = n0 + nn;
    float v = 0.f;
    if (n < N) { v = W[(size_t)(k0 + kk) * N + n]; if (g) v *= g[k0 + kk]; }
    tile[kk * 65 + nn] = v;
  }
  __syncthreads();
  for (int i = tid; i < 2048; i += NTHR) {
    int nn = i >> 5, kp = i & 31, n = n0 + nn;
    float cs = 1.f; int drow = n;
    if (mapmode == 1) { if (n < 256 || (n >= 1280 && n < 1536)) cs = QSCALE64; }
    else if (mapmode == 2) cs = QSCALE96;
    else if (mapmode == 3) drow = 32 * (n >> 4) + (n & 15);
    else if (mapmode == 4) drow = 32 * (n >> 4) + 16 + (n & 15);
    unsigned w = pack2(tile[(2 * kp) * 65 + nn] * cs, tile[(2 * kp + 1) * 65 + nn] * cs);
    *(unsigned*)(Wt + (size_t)drow * K + k0 + 2 * kp) = w;
  }
  __syncthreads();
}

constexpr int WJ_IN = 640, WJ_UQ = 32, WJ_UKV = 16, WJ_OUT = 256, WJ_G = 704, WJ_U = 704, WJ_D = 704;
constexpr int WJ_LAYER = WJ_IN + WJ_UQ + WJ_UKV + WJ_OUT + WJ_G + WJ_U + WJ_D;
constexpr int WJ_TOTAL = 2 * WJ_LAYER + 20;

DI void wprep_job(const Params& p, int job, char* smem) {
  float* tile = (float*)smem;
  u16* wtb = (u16*)(p.ws + OFF_WT);
  if (job >= 2 * WJ_LAYER) {
    int idx = (job - 2 * WJ_LAYER) * NTHR + opaque_tid();
    int head = idx / 2560, e = idx % 2560, d = e - 1280, n = d < 0 ? -d : d;
    int mult = (n <= 64 ? 1 : 0) + (((n & 3) == 0 && n <= 256) ? 1 : 0) + (((n & 15) == 0 && n <= 1024) ? 1 : 0);
    float v = NEGBIG;
    if (mult > 0) {
      int bk;
      if (n < 8) bk = n;
      else { float nf = (float)n; int lg = 8 + (int)(__logf(nf * 0.125f) / 4.852030263919617f * 8.0f); bk = lg < 15 ? lg : 15; }
      if (d > 0) bk += 16;
      v = (p.t5_bias[bk * 4 + head] + __logf((float)mult)) * LOG2E;
    }
    ((float*)(p.ws + OFF_TBLA))[idx] = v;
    return;
  }
  int layer = job / WJ_LAYER, j = job % WJ_LAYER;
  u16* wl = wtb + (size_t)layer * WT_LAYER;
  if (j < WJ_IN) { int kt = j & 15, nt = j >> 4; wt_tile(p.w_in + (size_t)layer * 1024 * DIN, 1024, DIN, p.norm_mix + layer * 1024, wl + WT_IN, kt * 64, nt * 64, 1, tile); return; }
  j -= WJ_IN;
  if (j < WJ_UQ) { int kt = j & 3, nt = j >> 2; wt_tile(p.d_w_uq + (size_t)layer * 256 * 384, 256, 384, p.d_q_gain + layer * 256, wl + WT_UQ, kt * 64, nt * 64, 2, tile); return; }
  j -= WJ_UQ;
  if (j < WJ_UKV) { int kt = j & 1, nt = j >> 1; wt_tile(p.d_w_ukv + (size_t)layer * 128 * 512, 128, 512, p.d_kv_gain + layer * 128, wl + WT_UKV, kt * 64, nt * 64, 0, tile); return; }
  j -= WJ_UKV;
  if (j < WJ_OUT) { int kt = j & 15, nt = j >> 4; wt_tile(p.w_out + (size_t)layer * 1024 * 1024, 1024, 1024, p.out_gain + layer * 1024, wl + WT_OUT, kt * 64, nt * 64, 0, tile); return; }
  j -= WJ_OUT;
  if (j < WJ_G) { int kt = j & 15, nt = j >> 4; wt_tile(p.w_gate + (size_t)layer * 1024 * DFF, 1024, DFF, p.norm_ffn + layer * 1024, wl + WT_GU, kt * 64, nt * 64, 3, tile); return; }
  j -= WJ_G;
  if (j < WJ_U) { int kt = j & 15, nt = j >> 4; wt_tile(p.w_up + (size_t)layer * 1024 * DFF, 1024, DFF, p.norm_ffn + layer * 1024, wl + WT_GU, kt * 64, nt * 64, 4, tile); return; }
  j -= WJ_U;
  { int kt = j % 44, nt = j / 44; wt_tile(p.w_down + (size_t)layer * DFF * 1024, DFF, 1024, nullptr, wl + WT_DN, kt * 64, nt * 64, 0, tile); }
}

constexpr int NRW = 4;
DI void norm_rows(const Params& p, int layer, int rb, int mode) {
  const int tid = opaque_tid();
  const int lane = tid & 63, wave = tid >> 6;
  const size_t rowb = (size_t)rb * (8 * NRW) + wave;
  f32x4 v[NRW][4];
#pragma unroll
  for (int rr = 0; rr < NRW; ++rr) {
    const float* src = xrow(p, layer, rowb + 8 * rr);
#pragma unroll
    for (int i = 0; i < 4; ++i) v[rr][i] = __builtin_nontemporal_load((const f32x4*)(src + lane * 4 + 256 * i));
  }
#pragma unroll
  for (int rr = 0; rr < NRW; ++rr) {
    float ss = 0.f;
#pragma unroll
    for (int i = 0; i < 4; ++i) ss += v[rr][i][0] * v[rr][i][0] + v[rr][i][1] * v[rr][i][1] + v[rr][i][2] * v[rr][i][2] + v[rr][i][3] * v[rr][i][3];
#pragma unroll
    for (int o = 1; o < 64; o <<= 1) ss += __shfl_xor(ss, o);
    const float rstd = rsqrtf(ss * (1.f / 1024.f) + EPS);
    const size_t row = rowb + 8 * rr;
    if (mode == 0) {
      u16* dst = (u16*)(p.ws + OFF_ACTB) + row * DM;
#pragma unroll
      for (int i = 0; i < 4; ++i) { u32x2 w = {pack2(v[rr][i][0] * rstd, v[rr][i][1] * rstd), pack2(v[rr][i][2] * rstd, v[rr][i][3] * rstd)}; *(u32x2*)(dst + lane * 4 + 256 * i) = w; }
    } else {
      float* dst = p.out + row * DM;
#pragma unroll
      for (int i = 0; i < 4; ++i) { f32x4 g = *(const f32x4*)(p.final_norm + lane * 4 + 256 * i); f32x4 o = {v[rr][i][0] * rstd * g[0], v[rr][i][1] * rstd * g[1], v[rr][i][2] * rstd * g[2], v[rr][i][3] * rstd * g[3]}; __builtin_nontemporal_store(o, (f32x4*)(dst + lane * 4 + 256 * i)); }
    }
  }
}

enum { EPI_PROJ = 0, EPI_UQ = 1, EPI_UKV = 2, EPI_RES = 3, EPI_SWIGLU = 4 };
constexpr int GS = 72;
constexpr int BM = 256;
constexpr int TMW = 4;

template <int EPI, bool ASCALE, bool ROWNORM>
DI void gemm_tile(const Params& p, int layer, const u16* __restrict__ A, int lda, const u16* __restrict__ Wt, int K, int m0, int n0, char* smem) {
  u16* As = (u16*)smem;
  u16* Bs = As + 2 * BM * GS;
  float* rowscale = (float*)(Bs + 2 * 256 * GS);
  const int tid = opaque_tid(), lane = tid & 63, wave = tid >> 6, r = lane & 31, h = lane >> 5;
  const int wm = wave >> 2, wn = wave & 3;
  const int lrow = tid >> 3, kc = tid & 7;
  const u16* At = A + (size_t)m0 * lda;
  const u16* Bt = Wt + (size_t)n0 * K;
  const unsigned aoff = (unsigned)lrow * lda + kc * 8, boff = (unsigned)lrow * K + kc * 8;
  const float* ssq = (const float*)(p.ws + OFF_SSQ);

  if (ROWNORM) {
    const int rr = tid >> 1, half = tid & 1;
    const u16* src = A + (size_t)(m0 + rr) * lda + half * (K / 2);
    float ss = 0.f;
    for (int i = 0; i < K / 16; ++i) {
      u32x4 w = *(const u32x4*)(src + i * 8);
#pragma unroll
      for (int e = 0; e < 4; ++e) { float a = bflo(w[e]), b = bfhi(w[e]); ss += a * a + b * b; }
    }
    ss += __shfl_xor(ss, 1);
    if (half == 0) rowscale[rr] = rsqrtf(ss / (float)K + EPS);
  }

  f32x16 acc[TMW][2];
#pragma unroll
  for (int a = 0; a < TMW; ++a)
#pragma unroll
    for (int b = 0; b < 2; ++b)
#pragma unroll
      for (int i = 0; i < 16; ++i) acc[a][b][i] = 0.f;

  u32x4 ra[4], rb[4];
  float sc[4] = {1.f, 1.f, 1.f, 1.f};
  const int KT = K / 64;
  auto gload = [&](int kt) {
#pragma unroll
    for (int pp = 0; pp < 4; ++pp) ra[pp] = *(const u32x4*)(At + (size_t)(64 * pp) * lda + (aoff + (unsigned)kt * 64));
#pragma unroll
    for (int pp = 0; pp < 4; ++pp) rb[pp] = *(const u32x4*)(Bt + (size_t)(64 * pp) * K + (boff + (unsigned)kt * 64));
  };
  auto lstore = [&](int buf, int kt) {
    if (ASCALE) {
      if ((kt & 3) == 0) {
        const int g = kt >> 2;
#pragma unroll
        for (int pp = 0; pp < 4; ++pp) {
          f32x4 s4 = *(const f32x4*)(ssq + (size_t)(m0 + lrow + 64 * pp) * 16 + 4 * g);
          sc[pp] = rsqrtf((s4[0] + s4[1] + s4[2] + s4[3]) * (1.f / 256.f) + EPS);
        }
      }
#pragma unroll
      for (int pp = 0; pp < 4; ++pp)
#pragma unroll
        for (int e = 0; e < 4; ++e) ra[pp][e] = pack2(bflo(ra[pp][e]) * sc[pp], bfhi(ra[pp][e]) * sc[pp]);
    }
#pragma unroll
    for (int pp = 0; pp < 4; ++pp) *(u32x4*)(As + (buf * BM + lrow + 64 * pp) * GS + kc * 8) = ra[pp];
#pragma unroll
    for (int pp = 0; pp < 4; ++pp) *(u32x4*)(Bs + (buf * 256 + lrow + 64 * pp) * GS + kc * 8) = rb[pp];
  };
  auto compute = [&](int buf) {
    const u16* Ab = As + (buf * BM + wm * 128 + r) * GS + 8 * h;
    const u16* Bb = Bs + (buf * 256 + wn * 64 + r) * GS + 8 * h;
#pragma unroll
    for (int ks = 0; ks < 4; ++ks) {
      bf16x8 b0 = *(const bf16x8*)(Bb + ks * 16);
      bf16x8 b1 = *(const bf16x8*)(Bb + 32 * GS + ks * 16);
#pragma unroll
      for (int tm = 0; tm < TMW; ++tm) {
        bf16x8 a = *(const bf16x8*)(Ab + tm * 32 * GS + ks * 16);
        acc[tm][0] = mfma(a, b0, acc[tm][0]);
        acc[tm][1] = mfma(a, b1, acc[tm][1]);
      }
    }
  };
  gload(0);
  lstore(0, 0);
  if (KT > 1) gload(1);
  __syncthreads();
  for (int kt = 0; kt < KT; ++kt) {
    compute(kt & 1);
    if (kt + 1 < KT) lstore((kt + 1) & 1, kt + 1);
    if (kt + 2 < KT) gload(kt + 2);
    __syncthreads();
  }

  const int wms = __builtin_amdgcn_readfirstlane(wm), wns = __builtin_amdgcn_readfirstlane(wn);
  const int mrow0 = m0 + wms * 128;
  const int nwb = n0 + wns * 64;
  if (ROWNORM) {
#pragma unroll
    for (int tm = 0; tm < TMW; ++tm) {
#pragma unroll
      for (int i = 0; i < 16; ++i) {
        const float rs = rowscale[wms * 128 + 4 * h + 32 * tm + (i & 3) + 8 * (i >> 2)];
        acc[tm][0][i] *= rs; acc[tm][1][i] *= rs;
      }
    }
  }
  if (EPI == EPI_SWIGLU) {
    u16* dw = (u16*)(p.ws + OFF_ACT) + (size_t)mrow0 * DFF + (nwb >> 1);
    const unsigned lo = (unsigned)(4 * h) * DFF + r;
#pragma unroll
    for (int tm = 0; tm < TMW; ++tm) {
#pragma unroll
      for (int i = 0; i < 16; ++i) {
        const float g = acc[tm][0][i], u = acc[tm][1][i];
        const float a = g * __builtin_amdgcn_rcpf(1.f + fexp2(-g * LOG2E)) * u;
        dw[lo + (unsigned)((32 * tm + (i & 3) + 8 * (i >> 2)) * DFF)] = (u16)(pack2(a, 0.f) & 0xffff);
      }
      __builtin_amdgcn_sched_barrier(0);
    }
  } else {
#pragma unroll
    for (int tn = 0; tn < 2; ++tn) {
      const int nb0 = nwb + 32 * tn;
      if (EPI == EPI_RES) {
        const float* xw = (layer == 0 ? (m0 < NPROMPT ? p.x_prompt + (size_t)mrow0 * DM : p.x_sample + (size_t)(mrow0 - NPROMPT) * DM) : p.out + (size_t)mrow0 * DM) + nb0;
        float* ow = p.out + (size_t)mrow0 * DM + nb0;
        const unsigned lo = (unsigned)(4 * h) * DM + r;
#pragma unroll
        for (int tm = 0; tm < TMW; ++tm) {
#pragma unroll
          for (int g4 = 0; g4 < 4; ++g4) {
            float xv[4];
#pragma unroll
            for (int e = 0; e < 4; ++e) xv[e] = xw[lo + (unsigned)((32 * tm + 8 * g4 + e) * DM)];
#pragma unroll
            for (int e = 0; e < 4; ++e) ow[lo + (unsigned)((32 * tm + 8 * g4 + e) * DM)] = xv[e] + acc[tm][tn][4 * g4 + e];
          }
          __builtin_amdgcn_sched_barrier(0);
        }
      } else {
        u16* dw; int ld; bool ok = true;
        if (EPI == EPI_PROJ) { dw = (u16*)(p.ws + OFF_PROJ) + (size_t)mrow0 * DIN + nb0; ld = DIN; ok = (nb0 + r) < DIN; }
        else if (EPI == EPI_UQ) { dw = (u16*)(p.ws + OFF_QD) + (size_t)mrow0 * 384 + nb0; ld = 384; ok = nb0 < 384; }
        else {
          const int head = nb0 >> 7, w = nb0 & 127;
          if (w < 64) { dw = (u16*)(p.ws + OFF_KD) + (size_t)mrow0 * 384 + head * 96 + w; ld = 384; }
          else { dw = (u16*)(p.ws + OFF_VD) + (size_t)mrow0 * 256 + head * 64 + (w - 64); ld = 256; }
        }
        const unsigned lo = (unsigned)(4 * h) * ld + r;
        if (ok) {
#pragma unroll
          for (int tm = 0; tm < TMW; ++tm) {
#pragma unroll
            for (int i = 0; i < 16; ++i) dw[lo + (unsigned)((32 * tm + (i & 3) + 8 * (i >> 2)) * ld)] = (u16)(pack2(acc[tm][tn][i], 0.f) & 0xffff);
            __builtin_amdgcn_sched_barrier(0);
          }
        }
      }
    }
  }
  if (ROWNORM) __syncthreads();
}


typedef float f32x4v __attribute__((ext_vector_type(4)));
constexpr int G8_HT = 128 * 64;
DI int lds_byte8(int r, int c) { const int st = (r >> 4) * 2 + (c >> 5), ob = (r & 15) * 64 + (c & 31) * 2; return st * 1024 + (ob ^ (((ob >> 9) & 1) << 5)); }
DI void stage_rc8(int b, int& R, int& C) { const int st = b >> 10, sb = b & 1023, swz = sb ^ (((sb >> 9) & 1) << 5); R = (st >> 1) * 16 + (swz >> 6); C = (st & 1) * 32 + ((swz & 63) >> 1); }

DI void gemm8_prestage(const u16* __restrict__ A, const u16* __restrict__ Bt, int K, int brow, int bcol, char* smem) {
  u16* shm = (u16*)smem;
  const int tid = opaque_tid();
  int sr0, sc0, sr1, sc1;
  stage_rc8(tid * 16, sr0, sc0);
  stage_rc8(tid * 16 + 8192, sr1, sc1);
  const unsigned go0 = (unsigned)sr0 * K + sc0, go1 = (unsigned)sr1 * K + sc1;
#define G8P_STAGE(P, BASE, br) do { const u16* g_ = (BASE) + (size_t)(br) * K; \
    __builtin_amdgcn_global_load_lds((const unsigned*)(g_ + go0), (__attribute__((address_space(3))) unsigned*)((char*)(P) + tid * 16), 16, 0, 0); \
    __builtin_amdgcn_global_load_lds((const unsigned*)(g_ + go1), (__attribute__((address_space(3))) unsigned*)((char*)(P) + tid * 16 + 8192), 16, 0, 0); } while (0)
  G8P_STAGE(shm + 4 * G8_HT, Bt, bcol); G8P_STAGE(shm, A, brow);
  G8P_STAGE(shm + 5 * G8_HT, Bt, bcol + 128); G8P_STAGE(shm + G8_HT, A, brow + 128);
#undef G8P_STAGE
}

template <int EPI, bool GSCALE = false>
DI void gemm8_tile(const Params& p, int layer, const u16* __restrict__ A, const u16* __restrict__ Bt, int K, int brow, int bcol, char* smem,
                   bool next_valid, int next_brow, int next_bcol) {
  u16* shm = (u16*)smem;
  const int tid = opaque_tid();
  float* gfac = (float*)(smem + 8 * G8_HT * 2);
  if (GSCALE) {
    if (tid < 256) {
      const float* sq = (const float*)(p.ws + OFF_SSQ) + (size_t)(brow + tid) * 16;
      float rs[4];
#pragma unroll
      for (int g = 0; g < 4; ++g) { const f32x4 s4 = *(const f32x4*)(sq + 4 * g); rs[g] = rsqrtf((s4[0] + s4[1] + s4[2] + s4[3]) * (1.f / 256.f) + EPS); }
      gfac[tid] = rs[0] / rs[1]; gfac[256 + tid] = rs[1] / rs[2]; gfac[512 + tid] = rs[2] / rs[3]; gfac[768 + tid] = rs[3];
    }
  }
  const int wid = tid >> 6, lane = tid & 63, wr = wid >> 2, wc = wid & 3, fr = lane & 15, fq = lane >> 4;
  int sr0, sc0, sr1, sc1;
  stage_rc8(tid * 16, sr0, sc0);
  stage_rc8(tid * 16 + 8192, sr1, sc1);
  const unsigned go0 = (unsigned)sr0 * K + sc0, go1 = (unsigned)sr1 * K + sc1;
#define G8_SA(b, hh) (shm + ((b) * 2 + (hh)) * G8_HT)
#define G8_SB(b, hh) (shm + (4 + (b) * 2 + (hh)) * G8_HT)
#define G8_STAGE(P, BASE, br, kt) do { const u16* g_ = (BASE) + (size_t)(br) * K + (size_t)(kt) * 64; \
    __builtin_amdgcn_global_load_lds((const unsigned*)(g_ + go0), (__attribute__((address_space(3))) unsigned*)((char*)(P) + tid * 16), 16, 0, 0); \
    __builtin_amdgcn_global_load_lds((const unsigned*)(g_ + go1), (__attribute__((address_space(3))) unsigned*)((char*)(P) + tid * 16 + 8192), 16, 0, 0); } while (0)
#define G8_LDA(dst, b, hh) _Pragma("unroll") for (int m = 0; m < 4; ++m) _Pragma("unroll") for (int k = 0; k < 2; ++k) \
    dst[m][k] = *reinterpret_cast<const bf16x8*>((char*)G8_SA(b, hh) + lds_byte8(wr * 64 + m * 16 + fr, k * 32 + fq * 8))
#define G8_LDB(dst, b, hh) _Pragma("unroll") for (int n = 0; n < 2; ++n) _Pragma("unroll") for (int k = 0; k < 2; ++k) \
    dst[n][k] = *reinterpret_cast<const bf16x8*>((char*)G8_SB(b, hh) + lds_byte8(wc * 32 + n * 16 + fr, k * 32 + fq * 8))
#define G8_MMA(ai, bj, At_, Bt_) do { __builtin_amdgcn_s_setprio(1); \
    _Pragma("unroll") for (int m = 0; m < 4; ++m) _Pragma("unroll") for (int n = 0; n < 2; ++n) _Pragma("unroll") for (int k = 0; k < 2; ++k) \
      acc[ai][bj][m][n] = __builtin_amdgcn_mfma_f32_16x16x32_bf16(At_[m][k], Bt_[n][k], acc[ai][bj][m][n], 0, 0, 0); \
    __builtin_amdgcn_s_setprio(0); } while (0)
#define G8_WAIT_V(n) asm volatile("s_waitcnt vmcnt(" #n ")" ::: "memory")
#define G8_WAIT_L(n) asm volatile("s_waitcnt lgkmcnt(" #n ")" ::: "memory")
#define G8_BAR __builtin_amdgcn_s_barrier()
#define G8_SCHED __builtin_amdgcn_sched_barrier(0)
  f32x4v acc[2][2][4][2];
#pragma unroll
  for (int a = 0; a < 2; ++a)
#pragma unroll
    for (int b = 0; b < 2; ++b)
#pragma unroll
      for (int m = 0; m < 4; ++m)
#pragma unroll
        for (int n = 0; n < 2; ++n) acc[a][b][m][n] = (f32x4v){0.f, 0.f, 0.f, 0.f};
  bf16x8 At[4][2], B0[2][2], B1[2][2];
  const int nt = K / 64;
  if (wr == 1) G8_BAR;
  G8_WAIT_V(4); G8_BAR;
  G8_STAGE(G8_SB(1, 0), Bt, bcol, 1); G8_STAGE(G8_SA(1, 0), A, brow, 1); G8_STAGE(G8_SB(1, 1), Bt, bcol + 128, 1);
  G8_WAIT_V(6); G8_BAR;
  for (int t = 0; t < nt - 2; t += 2) {
    G8_LDB(B0, 0, 0); G8_SCHED; G8_LDA(At, 0, 0); G8_STAGE(G8_SA(1, 1), A, brow + 128, t + 1);
    G8_WAIT_L(8); G8_BAR; G8_WAIT_L(0); G8_MMA(0, 0, At, B0); G8_BAR; G8_SCHED;
    G8_LDB(B1, 0, 1); G8_STAGE(G8_SB(0, 0), Bt, bcol, t + 2);
    G8_BAR; G8_WAIT_L(0); G8_MMA(0, 1, At, B1); G8_BAR;
    G8_LDA(At, 0, 1); G8_STAGE(G8_SA(0, 0), A, brow, t + 2);
    G8_BAR; G8_WAIT_L(0); G8_MMA(1, 0, At, B0); G8_BAR; G8_SCHED;
    G8_STAGE(G8_SB(0, 1), Bt, bcol + 128, t + 2);
    G8_WAIT_V(6); G8_BAR; G8_MMA(1, 1, At, B1); G8_BAR;
    G8_LDB(B0, 1, 0); G8_SCHED; G8_LDA(At, 1, 0); G8_STAGE(G8_SA(0, 1), A, brow + 128, t + 2);
    G8_WAIT_L(8); G8_BAR; G8_WAIT_L(0); G8_MMA(0, 0, At, B0); G8_BAR; G8_SCHED;
    G8_LDB(B1, 1, 1); G8_STAGE(G8_SB(1, 0), Bt, bcol, t + 3);
    G8_BAR; G8_WAIT_L(0); G8_MMA(0, 1, At, B1); G8_BAR;
    G8_LDA(At, 1, 1); G8_STAGE(G8_SA(1, 0), A, brow, t + 3);
    G8_BAR; G8_WAIT_L(0); G8_MMA(1, 0, At, B0); G8_BAR; G8_SCHED;
    G8_STAGE(G8_SB(1, 1), Bt, bcol + 128, t + 3);
    G8_WAIT_V(6); G8_BAR; G8_MMA(1, 1, At, B1); G8_BAR;
    if (GSCALE && (t & 3) == 2) {
      const float* gf = gfac + (t >> 2) * 256 + wr * 64 + fq * 4;
#pragma unroll
      for (int ai = 0; ai < 2; ++ai)
#pragma unroll
        for (int m = 0; m < 4; ++m) {
          const f32x4 f4 = *(const f32x4*)(gf + ai * 128 + m * 16);
#pragma unroll
          for (int bj = 0; bj < 2; ++bj)
#pragma unroll
            for (int n = 0; n < 2; ++n)
#pragma unroll
              for (int j = 0; j < 4; ++j) acc[ai][bj][m][n][j] *= f4[j];
        }
    }
  }
  { G8_LDB(B0, 0, 0); G8_LDA(At, 0, 0); G8_STAGE(G8_SA(1, 1), A, brow + 128, nt - 1);
    G8_BAR; G8_WAIT_L(0); G8_MMA(0, 0, At, B0); G8_BAR;
    G8_LDB(B1, 0, 1); G8_BAR; G8_WAIT_L(0); G8_MMA(0, 1, At, B1); G8_BAR;
    G8_LDA(At, 0, 1); G8_WAIT_V(4); G8_BAR; G8_WAIT_L(0); G8_MMA(1, 0, At, B0); G8_MMA(1, 1, At, B1); G8_BAR; }
  { G8_LDB(B0, 1, 0); G8_LDA(At, 1, 0); G8_WAIT_V(2); G8_BAR; G8_WAIT_L(0); G8_MMA(0, 0, At, B0); G8_BAR;
    G8_LDB(B1, 1, 1); G8_WAIT_V(0); G8_BAR; G8_WAIT_L(0); G8_MMA(0, 1, At, B1); G8_BAR;
    G8_LDA(At, 1, 1); G8_BAR; G8_WAIT_L(0); G8_MMA(1, 0, At, B0); G8_MMA(1, 1, At, B1); G8_BAR; }
  if (wr == 0) G8_BAR;
  if (GSCALE) {
    const float* gf = gfac + 768 + wr * 64 + fq * 4;
#pragma unroll
    for (int ai = 0; ai < 2; ++ai)
#pragma unroll
      for (int m = 0; m < 4; ++m) {
        const f32x4 f4 = *(const f32x4*)(gf + ai * 128 + m * 16);
#pragma unroll
        for (int bj = 0; bj < 2; ++bj)
#pragma unroll
          for (int n = 0; n < 2; ++n)
#pragma unroll
            for (int j = 0; j < 4; ++j) acc[ai][bj][m][n][j] *= f4[j];
      }
  }
  if (next_valid) gemm8_prestage(A, Bt, K, next_brow, next_bcol, smem);
  const int wrs = __builtin_amdgcn_readfirstlane(wr), wcs = __builtin_amdgcn_readfirstlane(wc);
  if (EPI == EPI_RES) {
#pragma unroll
    for (int ai = 0; ai < 2; ++ai) {
      const int mrow0 = brow + ai * 128 + wrs * 64;
      const float* xw = (layer == 0 ? (brow < NPROMPT ? p.x_prompt + (size_t)mrow0 * DM : p.x_sample + (size_t)(mrow0 - NPROMPT) * DM) : p.out + (size_t)mrow0 * DM) + bcol + wcs * 32;
      float* ow = p.out + (size_t)mrow0 * DM + bcol + wcs * 32;
      const unsigned lo = (unsigned)(fq * 4) * DM + fr;
      float xv[4][4][4];
#pragma unroll
      for (int m = 0; m < 4; ++m)
#pragma unroll
        for (int j = 0; j < 4; ++j) {
          const float* xr = xw + (lo + (unsigned)((m * 16 + j) * DM));
#pragma unroll
          for (int c = 0; c < 4; ++c) xv[m][j][c] = xr[(c >> 1) * 128 + (c & 1) * 16];
        }
      __builtin_amdgcn_sched_barrier(0);
#pragma unroll
      for (int m = 0; m < 4; ++m)
#pragma unroll
        for (int j = 0; j < 4; ++j) {
          float* orow = ow + (lo + (unsigned)((m * 16 + j) * DM));
#pragma unroll
          for (int c = 0; c < 4; ++c) orow[(c >> 1) * 128 + (c & 1) * 16] = xv[m][j][c] + acc[ai][c >> 1][m][c & 1][j];
        }
      __builtin_amdgcn_sched_barrier(0);
    }
  }
#pragma unroll
  for (int ai = 0; ai < 2 && EPI != EPI_RES; ++ai) {
    const int mrow0 = brow + ai * 128 + wrs * 64;
#pragma unroll
    for (int bj = 0; bj < 2; ++bj) {
      const int ncol0 = bcol + bj * 128 + wcs * 32;
      if (EPI == EPI_SWIGLU) {
        u16* dw = (u16*)(p.ws + OFF_ACT) + (size_t)mrow0 * DFF + (ncol0 >> 1);
        const unsigned lo = (unsigned)(fq * 4) * DFF + fr;
#pragma unroll
        for (int m = 0; m < 4; ++m) {
#pragma unroll
          for (int j = 0; j < 4; ++j) {
            const float g = acc[ai][bj][m][0][j], u = acc[ai][bj][m][1][j];
            const float a = g * __builtin_amdgcn_rcpf(1.f + fexp2(-g * LOG2E)) * u;
            dw[lo + (unsigned)((m * 16 + j) * DFF)] = (u16)(pack2(a, 0.f) & 0xffff);
          }
        }
        __builtin_amdgcn_sched_barrier(0);
      } else if (EPI == EPI_RES) {
      } else {
#pragma unroll
        for (int n = 0; n < 2; ++n) {
          const int nb0 = ncol0 + n * 16;
          if (nb0 < DIN) {
            u16* dw = (u16*)(p.ws + OFF_PROJ) + (size_t)mrow0 * DIN + nb0;
            const unsigned lo = (unsigned)(fq * 4) * DIN + fr;
#pragma unroll
            for (int m = 0; m < 4; ++m)
#pragma unroll
              for (int j = 0; j < 4; ++j) dw[lo + (unsigned)((m * 16 + j) * DIN)] = (u16)(pack2(acc[ai][bj][m][n][j], 0.f) & 0xffff);
          }
          __builtin_amdgcn_sched_barrier(0);
        }
      }
    }
  }
  G8_WAIT_V(0);
  __syncthreads();
}

DI void e1_chunk(const Params& p, int layer, int chunk) {
  const int j = chunk & 7;
  const size_t tok = (size_t)(chunk >> 3) * NTHR + opaque_tid();
  if (j == 7) return;
  u16* proj = (u16*)(p.ws + OFF_PROJ);
  const int t = (int)(tok & 4095);
  if (j < 6) {
    u16* ptr = proj + tok * DIN + (j < 4 ? 768 + 64 * j : 1024 + 64 * (j - 4));
    const float* gain = (j < 4 ? p.b_q_gain : p.b_k_gain) + layer * 64;
    const float post = j < 4 ? QSCALE64 : 1.f;
    float x[64];
    float ss = 0.f;
#pragma unroll
    for (int c = 0; c < 8; ++c) {
      u32x4 w = *(const u32x4*)(ptr + c * 8);
#pragma unroll
      for (int e = 0; e < 4; ++e) { x[c * 8 + 2 * e] = bflo(w[e]); x[c * 8 + 2 * e + 1] = bfhi(w[e]); }
    }
#pragma unroll
    for (int d = 0; d < 64; ++d) ss += x[d] * x[d];
    const float rstd = rsqrtf(ss * (1.f / 64.f) + EPS);
    __builtin_amdgcn_sched_barrier(0);
#pragma unroll
    for (int c = 0; c < 4; ++c) {
#pragma unroll
      for (int d = 0; d < 16; ++d) x[c * 16 + d] = x[c * 16 + d] * rstd * gain[c * 16 + d];
      __builtin_amdgcn_sched_barrier(0);
    }
    const int prow = t >> 6, pcol = t & 63;
    { float* xa = x; float* xb = x + 16; ROPE16(p.ws, prow, xa, xb); }
    __builtin_amdgcn_sched_barrier(0);
    { float* xa = x + 32; float* xb = x + 48; ROPE16(p.ws, pcol, xa, xb); }
    __builtin_amdgcn_sched_barrier(0);
#pragma unroll
    for (int c = 0; c < 8; ++c) {
      u32x4 w;
#pragma unroll
      for (int e = 0; e < 4; ++e) w[e] = pack2(x[c * 8 + 2 * e] * post, x[c * 8 + 2 * e + 1] * post);
      *(u32x4*)(ptr + c * 8) = w;
    }
  } else {
    const u16* src = proj + tok * DIN + 2432;
    float x[32];
#pragma unroll
    for (int c = 0; c < 4; ++c) {
      u32x4 w = *(const u32x4*)(src + c * 8);
#pragma unroll
      for (int e = 0; e < 4; ++e) { x[c * 8 + 2 * e] = bflo(w[e]); x[c * 8 + 2 * e + 1] = bfhi(w[e]); }
    }
    { float* xa = x; float* xb = x + 16; ROPE16(p.ws, t, xa, xb); }
    u16* kd = (u16*)(p.ws + OFF_KD) + tok * 384 + 64;
#pragma unroll
    for (int c = 0; c < 4; ++c) {
      u32x4 w;
#pragma unroll
      for (int e = 0; e < 4; ++e) w[e] = pack2(x[c * 8 + 2 * e], x[c * 8 + 2 * e + 1]);
#pragma unroll
      for (int hh = 0; hh < 4; ++hh) *(u32x4*)(kd + hh * 96 + c * 8) = w;
    }
  }
}

template <int MODE>
DI void attn_tile(const Params& p, int layer, int tile, char* smem) {
  constexpr int DQK = (MODE == 3) ? 96 : 64;
  constexpr int NKQ = DQK / 16;
  constexpr int KROW = DQK + 8;
  constexpr int VROW = 72;
  constexpr int KCH = DQK / 8;
  constexpr int KLD = (64 * KCH + NTHR - 1) / NTHR;
  u16* Ks = (u16*)smem;
  u16* Vs = (u16*)(smem + 26624);
  float* tbl = (float*)(smem + 26624 + 18432);

  const int tid = opaque_tid(), lane = tid & 63, wave = tid >> 6, r = lane & 31, h = lane >> 5;
  const int qb = tile & 15, head = (tile >> 4) & 3, seq = tile >> 6;
  const size_t tok0 = (size_t)seq * SEQ;
  const u16* proj = (const u16*)(p.ws + OFF_PROJ);
  const u16 *Qp, *Kp, *Vp;
  int ldq, ldk, ldv;
  if (MODE == 0) { Qp = proj + 64 * head; Kp = proj + 256 + 64 * head; Vp = proj + 512 + 64 * head; ldq = ldk = ldv = DIN; }
  else if (MODE == 1) { Qp = proj + 768 + 64 * head; Kp = proj + 1024 + 64 * (head >> 1); Vp = proj + 1152 + 64 * (head >> 1); ldq = ldk = ldv = DIN; }
  else if (MODE == 2) { Qp = proj + 1280 + 64 * head; Kp = proj + 1536 + 64 * head; Vp = proj + 1792 + 64 * head; ldq = ldk = ldv = DIN; }
  else { Qp = (const u16*)(p.ws + OFF_QD) + 96 * head; Kp = (const u16*)(p.ws + OFF_KD) + 96 * head; Vp = (const u16*)(p.ws + OFF_VD) + 64 * head; ldq = ldk = 384; ldv = 256; }

  int kt0 = 0, kt1 = 64;
  if (MODE == 0) { kt0 = 4 * qb - 16; if (kt0 < 0) kt0 = 0; kt1 = 4 * qb + 20; if (kt1 > 64) kt1 = 64; }
  if (MODE == 2) { int r0 = 4 * qb - 4; r0 = r0 < 0 ? 0 : (r0 > 56 ? 56 : r0); int r1 = 4 * qb + 3 - 4; r1 = r1 < 0 ? 0 : (r1 > 56 ? 56 : r1); kt0 = r0; kt1 = r1 + 8; }

  if (MODE == 0) { const float* src = (const float*)(p.ws + OFF_TBLA) + head * 2560; for (int i = tid; i < 2560; i += NTHR) tbl[i] = src[i]; }
  if (MODE == 2) { const float* src = p.c_rpb + (size_t)(layer * 4 + head) * 465; for (int i = tid; i < 465; i += NTHR) tbl[i] = src[i] * LOG2E; }

  const int qpos = qb * 256 + wave * 32 + r;
  bf16x8 qf[NKQ];
  {
    const u16* qrow = Qp + (tok0 + qpos) * ldq + 8 * h;
#pragma unroll
    for (int d0 = 0; d0 < NKQ; ++d0) qf[d0] = *(const bf16x8*)(qrow + d0 * 16);
  }
  if (MODE == 3) {
    bf16x8 x1 = qf[NKQ - 2], x2 = qf[NKQ - 1];
    const f32x4* rt = (const f32x4*)(p.ws + OFF_ROPE) + (size_t)qpos * 8 + 4 * h;
#pragma unroll
    for (int j2 = 0; j2 < 4; ++j2) {
      const f32x4 cs4 = rt[j2];
#pragma unroll
      for (int e = 0; e < 2; ++e) {
        const int j = 2 * j2 + e;
        const float c = cs4[2 * e], sn = cs4[2 * e + 1];
        float a = __uint_as_float(((unsigned)(u16)x1[j]) << 16), b = __uint_as_float(((unsigned)(u16)x2[j]) << 16);
        unsigned w = pack2(a * c - b * sn, a * sn + b * c);
        x1[j] = (short)(w & 0xffff); x2[j] = (short)(w >> 16);
      }
    }
    qf[NKQ - 2] = x1; qf[NKQ - 1] = x2;
  }

  u32x4 rk0[KLD], rv0, rk1[KLD], rv1;
  const u16* Kt = Kp + tok0 * ldk;
  const u16* Vt = Vp + tok0 * ldv;
  unsigned koff[KLD];
#pragma unroll
  for (int pp = 0; pp < KLD; ++pp) { int c = tid + NTHR * pp; if (c >= 64 * KCH) c = tid; const int row = c / KCH, col = c % KCH; koff[pp] = (unsigned)row * ldk + col * 8; }
  const unsigned voff = (unsigned)(tid >> 3) * ldv + (tid & 7) * 8;
  const int ktl = kt1 - 1;
  auto gload = [&](u32x4 (&rk)[KLD], u32x4& rv, int kt) {
    kt = kt < ktl ? kt : ktl;
#pragma unroll
    for (int pp = 0; pp < KLD; ++pp) rk[pp] = *(const u32x4*)(Kt + (koff[pp] + (unsigned)(kt * 64) * ldk));
    rv = *(const u32x4*)(Vt + (voff + (unsigned)(kt * 64) * ldv));
  };
  auto lstore = [&](u32x4 (&rk)[KLD], u32x4& rv, int buf) {
#pragma unroll
    for (int pp = 0; pp < KLD; ++pp) { const int c = tid + NTHR * pp; if (c < 64 * KCH) { const int row = c / KCH, col = c % KCH; *(u32x4*)(Ks + (buf * 64 + row) * KROW + col * 8) = rk[pp]; } }
    *(u32x4*)(Vs + (buf * 64 + (tid >> 3)) * VROW + (tid & 7) * 8) = rv;
  };

  f32x16 o0, o1, negm;
#pragma unroll
  for (int i = 0; i < 16; ++i) { o0[i] = 0.f; o1[i] = 0.f; negm[i] = 0.f; }
  float mref = 0.f, lsum = 0.f;
  bool started = false;
  int qr = 0, qc = 0, cs = 0, rs = 0;
  if (MODE == 2) { qr = qpos >> 6; qc = qpos & 63; cs = qc - 8; cs = cs < 0 ? 0 : (cs > 48 ? 48 : cs); rs = qr - 4; rs = rs < 0 ? 0 : (rs > 56 ? 56 : rs); }
  const int i16 = lane & 15, qq = i16 >> 2, pp4 = i16 & 3, g16 = (lane >> 4) & 1;

  auto compute = [&](int buf, int kt) {
    bool active = true;
    if (MODE == 2) active = (kt >= rs) && (kt < rs + 8);
    if (active) {
      const u16* Kb = Ks + buf * 64 * KROW + r * KROW + 8 * h;
      const u16* Vb = Vs + buf * 64 * VROW;
      bf16x8 vf[8];
#pragma unroll
      for (int cs2 = 0; cs2 < 4; ++cs2) {
        const u16* vp = Vb + (16 * cs2 + 4 * h + qq) * VROW + 16 * g16 + 4 * pp4;
        { s16x4 lo = tr_read(vp), hi = tr_read(vp + 8 * VROW); vf[2 * cs2] = __builtin_shufflevector(lo, hi, 0, 1, 2, 3, 4, 5, 6, 7); }
        { s16x4 lo = tr_read(vp + 32), hi = tr_read(vp + 8 * VROW + 32); vf[2 * cs2 + 1] = __builtin_shufflevector(lo, hi, 0, 1, 2, 3, 4, 5, 6, 7); }
      }
      f32x16 s0 = negm, s1 = negm;
#pragma unroll
      for (int d0 = 0; d0 < NKQ; ++d0) {
        bf16x8 k0 = *(const bf16x8*)(Kb + d0 * 16);
        bf16x8 k1 = *(const bf16x8*)(Kb + 32 * KROW + d0 * 16);
        s0 = mfma(k0, qf[d0], s0);
        s1 = mfma(k1, qf[d0], s1);
      }
      if (MODE == 0) {
        const float* tb = tbl + (kt * 64 + 4 * h - qpos + 1280);
#pragma unroll
        for (int i = 0; i < 16; ++i) { s0[i] += tb[(i & 3) + 8 * (i >> 2)]; s1[i] += tb[32 + (i & 3) + 8 * (i >> 2)]; }
      }
      if (MODE == 2) {
        const float* tb = tbl + (kt - qr + 7) * 31 + (15 - qc);
#pragma unroll
        for (int i = 0; i < 16; ++i) {
          const int kc0 = 4 * h + (i & 3) + 8 * (i >> 2), kc1 = kc0 + 32;
          const bool v0 = (kc0 >= cs) && (kc0 < cs + 16), v1 = (kc1 >= cs) && (kc1 < cs + 16);
          const float b0 = tb[v0 ? kc0 : qc], b1 = tb[v1 ? kc1 : qc];
          s0[i] = v0 ? s0[i] + b0 : NEGBIG;
          s1[i] = v1 ? s1[i] + b1 : NEGBIG;
        }
      }
      float ma = __builtin_fmaxf(__builtin_fmaxf(s0[0], s0[1]), s0[2]), mb = __builtin_fmaxf(__builtin_fmaxf(s1[0], s1[1]), s1[2]);
#pragma unroll
      for (int i = 3; i < 15; i += 2) { ma = __builtin_fmaxf(__builtin_fmaxf(ma, s0[i]), s0[i + 1]); mb = __builtin_fmaxf(__builtin_fmaxf(mb, s1[i]), s1[i + 1]); }
      float mt = __builtin_fmaxf(__builtin_fmaxf(ma, s0[15]), s1[15]);
      mt = hmax(__builtin_fmaxf(mt, mb));
      const bool fresh = !started && (mt > -1e29f);
      if (__any(fresh || (started && mt > 8.f))) {
        float delta = 0.f, al = 1.f;
        if (fresh) { delta = mt; started = true; }
        else if (started) { delta = __builtin_fmaxf(mt, 0.f); al = fexp2(-delta); }
        mref += delta;
        lsum *= al;
#pragma unroll
        for (int i = 0; i < 16; ++i) { o0[i] *= al; o1[i] *= al; s0[i] -= delta; s1[i] -= delta; negm[i] = -mref; }
      }
      float ps = 0.f;
#pragma unroll
      for (int i = 0; i < 16; ++i) { s0[i] = fexp2(s0[i]); s1[i] = fexp2(s1[i]); ps += s0[i] + s1[i]; }
      lsum += ps;
#pragma unroll
      for (int c = 0; c < 2; ++c) {
#pragma unroll
        for (int s = 0; s < 2; ++s) {
          u32x4 pw;
          if (c == 0) pw = (u32x4){pack2(s0[8 * s], s0[8 * s + 1]), pack2(s0[8 * s + 2], s0[8 * s + 3]), pack2(s0[8 * s + 4], s0[8 * s + 5]), pack2(s0[8 * s + 6], s0[8 * s + 7])};
          else pw = (u32x4){pack2(s1[8 * s], s1[8 * s + 1]), pack2(s1[8 * s + 2], s1[8 * s + 3]), pack2(s1[8 * s + 4], s1[8 * s + 5]), pack2(s1[8 * s + 6], s1[8 * s + 7])};
          const bf16x8 pf = __builtin_bit_cast(bf16x8, pw);
          o0 = mfma(vf[2 * (2 * c + s)], pf, o0);
          o1 = mfma(vf[2 * (2 * c + s) + 1], pf, o1);
        }
      }
    }
  };

  const int ntile = kt1 - kt0;
  gload(rk1, rv1, kt0);
  gload(rk0, rv0, kt0 + 1);
  lstore(rk1, rv1, 0);
  gload(rk1, rv1, kt0 + 2);
  __syncthreads();
  for (int j = 0; j < ntile; j += 2) {
    compute(0, kt0 + j);
    lstore(rk0, rv0, 1);
    gload(rk0, rv0, kt0 + j + 3);
    __syncthreads();
    if (j + 1 >= ntile) break;
    compute(1, kt0 + j + 1);
    lstore(rk1, rv1, 0);
    gload(rk1, rv1, kt0 + j + 4);
    __syncthreads();
  }
  lsum = hsum(lsum);
  const float inv = 1.f / lsum;
  float sq = 0.f;
#pragma unroll
  for (int i = 0; i < 16; ++i) { o0[i] *= inv; o1[i] *= inv; sq += o0[i] * o0[i] + o1[i] * o1[i]; }
  sq = hsum(sq);
  if (h == 0) ((float*)(p.ws + OFF_SSQ))[(tok0 + qpos) * 16 + MODE * 4 + head] = sq;
  u16* op = (u16*)(p.ws + OFF_ACTB) + (tok0 + qpos) * DM + MODE * 256 + head * 64 + 4 * h;
#pragma unroll
  for (int g4 = 0; g4 < 4; ++g4) {
    u32x2 w0 = {pack2(o0[4 * g4], o0[4 * g4 + 1]), pack2(o0[4 * g4 + 2], o0[4 * g4 + 3])};
    u32x2 w1 = {pack2(o1[4 * g4], o1[4 * g4 + 1]), pack2(o1[4 * g4 + 2], o1[4 * g4 + 3])};
    *(u32x2*)(op + 8 * g4) = w0;
    *(u32x2*)(op + 32 + 8 * g4) = w1;
  }
}


DI bool sb_tile(int bid, int nb, int it, int NT, int& mt, int& nt) {
  const int G = nb >> 3, x = bid & 7, l = bid >> 3;
  const int s = l + it * G;
  const int sb = (s >> 5) * 8 + x, w = s & 31;
  if (NT == 4) {
    if (sb >= 48) return false;
    mt = sb * 8 + (w >> 2); nt = w & 3;
    return true;
  }
  const int NG = NT >> 1;
  if (sb >= 24 * NG) return false;
  const int mg = sb / NG, ng = sb - mg * NG;
  mt = mg * 16 + (w >> 1); nt = ng * 2 + (w & 1);
  return true;
}

DI bool att_tile_index(int bid, int nb, int it, int& tile) {
  if (nb != 256) { tile = bid + it * nb; return tile < 1536; }
  const int x = bid & 7, l = bid >> 3;
  const int pair = 2 * (it * 8 + x) + (l >> 4);
  tile = pair * 16 + ((l + 3 * it) & 15);
  return pair < 96;
}

template <int EPI, bool GSCALE = false>
DI void gemm8_phase(const Params& p, int layer, const u16* A, const u16* Bt, int K, int NT, char* smem) {
  const int bid = blockIdx.x, nb = gridDim.x;
  int mt, nt;
  bool have = sb_tile(bid, nb, 0, NT, mt, nt);
  if (have) gemm8_prestage(A, Bt, K, mt * 256, nt * 256, smem);
  for (int it = 0; have; ++it) {
    int mt2 = 0, nt2 = 0;
    const bool have2 = sb_tile(bid, nb, it + 1, NT, mt2, nt2);
    gemm8_tile<EPI, GSCALE>(p, layer, A, Bt, K, mt * 256, nt * 256, smem, have2, mt2 * 256, nt2 * 256);
    have = have2; mt = mt2; nt = nt2;
  }
}

constexpr int NPHASE = 17;
constexpr int MT = T_TOK / 256;

DI void run_phase(const Params& p, int ph, char* smem) {
  const int bid = blockIdx.x, nb = gridDim.x;
  u16* wtb = (u16*)(p.ws + OFF_WT);
  const u16* actb = (const u16*)(p.ws + OFF_ACTB);
  if (ph == 0) {
    for (int j = bid; j < 128; j += nb) rope_tab_build(p.ws, j * NTHR + opaque_tid());
    for (int j = bid; j < WJ_TOTAL; j += nb) wprep_job(p, j, smem);
    for (int rb = bid; rb < T_TOK / (8 * NRW); rb += nb) norm_rows(p, 0, rb, 0);
    return;
  }
  if (ph == 16) { for (int rb = bid; rb < T_TOK / (8 * NRW); rb += nb) norm_rows(p, 1, rb, 1); return; }
  const int layer = (ph - 1) >> 3, sub = (ph - 1) & 7;
  const u16* wl = wtb + (size_t)layer * WT_LAYER;
  switch (sub) {
    case 0:
      gemm8_phase<EPI_PROJ>(p, layer, actb, wl + WT_IN, 1024, 10, smem);
      break;
    case 1:
      for (int c = bid; c < (T_TOK / NTHR) * 8; c += nb) e1_chunk(p, layer, c);
      for (int t = bid; t < MT * 2; t += nb) { const int nt = t & 1, mt = t >> 1; gemm_tile<EPI_UQ, false, true>(p, layer, (const u16*)(p.ws + OFF_PROJ) + 2048, DIN, wl + WT_UQ, 256, mt * 256, nt * 256, smem); }
      for (int t = bid; t < MT * 2; t += nb) { const int nt = t & 1, mt = t >> 1; gemm_tile<EPI_UKV, false, true>(p, layer, (const u16*)(p.ws + OFF_PROJ) + 2304, DIN, wl + WT_UKV, 128, mt * 256, nt * 256, smem); }
      break;
    case 2:
      for (int it = 0, t; att_tile_index(bid, nb, it, t); ++it) attn_tile<3>(p, layer, t, smem);
      for (int it = 0, t; att_tile_index(bid, nb, it, t); ++it) attn_tile<1>(p, layer, t, smem);
      for (int it = 0, t; att_tile_index(bid, nb, it, t); ++it) attn_tile<0>(p, layer, t, smem);
      for (int it = 0, t; att_tile_index(bid, nb, it, t); ++it) attn_tile<2>(p, layer, t, smem);
      break;
    case 3:
      gemm8_phase<EPI_RES, true>(p, layer, actb, wl + WT_OUT, 1024, 4, smem);
      break;
    case 4:
      for (int rb = bid; rb < T_TOK / (8 * NRW); rb += nb) norm_rows(p, 1, rb, 0);
      break;
    case 5:
      gemm8_phase<EPI_SWIGLU>(p, layer, actb, wl + WT_GU, 1024, 22, smem);
      break;
    case 6:
      gemm8_phase<EPI_RES>(p, 1, (const u16*)(p.ws + OFF_ACT), wl + WT_DN, DFF, 4, smem);
      break;
    case 7:
      for (int rb = bid; rb < T_TOK / (8 * NRW); rb += nb) norm_rows(p, 1, rb, 0);
      break;
  }
}

__global__ void __launch_bounds__(NTHR, 2) mega(Params p, int ph_lo, int ph_hi) {
  __shared__ __attribute__((aligned(16))) char smem[SMEM_BYTES];
  cg::grid_group grid = cg::this_grid();
  for (int ph = ph_lo; ph < ph_hi; ++ph) {
    if (ph > ph_lo) grid.sync();
    run_phase(p, ph, smem);
#ifdef DUPMASK
    if (ph >= 1 && ph < 16 && ((DUPMASK >> ((ph - 1) & 7)) & 1)) { grid.sync(); run_phase(p, ph, smem); }
#endif
  }
}

extern "C" void kernel_launch(void* const* d_in, const int* in_sizes, int n_in, void* d_out, int out_size, void* d_ws, size_t ws_size, hipStream_t stream) {
  Params p{};
  p.x_prompt = (const float*)d_in[0]; p.x_sample = (const float*)d_in[1]; p.t5_bias = (const float*)d_in[2]; p.norm_mix = (const float*)d_in[3];
  p.w_in = (const float*)d_in[4]; p.b_q_gain = (const float*)d_in[5]; p.b_k_gain = (const float*)d_in[6]; p.c_rpb = (const float*)d_in[7];
  p.d_q_gain = (const float*)d_in[8]; p.d_w_uq = (const float*)d_in[9]; p.d_kv_gain = (const float*)d_in[10]; p.d_w_ukv = (const float*)d_in[11];
  p.out_gain = (const float*)d_in[12]; p.w_out = (const float*)d_in[13]; p.norm_ffn = (const float*)d_in[14]; p.w_gate = (const float*)d_in[15];
  p.w_up = (const float*)d_in[16]; p.w_down = (const float*)d_in[17]; p.final_norm = (const float*)d_in[18];
  p.out = (float*)d_out; p.ws = (char*)d_ws;
  if (ws_size < WS_NEED) { fprintf(stderr, "workspace too small: %zu < %zu\n", ws_size, (size_t)WS_NEED); return; }
  static int grid_blocks = 0;
  if (!grid_blocks) {
    int dev = 0, cus = 0, per_cu = 0;
    hipGetDevice(&dev);
    hipDeviceGetAttribute(&cus, hipDeviceAttributeMultiprocessorCount, dev);
    hipOccupancyMaxActiveBlocksPerMultiprocessor(&per_cu, mega, NTHR, 0);
    if (per_cu < 1) per_cu = 1;
    if (per_cu > 1) per_cu = 1;
    grid_blocks = cus * per_cu;
  }
#if ONE_LAUNCH
  int lo = 0, hi = NPHASE;
  void* args[] = {&p, &lo, &hi};
  hipError_t e = hipLaunchCooperativeKernel((void*)mega, dim3(grid_blocks), dim3(NTHR), args, 0, stream);
  if (e != hipSuccess) fprintf(stderr, "cooperative launch failed: %s (grid %d)\n", hipGetErrorString(e), grid_blocks);
#else
  for (int ph = 0; ph < NPHASE; ++ph) hipLaunchKernelGGL(mega, dim3(grid_blocks), dim3(NTHR), 0, stream, p, ph, ph + 1);
#endif
}
```

```cpp
#include <hip/hip_runtime.h>
#include <hip/hip_cooperative_groups.h>
#include <cstdio>
#include <cstdint>
namespace cg = cooperative_groups;

#ifndef ONE_LAUNCH
#define ONE_LAUNCH 1
#endif

#define DI __device__ __forceinline__
typedef short bf16x8 __attribute__((ext_vector_type(8)));
typedef short s16x4 __attribute__((ext_vector_type(4)));
typedef float f32x16 __attribute__((ext_vector_type(16)));
typedef float f32x4 __attribute__((ext_vector_type(4)));
typedef float f32x2 __attribute__((ext_vector_type(2)));
typedef unsigned u32x4 __attribute__((ext_vector_type(4)));
typedef unsigned u32x2 __attribute__((ext_vector_type(2)));
typedef __bf16 bf16v2 __attribute__((ext_vector_type(2)));
typedef unsigned short u16;

constexpr int T_TOK = 98304, SEQ = 4096, DM = 1024, DIN = 2464, DINP = 2560, DFF = 2816;
constexpr int NPROMPT = 8 * 4096;
constexpr int NTHR = 512;
constexpr float LOG2E = 1.4426950408889634f;
constexpr float QSCALE64 = 0.125f * LOG2E;
constexpr float QSCALE96 = 0.10206207261596575f * LOG2E;
constexpr float NEGBIG = -1e30f;
constexpr float EPS = 1e-6f;

constexpr size_t al256(size_t x) { return (x + 255) & ~(size_t)255; }
constexpr size_t WT_IN = 0;
constexpr size_t WT_UQ = WT_IN + (size_t)DINP * 1024;
constexpr size_t WT_UKV = WT_UQ + 512 * 256;
constexpr size_t WT_OUT = WT_UKV + 512 * 128;
constexpr size_t WT_GU = WT_OUT + 1024 * 1024;
constexpr size_t WT_DN = WT_GU + (size_t)5632 * 1024;
constexpr size_t WT_LAYER = WT_DN + (size_t)1024 * 2816;
constexpr size_t OFF_WT = 0;
constexpr size_t OFF_TBLA = al256(OFF_WT + 2 * WT_LAYER * 2);
constexpr size_t OFF_ROPE = al256(OFF_TBLA + 4 * 2560 * 4);
constexpr size_t OFF_ACTB = al256(OFF_ROPE + 4096 * 16 * 8);
constexpr size_t OFF_PROJ = al256(OFF_ACTB + (size_t)T_TOK * 1024 * 2);
constexpr size_t OFF_QD = al256(OFF_PROJ + (size_t)T_TOK * DIN * 2);
constexpr size_t OFF_KD = al256(OFF_QD + (size_t)T_TOK * 384 * 2);
constexpr size_t OFF_VD = al256(OFF_KD + (size_t)T_TOK * 384 * 2);
constexpr size_t OFF_SSQ = al256(OFF_VD + (size_t)T_TOK * 256 * 2);
constexpr size_t WS_NEED = al256(OFF_SSQ + (size_t)T_TOK * 16 * 4);
constexpr size_t OFF_ACT = OFF_PROJ;
static_assert(OFF_ACT + (size_t)T_TOK * DFF * 2 <= OFF_KD, "act alias overflow");

struct Params {
  const float *x_prompt, *x_sample, *t5_bias, *norm_mix, *w_in, *b_q_gain, *b_k_gain, *c_rpb, *d_q_gain, *d_w_uq,
      *d_kv_gain, *d_w_ukv, *out_gain, *w_out, *norm_ffn, *w_gate, *w_up, *w_down, *final_norm;
  float* out;
  char* ws;
};

constexpr int SMEM_BYTES = 2 * (256 + 256) * 72 * 2 + 1024;

DI unsigned pack2(float a, float b) { f32x2 v = {a, b}; bf16v2 r = __builtin_convertvector(v, bf16v2); return __builtin_bit_cast(unsigned, r); }
DI float bflo(unsigned w) { return __uint_as_float(w << 16); }
DI float bfhi(unsigned w) { return __uint_as_float(w & 0xffff0000u); }
DI f32x16 mfma(bf16x8 a, bf16x8 b, f32x16 c) { return __builtin_amdgcn_mfma_f32_32x32x16_bf16(a, b, c, 0, 0, 0); }
DI float hmax(float v) {
  auto rr = __builtin_amdgcn_permlane32_swap(__float_as_uint(v), __float_as_uint(v), false, false);
  return __builtin_fmaxf(__uint_as_float(rr[0]), __uint_as_float(rr[1]));
}
DI float hsum(float v) {
  auto rr = __builtin_amdgcn_permlane32_swap(__float_as_uint(v), __float_as_uint(v), false, false);
  return __uint_as_float(rr[0]) + __uint_as_float(rr[1]);
}
DI float fexp2(float x) { return __builtin_amdgcn_exp2f(x); }
DI int crow(int i, int h) { return (i & 3) + 8 * (i >> 2) + 4 * h; }
typedef short v4i16_t __attribute__((ext_vector_type(4)));
DI s16x4 tr_read(const u16* p) {
  return __builtin_bit_cast(s16x4, __builtin_amdgcn_ds_read_tr16_b64_v4i16((__attribute__((address_space(3))) v4i16_t*)p));
}
constexpr double inv_rev_c(int i) {
  constexpr double b[4] = {1.0, 0.5623413251903491, 0.31622776601683794, 0.1778279410038923};
  double v = b[i & 3];
  for (int k = 0; k < (i >> 2); ++k) v *= 0.1;
  return v * 0.15915494309189535;
}
DI void rope_tab_build(char* ws, int idx) {
  const int pos = idx >> 4, i = idx & 15;
  double invrev = inv_rev_c(0);
#pragma unroll
  for (int k = 1; k < 16; ++k) if (i == k) invrev = inv_rev_c(k);
  double rev = (double)pos * invrev;
  float f = (float)(rev - (double)(int)rev);
  f32x2 cs = {__builtin_amdgcn_cosf(f), __builtin_amdgcn_sinf(f)};
  ((f32x2*)(ws + OFF_ROPE))[idx] = cs;
}
#define ROPE16(ws_, pos_, A_, B_)                                                              \
  {                                                                                            \
    const f32x4* rt_ = (const f32x4*)((ws_) + OFF_ROPE) + (size_t)(pos_) * 8;                  \
    _Pragma("unroll") for (int i2_ = 0; i2_ < 8; ++i2_) {                                      \
      const f32x4 cs_ = rt_[i2_];                                                              \
      float a_ = A_[2 * i2_], b_ = B_[2 * i2_];                                                \
      A_[2 * i2_] = a_ * cs_[0] - b_ * cs_[1]; B_[2 * i2_] = a_ * cs_[1] + b_ * cs_[0];        \
      a_ = A_[2 * i2_ + 1]; b_ = B_[2 * i2_ + 1];                                              \
      A_[2 * i2_ + 1] = a_ * cs_[2] - b_ * cs_[3]; B_[2 * i2_ + 1] = a_ * cs_[3] + b_ * cs_[2]; \
    }                                                                                          \
  }
DI const float* xrow(const Params& p, int layer, size_t tok) {
  if (layer == 0) return tok < (size_t)NPROMPT ? p.x_prompt + tok * DM : p.x_sample + (tok - NPROMPT) * DM;
  return p.out + tok * DM;
}

DI int opaque_tid() { int t = threadIdx.x; asm volatile("" : "+v"(t)); return t; }
DI void wt_tile(const float* __restrict__ W, int K, int N, const float* __restrict__ g, u16* __restrict__ Wt, int k0, int n0, int mapmode, float* tile) {
  const int tid = opaque_tid();
  for (int i = tid; i < 4096; i += NTHR) {
    int kk = i >> 6, nn = i & 63, n = n0 + nn;
    float v = 0.f;
    if (n < N) { v = W[(size_t)(k0 + kk) * N + n]; if (g) v *= g[k0 + kk]; }
    tile[kk * 65 + nn] = v;
  }
  __syncthreads();
  for (int i = tid; i < 2048; i += NTHR) {
    int nn = i >> 5, kp = i & 31, n = n0 + nn;
    float cs = 1.f; int drow = n;
    if (mapmode == 1) { if (n < 256 || (n >= 1280 && n < 1536)) cs = QSCALE64; }
    else if (mapmode == 2) cs = QSCALE96;
    else if (mapmode == 3) drow = 32 * (n >> 4) + (n & 15);
    else if (mapmode == 4) drow = 32 * (n >> 4) + 16 + (n & 15);
    unsigned w = pack2(tile[(2 * kp) * 65 + nn] * cs, tile[(2 * kp + 1) * 65 + nn] * cs);
    *(unsigned*)(Wt + (size_t)drow * K + k0 + 2 * kp) = w;
  }
  __syncthreads();
}

constexpr int WJ_IN = 640, WJ_UQ = 32, WJ_UKV = 16, WJ_OUT = 256, WJ_G = 704, WJ_U = 704, WJ_D = 704;
constexpr int WJ_LAYER = WJ_IN + WJ_UQ + WJ_UKV + WJ_OUT + WJ_G + WJ_U + WJ_D;
constexpr int WJ_TOTAL = 2 * WJ_LAYER + 20;

DI void wprep_job(const Params& p, int job, char* smem) {
  float* tile = (float*)smem;
  u16* wtb = (u16*)(p.ws + OFF_WT);
  if (job >= 2 * WJ_LAYER) {
    int idx = (job - 2 * WJ_LAYER) * NTHR + opaque_tid();
    int head = idx / 2560, e = idx % 2560, d = e - 1280, n = d < 0 ? -d : d;
    int mult = (n <= 64 ? 1 : 0) + (((n & 3) == 0 && n <= 256) ? 1 : 0) + (((n & 15) == 0 && n <= 1024) ? 1 : 0);
    float v = NEGBIG;
    if (mult > 0) {
      int bk;
      if (n < 8) bk = n;
      else { float nf = (float)n; int lg = 8 + (int)(__logf(nf * 0.125f) / 4.852030263919617f * 8.0f); bk = lg < 15 ? lg : 15; }
      if (d > 0) bk += 16;
      v = (p.t5_bias[bk * 4 + head] + __logf((float)mult)) * LOG2E;
    }
    ((float*)(p.ws + OFF_TBLA))[idx] = v;
    return;
  }
  int layer = job / WJ_LAYER, j = job % WJ_LAYER;
  u16* wl = wtb + (size_t)layer * WT_LAYER;
  if (j < WJ_IN) { int kt = j & 15, nt = j >> 4; wt_tile(p.w_in + (size_t)layer * 1024 * DIN, 1024, DIN, p.norm_mix + layer * 1024, wl + WT_IN, kt * 64, nt * 64, 1, tile); return; }
  j -= WJ_IN;
  if (j < WJ_UQ) { int kt = j & 3, nt = j >> 2; wt_tile(p.d_w_uq + (size_t)layer * 256 * 384, 256, 384, p.d_q_gain + layer * 256, wl + WT_UQ, kt * 64, nt * 64, 2, tile); return; }
  j -= WJ_UQ;
  if (j < WJ_UKV) { int kt = j & 1, nt = j >> 1; wt_tile(p.d_w_ukv + (size_t)layer * 128 * 512, 128, 512, p.d_kv_gain + layer * 128, wl + WT_UKV, kt * 64, nt * 64, 0, tile); return; }
  j -= WJ_UKV;
  if (j < WJ_OUT) { int kt = j & 15, nt = j >> 4; wt_tile(p.w_out + (size_t)layer * 1024 * 1024, 1024, 1024, p.out_gain + layer * 1024, wl + WT_OUT, kt * 64, nt * 64, 0, tile); return; }
  j -= WJ_OUT;
  if (j < WJ_G) { int kt = j & 15, nt = j >> 4; wt_tile(p.w_gate + (size_t)layer * 1024 * DFF, 1024, DFF, p.norm_ffn + layer * 1024, wl + WT_GU, kt * 64, nt * 64, 3, tile); return; }
  j -= WJ_G;
  if (j < WJ_U) { int kt = j & 15, nt = j >> 4; wt_tile(p.w_up + (size_t)layer * 1024 * DFF, 1024, DFF, p.norm_ffn + layer * 1024, wl + WT_GU, kt * 64, nt * 64, 4, tile); return; }
  j -= WJ_U;
  { int kt = j % 44, nt = j / 44; wt_tile(p.w_down + (size_t)layer * DFF * 1024, DFF, 1024, nullptr, wl + WT_DN, kt * 64, nt * 64, 0, tile); }
}

constexpr int NRW = 4;
DI void norm_rows(const Params& p, int layer, int rb, int mode) {
  const int tid = opaque_tid();
  const int lane = tid & 63, wave = tid >> 6;
  const size_t rowb = (size_t)rb * (8 * NRW) + wave;
  f32x4 v[NRW][4];
#pragma unroll
  for (int rr = 0; rr < NRW; ++rr) {
    const float* src = xrow(p, layer, rowb + 8 * rr);
#pragma unroll
    for (int i = 0; i < 4; ++i) v[rr][i] = __builtin_nontemporal_load((const f32x4*)(src + lane * 4 + 256 * i));
  }
#pragma unroll
  for (int rr = 0; rr < NRW; ++rr) {
    float ss = 0.f;
#pragma unroll
    for (int i = 0; i < 4; ++i) ss += v[rr][i][0] * v[rr][i][0] + v[rr][i][1] * v[rr][i][1] + v[rr][i][2] * v[rr][i][2] + v[rr][i][3] * v[rr][i][3];
#pragma unroll
    for (int o = 1; o < 64; o <<= 1) ss += __shfl_xor(ss, o);
    const float rstd = rsqrtf(ss * (1.f / 1024.f) + EPS);
    const size_t row = rowb + 8 * rr;
    if (mode == 0) {
      u16* dst = (u16*)(p.ws + OFF_ACTB) + row * DM;
#pragma unroll
      for (int i = 0; i < 4; ++i) { u32x2 w = {pack2(v[rr][i][0] * rstd, v[rr][i][1] * rstd), pack2(v[rr][i][2] * rstd, v[rr][i][3] * rstd)}; *(u32x2*)(dst + lane * 4 + 256 * i) = w; }
    } else {
      float* dst = p.out + row * DM;
#pragma unroll
      for (int i = 0; i < 4; ++i) { f32x4 g = *(const f32x4*)(p.final_norm + lane * 4 + 256 * i); f32x4 o = {v[rr][i][0] * rstd * g[0], v[rr][i][1] * rstd * g[1], v[rr][i][2] * rstd * g[2], v[rr][i][3] * rstd * g[3]}; __builtin_nontemporal_store(o, (f32x4*)(dst + lane * 4 + 256 * i)); }
    }
  }
}

enum { EPI_PROJ = 0, EPI_UQ = 1, EPI_UKV = 2, EPI_RES = 3, EPI_SWIGLU = 4 };
constexpr int GS = 72;
constexpr int BM = 256;
constexpr int TMW = 4;

template <int EPI, bool ASCALE, bool ROWNORM>
DI void gemm_tile(const Params& p, int layer, const u16* __restrict__ A, int lda, const u16* __restrict__ Wt, int K, int m0, int n0, char* smem) {
  u16* As = (u16*)smem;
  u16* Bs = As + 2 * BM * GS;
  float* rowscale = (float*)(Bs + 2 * 256 * GS);
  const int tid = opaque_tid(), lane = tid & 63, wave = tid >> 6, r = lane & 31, h = lane >> 5;
  const int wm = wave >> 2, wn = wave & 3;
  const int lrow = tid >> 3, kc = tid & 7;
  const u16* At = A + (size_t)m0 * lda;
  const u16* Bt = Wt + (size_t)n0 * K;
  const unsigned aoff = (unsigned)lrow * lda + kc * 8, boff = (unsigned)lrow * K + kc * 8;
  const float* ssq = (const float*)(p.ws + OFF_SSQ);

  if (ROWNORM) {
    const int rr = tid >> 1, half = tid & 1;
    const u16* src = A + (size_t)(m0 + rr) * lda + half * (K / 2);
    float ss = 0.f;
    for (int i = 0; i < K / 16; ++i) {
      u32x4 w = *(const u32x4*)(src + i * 8);
#pragma unroll
      for (int e = 0; e < 4; ++e) { float a = bflo(w[e]), b = bfhi(w[e]); ss += a * a + b * b; }
    }
    ss += __shfl_xor(ss, 1);
    if (half == 0) rowscale[rr] = rsqrtf(ss / (float)K + EPS);
  }

  f32x16 acc[TMW][2];
#pragma unroll
  for (int a = 0; a < TMW; ++a)
#pragma unroll
    for (int b = 0; b < 2; ++b)
#pragma unroll
      for (int i = 0; i < 16; ++i) acc[a][b][i] = 0.f;

  u32x4 ra[4], rb[4];
  float sc[4] = {1.f, 1.f, 1.f, 1.f};
  const int KT = K / 64;
  auto gload = [&](int kt) {
#pragma unroll
    for (int pp = 0; pp < 4; ++pp) ra[pp] = *(const u32x4*)(At + (size_t)(64 * pp) * lda + (aoff + (unsigned)kt * 64));
#pragma unroll
    for (int pp = 0; pp < 4; ++pp) rb[pp] = *(const u32x4*)(Bt + (size_t)(64 * pp) * K + (boff + (unsigned)kt * 64));
  };
  auto lstore = [&](int buf, int kt) {
    if (ASCALE) {
      if ((kt & 3) == 0) {
        const int g = kt >> 2;
#pragma unroll
        for (int pp = 0; pp < 4; ++pp) {
          f32x4 s4 = *(const f32x4*)(ssq + (size_t)(m0 + lrow + 64 * pp) * 16 + 4 * g);
          sc[pp] = rsqrtf((s4[0] + s4[1] + s4[2] + s4[3]) * (1.f / 256.f) + EPS);
        }
      }
#pragma unroll
      for (int pp = 0; pp < 4; ++pp)
#pragma unroll
        for (int e = 0; e < 4; ++e) ra[pp][e] = pack2(bflo(ra[pp][e]) * sc[pp], bfhi(ra[pp][e]) * sc[pp]);
    }
#pragma unroll
    for (int pp = 0; pp < 4; ++pp) *(u32x4*)(As + (buf * BM + lrow + 64 * pp) * GS + kc * 8) = ra[pp];
#pragma unroll
    for (int pp = 0; pp < 4; ++pp) *(u32x4*)(Bs + (buf * 256 + lrow + 64 * pp) * GS + kc * 8) = rb[pp];
  };
  auto compute = [&](int buf) {
    const u16* Ab = As + (buf * BM + wm * 128 + r) * GS + 8 * h;
    const u16* Bb = Bs + (buf * 256 + wn * 64 + r) * GS + 8 * h;
#pragma unroll
    for (int ks = 0; ks < 4; ++ks) {
      bf16x8 b0 = *(const bf16x8*)(Bb + ks * 16);
      bf16x8 b1 = *(const bf16x8*)(Bb + 32 * GS + ks * 16);
#pragma unroll
      for (int tm = 0; tm < TMW; ++tm) {
        bf16x8 a = *(const bf16x8*)(Ab + tm * 32 * GS + ks * 16);
        acc[tm][0] = mfma(a, b0, acc[tm][0]);
        acc[tm][1] = mfma(a, b1, acc[tm][1]);
      }
    }
  };
  gload(0);
  lstore(0, 0);
  if (KT > 1) gload(1);
  __syncthreads();
  for (int kt = 0; kt < KT; ++kt) {
    compute(kt & 1);
    if (kt + 1 < KT) lstore((kt + 1) & 1, kt + 1);
    if (kt + 2 < KT) gload(kt + 2);
    __syncthreads();
  }

  const int wms = __builtin_amdgcn_readfirstlane(wm), wns = __builtin_amdgcn_readfirstlane(wn);
  const int mrow0 = m0 + wms * 128;
  const int nwb = n0 + wns * 64;
  if (ROWNORM) {
#pragma unroll
    for (int tm = 0; tm < TMW; ++tm) {
#pragma unroll
      for (int i = 0; i < 16; ++i) {
        const float rs = rowscale[wms * 128 + 4 * h + 32 * tm + (i & 3) + 8 * (i >> 2)];
        acc[tm][0][i] *= rs; acc[tm][1][i] *= rs;
      }
    }
  }
  if (EPI == EPI_SWIGLU) {
    u16* dw = (u16*)(p.ws + OFF_ACT) + (size_t)mrow0 * DFF + (nwb >> 1);
    const unsigned lo = (unsigned)(4 * h) * DFF + r;
#pragma unroll
    for (int tm = 0; tm < TMW; ++tm) {
#pragma unroll
      for (int i = 0; i < 16; ++i) {
        const float g = acc[tm][0][i], u = acc[tm][1][i];
        const float a = g * __builtin_amdgcn_rcpf(1.f + fexp2(-g * LOG2E)) * u;
        dw[lo + (unsigned)((32 * tm + (i & 3) + 8 * (i >> 2)) * DFF)] = (u16)(pack2(a, 0.f) & 0xffff);
      }
      __builtin_amdgcn_sched_barrier(0);
    }
  } else {
#pragma unroll
    for (int tn = 0; tn < 2; ++tn) {
      const int nb0 = nwb + 32 * tn;
      if (EPI == EPI_RES) {
        const float* xw = (layer == 0 ? (m0 < NPROMPT ? p.x_prompt + (size_t)mrow0 * DM : p.x_sample + (size_t)(mrow0 - NPROMPT) * DM) : p.out + (size_t)mrow0 * DM) + nb0;
        float* ow = p.out + (size_t)mrow0 * DM + nb0;
        const unsigned lo = (unsigned)(4 * h) * DM + r;
#pragma unroll
        for (int tm = 0; tm < TMW; ++tm) {
#pragma unroll
          for (int g4 = 0; g4 < 4; ++g4) {
            float xv[4];
#pragma unroll
            for (int e = 0; e < 4; ++e) xv[e] = xw[lo + (unsigned)((32 * tm + 8 * g4 + e) * DM)];
#pragma unroll
            for (int e = 0; e < 4; ++e) ow[lo + (unsigned)((32 * tm + 8 * g4 + e) * DM)] = xv[e] + acc[tm][tn][4 * g4 + e];
          }
          __builtin_amdgcn_sched_barrier(0);
        }
      } else {
        u16* dw; int ld; bool ok = true;
        if (EPI == EPI_PROJ) { dw = (u16*)(p.ws + OFF_PROJ) + (size_t)mrow0 * DIN + nb0; ld = DIN; ok = (nb0 + r) < DIN; }
        else if (EPI == EPI_UQ) { dw = (u16*)(p.ws + OFF_QD) + (size_t)mrow0 * 384 + nb0; ld = 384; ok = nb0 < 384; }
        else {
          const int head = nb0 >> 7, w = nb0 & 127;
          if (w < 64) { dw = (u16*)(p.ws + OFF_KD) + (size_t)mrow0 * 384 + head * 96 + w; ld = 384; }
          else { dw = (u16*)(p.ws + OFF_VD) + (size_t)mrow0 * 256 + head * 64 + (w - 64); ld = 256; }
        }
        const unsigned lo = (unsigned)(4 * h) * ld + r;
        if (ok) {
#pragma unroll
          for (int tm = 0; tm < TMW; ++tm) {
#pragma unroll
            for (int i = 0; i < 16; ++i) dw[lo + (unsigned)((32 * tm + (i & 3) + 8 * (i >> 2)) * ld)] = (u16)(pack2(acc[tm][tn][i], 0.f) & 0xffff);
            __builtin_amdgcn_sched_barrier(0);
          }
        }
      }
    }
  }
  if (ROWNORM) __syncthreads();
}


typedef float f32x4v __attribute__((ext_vector_type(4)));
constexpr int G8_HT = 128 * 64;
DI int lds_byte8(int r, int c) { const int st = (r >> 4) * 2 + (c >> 5), ob = (r & 15) * 64 + (c & 31) * 2; return st * 1024 + (ob ^ (((ob >> 9) & 1) << 5)); }
DI void stage_rc8(int b, int& R, int& C) { const int st = b >> 10, sb = b & 1023, swz = sb ^ (((sb >> 9) & 1) << 5); R = (st >> 1) * 16 + (swz >> 6); C = (st & 1) * 32 + ((swz & 63) >> 1); }

DI void gemm8_prestage(const u16* __restrict__ A, const u16* __restrict__ Bt, int K, int brow, int bcol, char* smem) {
  u16* shm = (u16*)smem;
  const int tid = opaque_tid();
  int sr0, sc0, sr1, sc1;
  stage_rc8(tid * 16, sr0, sc0);
  stage_rc8(tid * 16 + 8192, sr1, sc1);
  const unsigned go0 = (unsigned)sr0 * K + sc0, go1 = (unsigned)sr1 * K + sc1;
#define G8P_STAGE(P, BASE, br) do { const u16* g_ = (BASE) + (size_t)(br) * K; \
    __builtin_amdgcn_global_load_lds((const unsigned*)(g_ + go0), (__attribute__((address_space(3))) unsigned*)((char*)(P) + tid * 16), 16, 0, 0); \
    __builtin_amdgcn_global_load_lds((const unsigned*)(g_ + go1), (__attribute__((address_space(3))) unsigned*)((char*)(P) + tid * 16 + 8192), 16, 0, 0); } while (0)
  G8P_STAGE(shm + 4 * G8_HT, Bt, bcol); G8P_STAGE(shm, A, brow);
  G8P_STAGE(shm + 5 * G8_HT, Bt, bcol + 128); G8P_STAGE(shm + G8_HT, A, brow + 128);
#undef G8P_STAGE
}

template <int EPI, bool GSCALE = false>
DI void gemm8_tile(const Params& p, int layer, const u16* __restrict__ A, const u16* __restrict__ Bt, int K, int brow, int bcol, char* smem,
                   bool next_valid, int next_brow, int next_bcol) {
  u16* shm = (u16*)smem;
  const int tid = opaque_tid();
  float* gfac = (float*)(smem + 8 * G8_HT * 2);
  if (GSCALE) {
    if (tid < 256) {
      const float* sq = (const float*)(p.ws + OFF_SSQ) + (size_t)(brow + tid) * 16;
      float rs[4];
#pragma unroll
      for (int g = 0; g < 4; ++g) { const f32x4 s4 = *(const f32x4*)(sq + 4 * g); rs[g] = rsqrtf((s4[0] + s4[1] + s4[2] + s4[3]) * (1.f / 256.f) + EPS); }
      gfac[tid] = rs[0] / rs[1]; gfac[256 + tid] = rs[1] / rs[2]; gfac[512 + tid] = rs[2] / rs[3]; gfac[768 + tid] = rs[3];
    }
  }
  const int wid = tid >> 6, lane = tid & 63, wr = wid >> 2, wc = wid & 3, fr = lane & 15, fq = lane >> 4;
  int sr0, sc0, sr1, sc1;
  stage_rc8(tid * 16, sr0, sc0);
  stage_rc8(tid * 16 + 8192, sr1, sc1);
  const unsigned go0 = (unsigned)sr0 * K + sc0, go1 = (unsigned)sr1 * K + sc1;
#define G8_SA(b, hh) (shm + ((b) * 2 + (hh)) * G8_HT)
#define G8_SB(b, hh) (shm + (4 + (b) * 2 + (hh)) * G8_HT)
#define G8_STAGE(P, BASE, br, kt) do { const u16* g_ = (BASE) + (size_t)(br) * K + (size_t)(kt) * 64; \
    __builtin_amdgcn_global_load_lds((const unsigned*)(g_ + go0), (__attribute__((address_space(3))) unsigned*)((char*)(P) + tid * 16), 16, 0, 0); \
    __builtin_amdgcn_global_load_lds((const unsigned*)(g_ + go1), (__attribute__((address_space(3))) unsigned*)((char*)(P) + tid * 16 + 8192), 16, 0, 0); } while (0)
#define G8_LDA(dst, b, hh) _Pragma("unroll") for (int m = 0; m < 4; ++m) _Pragma("unroll") for (int k = 0; k < 2; ++k) \
    dst[m][k] = *reinterpret_cast<const bf16x8*>((char*)G8_SA(b, hh) + lds_byte8(wr * 64 + m * 16 + fr, k * 32 + fq * 8))
#define G8_LDB(dst, b, hh) _Pragma("unroll") for (int n = 0; n < 2; ++n) _Pragma("unroll") for (int k = 0; k < 2; ++k) \
    dst[n][k] = *reinterpret_cast<const bf16x8*>((char*)G8_SB(b, hh) + lds_byte8(wc * 32 + n * 16 + fr, k * 32 + fq * 8))
#define G8_MMA(ai, bj, At_, Bt_) do { __builtin_amdgcn_s_setprio(1); \
    _Pragma("unroll") for (int m = 0; m < 4; ++m) _Pragma("unroll") for (int n = 0; n < 2; ++n) _Pragma("unroll") for (int k = 0; k < 2; ++k) \
      acc[ai][bj][m][n] = __builtin_amdgcn_mfma_f32_16x16x32_bf16(At_[m][k], Bt_[n][k], acc[ai][bj][m][n], 0, 0, 0); \
    __builtin_amdgcn_s_setprio(0); } while (0)
#define G8_WAIT_V(n) asm volatile("s_waitcnt vmcnt(" #n ")" ::: "memory")
#define G8_WAIT_L(n) asm volatile("s_waitcnt lgkmcnt(" #n ")" ::: "memory")
#define G8_BAR __builtin_amdgcn_s_barrier()
#define G8_SCHED __builtin_amdgcn_sched_barrier(0)
  f32x4v acc[2][2][4][2];
#pragma unroll
  for (int a = 0; a < 2; ++a)
#pragma unroll
    for (int b = 0; b < 2; ++b)
#pragma unroll
      for (int m = 0; m < 4; ++m)
#pragma unroll
        for (int n = 0; n < 2; ++n) acc[a][b][m][n] = (f32x4v){0.f, 0.f, 0.f, 0.f};
  bf16x8 At[4][2], B0[2][2], B1[2][2];
  const int nt = K / 64;
  if (wr == 1) G8_BAR;
  G8_WAIT_V(4); G8_BAR;
  G8_STAGE(G8_SB(1, 0), Bt, bcol, 1); G8_STAGE(G8_SA(1, 0), A, brow, 1); G8_STAGE(G8_SB(1, 1), Bt, bcol + 128, 1);
  G8_WAIT_V(6); G8_BAR;
  for (int t = 0; t < nt - 2; t += 2) {
    G8_LDB(B0, 0, 0); G8_SCHED; G8_LDA(At, 0, 0); G8_STAGE(G8_SA(1, 1), A, brow + 128, t + 1);
    G8_WAIT_L(8); G8_BAR; G8_WAIT_L(0); G8_MMA(0, 0, At, B0); G8_BAR; G8_SCHED;
    G8_LDB(B1, 0, 1); G8_STAGE(G8_SB(0, 0), Bt, bcol, t + 2);
    G8_BAR; G8_WAIT_L(0); G8_MMA(0, 1, At, B1); G8_BAR;
    G8_LDA(At, 0, 1); G8_STAGE(G8_SA(0, 0), A, brow, t + 2);
    G8_BAR; G8_WAIT_L(0); G8_MMA(1, 0, At, B0); G8_BAR; G8_SCHED;
    G8_STAGE(G8_SB(0, 1), Bt, bcol + 128, t + 2);
    G8_WAIT_V(6); G8_BAR; G8_MMA(1, 1, At, B1); G8_BAR;
    G8_LDB(B0, 1, 0); G8_SCHED; G8_LDA(At, 1, 0); G8_STAGE(G8_SA(0, 1), A, brow + 128, t + 2);
    G8_WAIT_L(8); G8_BAR; G8_WAIT_L(0); G8_MMA(0, 0, At, B0); G8_BAR; G8_SCHED;
    G8_LDB(B1, 1, 1); G8_STAGE(G8_SB(1, 0), Bt, bcol, t + 3);
    G8_BAR; G8_WAIT_L(0); G8_MMA(0, 1, At, B1); G8_BAR;
    G8_LDA(At, 1, 1); G8_STAGE(G8_SA(1, 0), A, brow, t + 3);
    G8_BAR; G8_WAIT_L(0); G8_MMA(1, 0, At, B0); G8_BAR; G8_SCHED;
    G8_STAGE(G8_SB(1, 1), Bt, bcol + 128, t + 3);
    G8_WAIT_V(6); G8_BAR; G8_MMA(1, 1, At, B1); G8_BAR;
    if (GSCALE && (t & 3) == 2) {
      const float* gf = gfac + (t >> 2) * 256 + wr * 64 + fq * 4;
#pragma unroll
      for (int ai = 0; ai < 2; ++ai)
#pragma unroll
        for (int m = 0; m < 4; ++m) {
          const f32x4 f4 = *(const f32x4*)(gf + ai * 128 + m * 16);
#pragma unroll
          for (int bj = 0; bj < 2; ++bj)
#pragma unroll
            for (int n = 0; n < 2; ++n)
#pragma unroll
              for (int j = 0; j < 4; ++j) acc[ai][bj][m][n][j] *= f4[j];
        }
    }
  }
  { G8_LDB(B0, 0, 0); G8_LDA(At, 0, 0); G8_STAGE(G8_SA(1, 1), A, brow + 128, nt - 1);
    G8_BAR; G8_WAIT_L(0); G8_MMA(0, 0, At, B0); G8_BAR;
    G8_LDB(B1, 0, 1); G8_BAR; G8_WAIT_L(0); G8_MMA(0, 1, At, B1); G8_BAR;
    G8_LDA(At, 0, 1); G8_WAIT_V(4); G8_BAR; G8_WAIT_L(0); G8_MMA(1, 0, At, B0); G8_MMA(1, 1, At, B1); G8_BAR; }
  { G8_LDB(B0, 1, 0); G8_LDA(At, 1, 0); G8_WAIT_V(2); G8_BAR; G8_WAIT_L(0); G8_MMA(0, 0, At, B0); G8_BAR;
    G8_LDB(B1, 1, 1); G8_WAIT_V(0); G8_BAR; G8_WAIT_L(0); G8_MMA(0, 1, At, B1); G8_BAR;
    G8_LDA(At, 1, 1); G8_BAR; G8_WAIT_L(0); G8_MMA(1, 0, At, B0); G8_MMA(1, 1, At, B1); G8_BAR; }
  if (wr == 0) G8_BAR;
  if (GSCALE) {
    const float* gf = gfac + 768 + wr * 64 + fq * 4;
#pragma unroll
    for (int ai = 0; ai < 2; ++ai)
#pragma unroll
      for (int m = 0; m < 4; ++m) {
        const f32x4 f4 = *(const f32x4*)(gf + ai * 128 + m * 16);
#pragma unroll
        for (int bj = 0; bj < 2; ++bj)
#pragma unroll
          for (int n = 0; n < 2; ++n)
#pragma unroll
            for (int j = 0; j < 4; ++j) acc[ai][bj][m][n][j] *= f4[j];
      }
  }
  if (next_valid) gemm8_prestage(A, Bt, K, next_brow, next_bcol, smem);
  const int wrs = __builtin_amdgcn_readfirstlane(wr), wcs = __builtin_amdgcn_readfirstlane(wc);
  if (EPI == EPI_RES) {
#pragma unroll
    for (int ai = 0; ai < 2; ++ai) {
      const int mrow0 = brow + ai * 128 + wrs * 64;
      const float* xw = (layer == 0 ? (brow < NPROMPT ? p.x_prompt + (size_t)mrow0 * DM : p.x_sample + (size_t)(mrow0 - NPROMPT) * DM) : p.out + (size_t)mrow0 * DM) + bcol + wcs * 32;
      float* ow = p.out + (size_t)mrow0 * DM + bcol + wcs * 32;
      const unsigned lo = (unsigned)(fq * 4) * DM + fr;
      float xv[4][4][4];
#pragma unroll
      for (int m = 0; m < 4; ++m)
#pragma unroll
        for (int j = 0; j < 4; ++j) {
          const float* xr = xw + (lo + (unsigned)((m * 16 + j) * DM));
#pragma unroll
          for (int c = 0; c < 4; ++c) xv[m][j][c] = xr[(c >> 1) * 128 + (c & 1) * 16];
        }
      __builtin_amdgcn_sched_barrier(0);
#pragma unroll
      for (int m = 0; m < 4; ++m)
#pragma unroll
        for (int j = 0; j < 4; ++j) {
          float* orow = ow + (lo + (unsigned)((m * 16 + j) * DM));
#pragma unroll
          for (int c = 0; c < 4; ++c) orow[(c >> 1) * 128 + (c & 1) * 16] = xv[m][j][c] + acc[ai][c >> 1][m][c & 1][j];
        }
      __builtin_amdgcn_sched_barrier(0);
    }
  }
#pragma unroll
  for (int ai = 0; ai < 2 && EPI != EPI_RES; ++ai) {
    const int mrow0 = brow + ai * 128 + wrs * 64;
#pragma unroll
    for (int bj = 0; bj < 2; ++bj) {
      const int ncol0 = bcol + bj * 128 + wcs * 32;
      if (EPI == EPI_SWIGLU) {
        u16* dw = (u16*)(p.ws + OFF_ACT) + (size_t)mrow0 * DFF + (ncol0 >> 1);
        const unsigned lo = (unsigned)(fq * 4) * DFF + fr;
#pragma unroll
        for (int m = 0; m < 4; ++m) {
#pragma unroll
          for (int j = 0; j < 4; ++j) {
            const float g = acc[ai][bj][m][0][j], u = acc[ai][bj][m][1][j];
            const float a = g * __builtin_amdgcn_rcpf(1.f + fexp2(-g * LOG2E)) * u;
            dw[lo + (unsigned)((m * 16 + j) * DFF)] = (u16)(pack2(a, 0.f) & 0xffff);
          }
        }
        __builtin_amdgcn_sched_barrier(0);
      } else if (EPI == EPI_RES) {
      } else {
#pragma unroll
        for (int n = 0; n < 2; ++n) {
          const int nb0 = ncol0 + n * 16;
          if (nb0 < DIN) {
            u16* dw = (u16*)(p.ws + OFF_PROJ) + (size_t)mrow0 * DIN + nb0;
            const unsigned lo = (unsigned)(fq * 4) * DIN + fr;
#pragma unroll
            for (int m = 0; m < 4; ++m)
#pragma unroll
              for (int j = 0; j < 4; ++j) dw[lo + (unsigned)((m * 16 + j) * DIN)] = (u16)(pack2(acc[ai][bj][m][n][j], 0.f) & 0xffff);
          }
          __builtin_amdgcn_sched_barrier(0);
        }
      }
    }
  }
  G8_WAIT_V(0);
  __syncthreads();
}

DI void e1_chunk(const Params& p, int layer, int chunk) {
  const int j = chunk & 7;
  const size_t tok = (size_t)(chunk >> 3) * NTHR + opaque_tid();
  if (j == 7) return;
  u16* proj = (u16*)(p.ws + OFF_PROJ);
  const int t = (int)(tok & 4095);
  if (j < 6) {
    u16* ptr = proj + tok * DIN + (j < 4 ? 768 + 64 * j : 1024 + 64 * (j - 4));
    const float* gain = (j < 4 ? p.b_q_gain : p.b_k_gain) + layer * 64;
    const float post = j < 4 ? QSCALE64 : 1.f;
    float x[64];
    float ss = 0.f;
#pragma unroll
    for (int c = 0; c < 8; ++c) {
      u32x4 w = *(const u32x4*)(ptr + c * 8);
#pragma unroll
      for (int e = 0; e < 4; ++e) { x[c * 8 + 2 * e] = bflo(w[e]); x[c * 8 + 2 * e + 1] = bfhi(w[e]); }
    }
#pragma unroll
    for (int d = 0; d < 64; ++d) ss += x[d] * x[d];
    const float rstd = rsqrtf(ss * (1.f / 64.f) + EPS);
    __builtin_amdgcn_sched_barrier(0);
#pragma unroll
    for (int c = 0; c < 4; ++c) {
#pragma unroll
      for (int d = 0; d < 16; ++d) x[c * 16 + d] = x[c * 16 + d] * rstd * gain[c * 16 + d];
      __builtin_amdgcn_sched_barrier(0);
    }
    const int prow = t >> 6, pcol = t & 63;
    { float* xa = x; float* xb = x + 16; ROPE16(p.ws, prow, xa, xb); }
    __builtin_amdgcn_sched_barrier(0);
    { float* xa = x + 32; float* xb = x + 48; ROPE16(p.ws, pcol, xa, xb); }
    __builtin_amdgcn_sched_barrier(0);
#pragma unroll
    for (int c = 0; c < 8; ++c) {
      u32x4 w;
#pragma unroll
      for (int e = 0; e < 4; ++e) w[e] = pack2(x[c * 8 + 2 * e] * post, x[c * 8 + 2 * e + 1] * post);
      *(u32x4*)(ptr + c * 8) = w;
    }
  } else {
    const u16* src = proj + tok * DIN + 2432;
    float x[32];
#pragma unroll
    for (int c = 0; c < 4; ++c) {
      u32x4 w = *(const u32x4*)(src + c * 8);
#pragma unroll
      for (int e = 0; e < 4; ++e) { x[c * 8 + 2 * e] = bflo(w[e]); x[c * 8 + 2 * e + 1] = bfhi(w[e]); }
    }
    { float* xa = x; float* xb = x + 16; ROPE16(p.ws, t, xa, xb); }
    u16* kd = (u16*)(p.ws + OFF_KD) + tok * 384 + 64;
#pragma unroll
    for (int c = 0; c < 4; ++c) {
      u32x4 w;
#pragma unroll
      for (int e = 0; e < 4; ++e) w[e] = pack2(x[c * 8 + 2 * e], x[c * 8 + 2 * e + 1]);
#pragma unroll
      for (int hh = 0; hh < 4; ++hh) *(u32x4*)(kd + hh * 96 + c * 8) = w;
    }
  }
}

template <int MODE>
DI void attn_tile(const Params& p, int layer, int tile, char* smem) {
  constexpr int DQK = (MODE == 3) ? 96 : 64;
  constexpr int NKQ = DQK / 16;
  constexpr int KROW = DQK + 8;
  constexpr int VROW = 72;
  constexpr int KCH = DQK / 8;
  constexpr int KLD = (64 * KCH + NTHR - 1) / NTHR;
  u16* Ks = (u16*)smem;
  u16* Vs = (u16*)(smem + 26624);
  float* tbl = (float*)(smem + 26624 + 18432);

  const int tid = opaque_tid(), lane = tid & 63, wave = tid >> 6, r = lane & 31, h = lane >> 5;
  const int qb = tile & 15, head = (tile >> 4) & 3, seq = tile >> 6;
  const size_t tok0 = (size_t)seq * SEQ;
  const u16* proj = (const u16*)(p.ws + OFF_PROJ);
  const u16 *Qp, *Kp, *Vp;
  int ldq, ldk, ldv;
  if (MODE == 0) { Qp = proj + 64 * head; Kp = proj + 256 + 64 * head; Vp = proj + 512 + 64 * head; ldq = ldk = ldv = DIN; }
  else if (MODE == 1) { Qp = proj + 768 + 64 * head; Kp = proj + 1024 + 64 * (head >> 1); Vp = proj + 1152 + 64 * (head >> 1); ldq = ldk = ldv = DIN; }
  else if (MODE == 2) { Qp = proj + 1280 + 64 * head; Kp = proj + 1536 + 64 * head; Vp = proj + 1792 + 64 * head; ldq = ldk = ldv = DIN; }
  else { Qp = (const u16*)(p.ws + OFF_QD) + 96 * head; Kp = (const u16*)(p.ws + OFF_KD) + 96 * head; Vp = (const u16*)(p.ws + OFF_VD) + 64 * head; ldq = ldk = 384; ldv = 256; }

  int kt0 = 0, kt1 = 64;
  if (MODE == 0) { kt0 = 4 * qb - 16; if (kt0 < 0) kt0 = 0; kt1 = 4 * qb + 20; if (kt1 > 64) kt1 = 64; }
  if (MODE == 2) { int r0 = 4 * qb - 4; r0 = r0 < 0 ? 0 : (r0 > 56 ? 56 : r0); int r1 = 4 * qb + 3 - 4; r1 = r1 < 0 ? 0 : (r1 > 56 ? 56 : r1); kt0 = r0; kt1 = r1 + 8; }

  if (MODE == 0) { const float* src = (const float*)(p.ws + OFF_TBLA) + head * 2560; for (int i = tid; i < 2560; i += NTHR) tbl[i] = src[i]; }
  if (MODE == 2) { const float* src = p.c_rpb + (size_t)(layer * 4 + head) * 465; for (int i = tid; i < 465; i += NTHR) tbl[i] = src[i] * LOG2E; }

  const int qpos = qb * 256 + wave * 32 + r;
  bf16x8 qf[NKQ];
  {
    const u16* qrow = Qp + (tok0 + qpos) * ldq + 8 * h;
#pragma unroll
    for (int d0 = 0; d0 < NKQ; ++d0) qf[d0] = *(const bf16x8*)(qrow + d0 * 16);
  }
  if (MODE == 3) {
    bf16x8 x1 = qf[NKQ - 2], x2 = qf[NKQ - 1];
    const f32x4* rt = (const f32x4*)(p.ws + OFF_ROPE) + (size_t)qpos * 8 + 4 * h;
#pragma unroll
    for (int j2 = 0; j2 < 4; ++j2) {
      const f32x4 cs4 = rt[j2];
#pragma unroll
      for (int e = 0; e < 2; ++e) {
        const int j = 2 * j2 + e;
        const float c = cs4[2 * e], sn = cs4[2 * e + 1];
        float a = __uint_as_float(((unsigned)(u16)x1[j]) << 16), b = __uint_as_float(((unsigned)(u16)x2[j]) << 16);
        unsigned w = pack2(a * c - b * sn, a * sn + b * c);
        x1[j] = (short)(w & 0xffff); x2[j] = (short)(w >> 16);
      }
    }
    qf[NKQ - 2] = x1; qf[NKQ - 1] = x2;
  }

  u32x4 rk0[KLD], rv0, rk1[KLD], rv1;
  const u16* Kt = Kp + tok0 * ldk;
  const u16* Vt = Vp + tok0 * ldv;
  unsigned koff[KLD];
#pragma unroll
  for (int pp = 0; pp < KLD; ++pp) { int c = tid + NTHR * pp; if (c >= 64 * KCH) c = tid; const int row = c / KCH, col = c % KCH; koff[pp] = (unsigned)row * ldk + col * 8; }
  const unsigned voff = (unsigned)(tid >> 3) * ldv + (tid & 7) * 8;
  const int ktl = kt1 - 1;
  auto gload = [&](u32x4 (&rk)[KLD], u32x4& rv, int kt) {
    kt = kt < ktl ? kt : ktl;
#pragma unroll
    for (int pp = 0; pp < KLD; ++pp) rk[pp] = *(const u32x4*)(Kt + (koff[pp] + (unsigned)(kt * 64) * ldk));
    rv = *(const u32x4*)(Vt + (voff + (unsigned)(kt * 64) * ldv));
  };
  auto lstore = [&](u32x4 (&rk)[KLD], u32x4& rv, int buf) {
#pragma unroll
    for (int pp = 0; pp < KLD; ++pp) { const int c = tid + NTHR * pp; if (c < 64 * KCH) { const int row = c / KCH, col = c % KCH; *(u32x4*)(Ks + (buf * 64 + row) * KROW + col * 8) = rk[pp]; } }
    *(u32x4*)(Vs + (buf * 64 + (tid >> 3)) * VROW + (tid & 7) * 8) = rv;
  };

  f32x16 o0, o1, negm;
#pragma unroll
  for (int i = 0; i < 16; ++i) { o0[i] = 0.f; o1[i] = 0.f; negm[i] = 0.f; }
  float mref = 0.f, lsum = 0.f;
  bool started = false;
  int qr = 0, qc = 0, cs = 0, rs = 0;
  if (MODE == 2) { qr = qpos >> 6; qc = qpos & 63; cs = qc - 8; cs = cs < 0 ? 0 : (cs > 48 ? 48 : cs); rs = qr - 4; rs = rs < 0 ? 0 : (rs > 56 ? 56 : rs); }
  const int i16 = lane & 15, qq = i16 >> 2, pp4 = i16 & 3, g16 = (lane >> 4) & 1;

  auto compute = [&](int buf, int kt) {
    bool active = true;
    if (MODE == 2) active = (kt >= rs) && (kt < rs + 8);
    if (active) {
      const u16* Kb = Ks + buf * 64 * KROW + r * KROW + 8 * h;
      const u16* Vb = Vs + buf * 64 * VROW;
      bf16x8 vf[8];
#pragma unroll
      for (int cs2 = 0; cs2 < 4; ++cs2) {
        const u16* vp = Vb + (16 * cs2 + 4 * h + qq) * VROW + 16 * g16 + 4 * pp4;
        { s16x4 lo = tr_read(vp), hi = tr_read(vp + 8 * VROW); vf[2 * cs2] = __builtin_shufflevector(lo, hi, 0, 1, 2, 3, 4, 5, 6, 7); }
        { s16x4 lo = tr_read(vp + 32), hi = tr_read(vp + 8 * VROW + 32); vf[2 * cs2 + 1] = __builtin_shufflevector(lo, hi, 0, 1, 2, 3, 4, 5, 6, 7); }
      }
      f32x16 s0 = negm, s1 = negm;
#pragma unroll
      for (int d0 = 0; d0 < NKQ; ++d0) {
        bf16x8 k0 = *(const bf16x8*)(Kb + d0 * 16);
        bf16x8 k1 = *(const bf16x8*)(Kb + 32 * KROW + d0 * 16);
        s0 = mfma(k0, qf[d0], s0);
        s1 = mfma(k1, qf[d0], s1);
      }
      if (MODE == 0) {
        const float* tb = tbl + (kt * 64 + 4 * h - qpos + 1280);
#pragma unroll
        for (int i = 0; i < 16; ++i) { s0[i] += tb[(i & 3) + 8 * (i >> 2)]; s1[i] += tb[32 + (i & 3) + 8 * (i >> 2)]; }
      }
      if (MODE == 2) {
        const float* tb = tbl + (kt - qr + 7) * 31 + (15 - qc);
#pragma unroll
        for (int i = 0; i < 16; ++i) {
          const int kc0 = 4 * h + (i & 3) + 8 * (i >> 2), kc1 = kc0 + 32;
          const bool v0 = (kc0 >= cs) && (kc0 < cs + 16), v1 = (kc1 >= cs) && (kc1 < cs + 16);
          const float b0 = tb[v0 ? kc0 : qc], b1 = tb[v1 ? kc1 : qc];
          s0[i] = v0 ? s0[i] + b0 : NEGBIG;
          s1[i] = v1 ? s1[i] + b1 : NEGBIG;
        }
      }
      float ma = __builtin_fmaxf(__builtin_fmaxf(s0[0], s0[1]), s0[2]), mb = __builtin_fmaxf(__builtin_fmaxf(s1[0], s1[1]), s1[2]);
#pragma unroll
      for (int i = 3; i < 15; i += 2) { ma = __builtin_fmaxf(__builtin_fmaxf(ma, s0[i]), s0[i + 1]); mb = __builtin_fmaxf(__builtin_fmaxf(mb, s1[i]), s1[i + 1]); }
      float mt = __builtin_fmaxf(__builtin_fmaxf(ma, s0[15]), s1[15]);
      mt = hmax(__builtin_fmaxf(mt, mb));
      const bool fresh = !started && (mt > -1e29f);
      if (__any(fresh || (started && mt > 8.f))) {
        float delta = 0.f, al = 1.f;
        if (fresh) { delta = mt; started = true; }
        else if (started) { delta = __builtin_fmaxf(mt, 0.f); al = fexp2(-delta); }
        mref += delta;
        lsum *= al;
#pragma unroll
        for (int i = 0; i < 16; ++i) { o0[i] *= al; o1[i] *= al; s0[i] -= delta; s1[i] -= delta; negm[i] = -mref; }
      }
      float ps = 0.f;
#pragma unroll
      for (int i = 0; i < 16; ++i) { s0[i] = fexp2(s0[i]); s1[i] = fexp2(s1[i]); ps += s0[i] + s1[i]; }
      lsum += ps;
#pragma unroll
      for (int c = 0; c < 2; ++c) {
#pragma unroll
        for (int s = 0; s < 2; ++s) {
          u32x4 pw;
          if (c == 0) pw = (u32x4){pack2(s0[8 * s], s0[8 * s + 1]), pack2(s0[8 * s + 2], s0[8 * s + 3]), pack2(s0[8 * s + 4], s0[8 * s + 5]), pack2(s0[8 * s + 6], s0[8 * s + 7])};
          else pw = (u32x4){pack2(s1[8 * s], s1[8 * s + 1]), pack2(s1[8 * s + 2], s1[8 * s + 3]), pack2(s1[8 * s + 4], s1[8 * s + 5]), pack2(s1[8 * s + 6], s1[8 * s + 7])};
          const bf16x8 pf = __builtin_bit_cast(bf16x8, pw);
          o0 = mfma(vf[2 * (2 * c + s)], pf, o0);
          o1 = mfma(vf[2 * (2 * c + s) + 1], pf, o1);
        }
      }
    }
  };

  const int ntile = kt1 - kt0;
  gload(rk1, rv1, kt0);
  gload(rk0, rv0, kt0 + 1);
  lstore(rk1, rv1, 0);
  gload(rk1, rv1, kt0 + 2);
  __syncthreads();
  for (int j = 0; j < ntile; j += 2) {
    compute(0, kt0 + j);
    lstore(rk0, rv0, 1);
    gload(rk0, rv0, kt0 + j + 3);
    __syncthreads();
    if (j + 1 >= ntile) break;
    compute(1, kt0 + j + 1);
    lstore(rk1, rv1, 0);
    gload(rk1, rv1, kt0 + j + 4);
    __syncthreads();
  }
  lsum = hsum(lsum);
  const float inv = 1.f / lsum;
  float sq = 0.f;
#pragma unroll
  for (int i = 0; i < 16; ++i) { o0[i] *= inv; o1[i] *= inv; sq += o0[i] * o0[i] + o1[i] * o1[i]; }
  sq = hsum(sq);
  if (h == 0) ((float*)(p.ws + OFF_SSQ))[(tok0 + qpos) * 16 + MODE * 4 + head] = sq;
  u16* stg = (u16*)smem + wave * (32 * 72);
#pragma unroll
  for (int g4 = 0; g4 < 4; ++g4) {
    u32x2 w0 = {pack2(o0[4 * g4], o0[4 * g4 + 1]), pack2(o0[4 * g4 + 2], o0[4 * g4 + 3])};
    u32x2 w1 = {pack2(o1[4 * g4], o1[4 * g4 + 1]), pack2(o1[4 * g4 + 2], o1[4 * g4 + 3])};
    *(u32x2*)(stg + r * 72 + 8 * g4 + 4 * h) = w0;
    *(u32x2*)(stg + r * 72 + 32 + 8 * g4 + 4 * h) = w1;
  }
  asm volatile("s_waitcnt lgkmcnt(0)" ::: "memory");
  u16* Ow = (u16*)(p.ws + OFF_ACTB) + (tok0 + (size_t)(qb * 256 + wave * 32)) * DM + MODE * 256 + head * 64;
#pragma unroll
  for (int i = 0; i < 4; ++i) {
    const int row = i * 8 + (lane >> 3), ch = lane & 7;
    *(u32x4*)(Ow + (size_t)row * DM + ch * 8) = *(const u32x4*)(stg + row * 72 + ch * 8);
  }
  __syncthreads();
}


DI bool sb_tile(int bid, int nb, int it, int NT, int& mt, int& nt) {
  const int G = nb >> 3, x = bid & 7, l = bid >> 3;
  const int s = l + it * G;
  const int sb = (s >> 5) * 8 + x, w = s & 31;
  if (NT == 4) {
    if (sb >= 48) return false;
    mt = sb * 8 + (w >> 2); nt = w & 3;
    return true;
  }
  const int NG = NT >> 1;
  if (sb >= 24 * NG) return false;
  const int mg = sb / NG, ng = sb - mg * NG;
  mt = mg * 16 + (w >> 1); nt = ng * 2 + (w & 1);
  return true;
}

DI bool att_tile_index(int bid, int nb, int it, int& tile) {
  if (nb != 256) { tile = bid + it * nb; return tile < 1536; }
  const int x = bid & 7, l = bid >> 3;
  const int pair = 2 * (it * 8 + x) + (l >> 4);
  tile = pair * 16 + ((l + 3 * it) & 15);
  return pair < 96;
}

template <int EPI, bool GSCALE = false>
DI void gemm8_phase(const Params& p, int layer, const u16* A, const u16* Bt, int K, int NT, char* smem) {
  const int bid = blockIdx.x, nb = gridDim.x;
  int mt, nt;
  bool have = sb_tile(bid, nb, 0, NT, mt, nt);
  if (have) gemm8_prestage(A, Bt, K, mt * 256, nt * 256, smem);
  for (int it = 0; have; ++it) {
    int mt2 = 0, nt2 = 0;
    const bool have2 = sb_tile(bid, nb, it + 1, NT, mt2, nt2);
    gemm8_tile<EPI, GSCALE>(p, layer, A, Bt, K, mt * 256, nt * 256, smem, have2, mt2 * 256, nt2 * 256);
    have = have2; mt = mt2; nt = nt2;
  }
}

constexpr int NPHASE = 17;
constexpr int MT = T_TOK / 256;

DI void run_phase(const Params& p, int ph, char* smem) {
  const int bid = blockIdx.x, nb = gridDim.x;
  u16* wtb = (u16*)(p.ws + OFF_WT);
  const u16* actb = (const u16*)(p.ws + OFF_ACTB);
  if (ph == 0) {
    for (int j = bid; j < 128; j += nb) rope_tab_build(p.ws, j * NTHR + opaque_tid());
    for (int j = bid; j < WJ_TOTAL; j += nb) wprep_job(p, j, smem);
    for (int rb = bid; rb < T_TOK / (8 * NRW); rb += nb) norm_rows(p, 0, rb, 0);
    return;
  }
  if (ph == 16) { for (int rb = bid; rb < T_TOK / (8 * NRW); rb += nb) norm_rows(p, 1, rb, 1); return; }
  const int layer = (ph - 1) >> 3, sub = (ph - 1) & 7;
  const u16* wl = wtb + (size_t)layer * WT_LAYER;
  switch (sub) {
    case 0:
      gemm8_phase<EPI_PROJ>(p, layer, actb, wl + WT_IN, 1024, 10, smem);
      break;
    case 1:
      for (int c = bid; c < (T_TOK / NTHR) * 8; c += nb) e1_chunk(p, layer, c);
      for (int t = bid; t < MT * 2; t += nb) { const int nt = t & 1, mt = t >> 1; gemm_tile<EPI_UQ, false, true>(p, layer, (const u16*)(p.ws + OFF_PROJ) + 2048, DIN, wl + WT_UQ, 256, mt * 256, nt * 256, smem); }
      for (int t = bid; t < MT * 2; t += nb) { const int nt = t & 1, mt = t >> 1; gemm_tile<EPI_UKV, false, true>(p, layer, (const u16*)(p.ws + OFF_PROJ) + 2304, DIN, wl + WT_UKV, 128, mt * 256, nt * 256, smem); }
      break;
    case 2:
      for (int it = 0, t; att_tile_index(bid, nb, it, t); ++it) attn_tile<3>(p, layer, t, smem);
      for (int it = 0, t; att_tile_index(bid, nb, it, t); ++it) attn_tile<1>(p, layer, t, smem);
      for (int it = 0, t; att_tile_index(bid, nb, it, t); ++it) attn_tile<0>(p, layer, t, smem);
      for (int it = 0, t; att_tile_index(bid, nb, it, t); ++it) attn_tile<2>(p, layer, t, smem);
      break;
    case 3:
      gemm8_phase<EPI_RES, true>(p, layer, actb, wl + WT_OUT, 1024, 4, smem);
      break;
    case 4:
      for (int rb = bid; rb < T_TOK / (8 * NRW); rb += nb) norm_rows(p, 1, rb, 0);
      break;
    case 5:
      gemm8_phase<EPI_SWIGLU>(p, layer, actb, wl + WT_GU, 1024, 22, smem);
      break;
    case 6:
      gemm8_phase<EPI_RES>(p, 1, (const u16*)(p.ws + OFF_ACT), wl + WT_DN, DFF, 4, smem);
      break;
    case 7:
      for (int rb = bid; rb < T_TOK / (8 * NRW); rb += nb) norm_rows(p, 1, rb, 0);
      break;
  }
}

__global__ void __launch_bounds__(NTHR, 2) mega(Params p, int ph_lo, int ph_hi) {
  __shared__ __attribute__((aligned(16))) char smem[SMEM_BYTES];
  cg::grid_group grid = cg::this_grid();
  for (int ph = ph_lo; ph < ph_hi; ++ph) {
    if (ph > ph_lo) grid.sync();
    run_phase(p, ph, smem);
#ifdef DUPMASK
    if (ph >= 1 && ph < 16 && ((DUPMASK >> ((ph - 1) & 7)) & 1)) { grid.sync(); run_phase(p, ph, smem); }
#endif
  }
}

extern "C" void kernel_launch(void* const* d_in, const int* in_sizes, int n_in, void* d_out, int out_size, void* d_ws, size_t ws_size, hipStream_t stream) {
  Params p{};
  p.x_prompt = (const float*)d_in[0]; p.x_sample = (const float*)d_in[1]; p.t5_bias = (const float*)d_in[2]; p.norm_mix = (const float*)d_in[3];
  p.w_in = (const float*)d_in[4]; p.b_q_gain = (const float*)d_in[5]; p.b_k_gain = (const float*)d_in[6]; p.c_rpb = (const float*)d_in[7];
  p.d_q_gain = (const float*)d_in[8]; p.d_w_uq = (const float*)d_in[9]; p.d_kv_gain = (const float*)d_in[10]; p.d_w_ukv = (const float*)d_in[11];
  p.out_gain = (const float*)d_in[12]; p.w_out = (const float*)d_in[13]; p.norm_ffn = (const float*)d_in[14]; p.w_gate = (const float*)d_in[15];
  p.w_up = (const float*)d_in[16]; p.w_down = (const float*)d_in[17]; p.final_norm = (const float*)d_in[18];
  p.out = (float*)d_out; p.ws = (char*)d_ws;
  if (ws_size < WS_NEED) { fprintf(stderr, "workspace too small: %zu < %zu\n", ws_size, (size_t)WS_NEED); return; }
  static int grid_blocks = 0;
  if (!grid_blocks) {
    int dev = 0, cus = 0, per_cu = 0;
    hipGetDevice(&dev);
    hipDeviceGetAttribute(&cus, hipDeviceAttributeMultiprocessorCount, dev);
    hipOccupancyMaxActiveBlocksPerMultiprocessor(&per_cu, mega, NTHR, 0);
    if (per_cu < 1) per_cu = 1;
    if (per_cu > 1) per_cu = 1;
    grid_blocks = cus * per_cu;
  }
#if ONE_LAUNCH
  int lo = 0, hi = NPHASE;
  void* args[] = {&p, &lo, &hi};
  hipError_t e = hipLaunchCooperativeKernel((void*)mega, dim3(grid_blocks), dim3(NTHR), args, 0, stream);
  if (e != hipSuccess) fprintf(stderr, "cooperative launch failed: %s (grid %d)\n", hipGetErrorString(e), grid_blocks);
#else
  for (int ph = 0; ph < NPHASE; ++ph) hipLaunchKernelGGL(mega, dim3(grid_blocks), dim3(NTHR), 0, stream, p, ph, ph + 1);
#endif
}
```

```cpp
#include <hip/hip_runtime.h>
#include <hip/hip_cooperative_groups.h>
#include <cstdio>
#include <cstdint>
namespace cg = cooperative_groups;

#ifndef ONE_LAUNCH
#define ONE_LAUNCH 1
#endif

#define DI __device__ __forceinline__
typedef short bf16x8 __attribute__((ext_vector_type(8)));
typedef short s16x4 __attribute__((ext_vector_type(4)));
typedef float f32x16 __attribute__((ext_vector_type(16)));
typedef float f32x4 __attribute__((ext_vector_type(4)));
typedef float f32x2 __attribute__((ext_vector_type(2)));
typedef unsigned u32x4 __attribute__((ext_vector_type(4)));
typedef unsigned u32x2 __attribute__((ext_vector_type(2)));
typedef __bf16 bf16v2 __attribute__((ext_vector_type(2)));
typedef unsigned short u16;

constexpr int T_TOK = 98304, SEQ = 4096, DM = 1024, DIN = 2464, DINP = 2560, DFF = 2816;
constexpr int NPROMPT = 8 * 4096;
constexpr int NTHR = 512;
constexpr float LOG2E = 1.4426950408889634f;
constexpr float QSCALE64 = 0.125f * LOG2E;
constexpr float QSCALE96 = 0.10206207261596575f * LOG2E;
constexpr float NEGBIG = -1e30f;
constexpr float EPS = 1e-6f;

constexpr size_t al256(size_t x) { return (x + 255) & ~(size_t)255; }
constexpr size_t WT_IN = 0;
constexpr size_t WT_UQ = WT_IN + (size_t)DINP * 1024;
constexpr size_t WT_UKV = WT_UQ + 512 * 256;
constexpr size_t WT_OUT = WT_UKV + 512 * 128;
constexpr size_t WT_GU = WT_OUT + 1024 * 1024;
constexpr size_t WT_DN = WT_GU + (size_t)5632 * 1024;
constexpr size_t WT_LAYER = WT_DN + (size_t)1024 * 2816;
constexpr size_t OFF_WT = 0;
constexpr size_t OFF_TBLA = al256(OFF_WT + 2 * WT_LAYER * 2);
constexpr size_t OFF_ROPE = al256(OFF_TBLA + 4 * 2560 * 4);
constexpr size_t OFF_ACTB = al256(OFF_ROPE + 4096 * 16 * 8);
constexpr size_t OFF_PROJ = al256(OFF_ACTB + (size_t)T_TOK * 1024 * 2);
constexpr size_t OFF_QD = al256(OFF_PROJ + (size_t)T_TOK * DIN * 2);
constexpr size_t OFF_KD = al256(OFF_QD + (size_t)T_TOK * 384 * 2);
constexpr size_t OFF_VD = al256(OFF_KD + (size_t)T_TOK * 384 * 2);
constexpr size_t OFF_SSQ = al256(OFF_VD + (size_t)T_TOK * 256 * 2);
constexpr size_t WS_NEED = al256(OFF_SSQ + (size_t)T_TOK * 16 * 4);
constexpr size_t OFF_ACT = OFF_PROJ;
static_assert(OFF_ACT + (size_t)T_TOK * DFF * 2 <= OFF_KD, "act alias overflow");

struct Params {
  const float *x_prompt, *x_sample, *t5_bias, *norm_mix, *w_in, *b_q_gain, *b_k_gain, *c_rpb, *d_q_gain, *d_w_uq,
      *d_kv_gain, *d_w_ukv, *out_gain, *w_out, *norm_ffn, *w_gate, *w_up, *w_down, *final_norm;
  float* out;
  char* ws;
};

constexpr int SMEM_BYTES = 2 * (256 + 256) * 72 * 2 + 1024;

DI unsigned pack2(float a, float b) { f32x2 v = {a, b}; bf16v2 r = __builtin_convertvector(v, bf16v2); return __builtin_bit_cast(unsigned, r); }
DI float bflo(unsigned w) { return __uint_as_float(w << 16); }
DI float bfhi(unsigned w) { return __uint_as_float(w & 0xffff0000u); }
DI f32x16 mfma(bf16x8 a, bf16x8 b, f32x16 c) { return __builtin_amdgcn_mfma_f32_32x32x16_bf16(a, b, c, 0, 0, 0); }
DI float hmax(float v) {
  auto rr = __builtin_amdgcn_permlane32_swap(__float_as_uint(v), __float_as_uint(v), false, false);
  return __builtin_fmaxf(__uint_as_float(rr[0]), __uint_as_float(rr[1]));
}
DI float hsum(float v) {
  auto rr = __builtin_amdgcn_permlane32_swap(__float_as_uint(v), __float_as_uint(v), false, false);
  return __uint_as_float(rr[0]) + __uint_as_float(rr[1]);
}
DI float fexp2(float x) { return __builtin_amdgcn_exp2f(x); }
DI int crow(int i, int h) { return (i & 3) + 8 * (i >> 2) + 4 * h; }
typedef short v4i16_t __attribute__((ext_vector_type(4)));
DI s16x4 tr_read(const u16* p) {
  return __builtin_bit_cast(s16x4, __builtin_amdgcn_ds_read_tr16_b64_v4i16((__attribute__((address_space(3))) v4i16_t*)p));
}
constexpr double inv_rev_c(int i) {
  constexpr double b[4] = {1.0, 0.5623413251903491, 0.31622776601683794, 0.1778279410038923};
  double v = b[i & 3];
  for (int k = 0; k < (i >> 2); ++k) v *= 0.1;
  return v * 0.15915494309189535;
}
DI void rope_tab_build(char* ws, int idx) {
  const int pos = idx >> 4, i = idx & 15;
  double invrev = inv_rev_c(0);
#pragma unroll
  for (int k = 1; k < 16; ++k) if (i == k) invrev = inv_rev_c(k);
  double rev = (double)pos * invrev;
  float f = (float)(rev - (double)(int)rev);
  f32x2 cs = {__builtin_amdgcn_cosf(f), __builtin_amdgcn_sinf(f)};
  ((f32x2*)(ws + OFF_ROPE))[idx] = cs;
}
#define ROPE16(ws_, pos_, A_, B_)                                                              \
  {                                                                                            \
    const f32x4* rt_ = (const f32x4*)((ws_) + OFF_ROPE) + (size_t)(pos_) * 8;                  \
    _Pragma("unroll") for (int i2_ = 0; i2_ < 8; ++i2_) {                                      \
      const f32x4 cs_ = rt_[i2_];                                                              \
      float a_ = A_[2 * i2_], b_ = B_[2 * i2_];                                                \
      A_[2 * i2_] = a_ * cs_[0] - b_ * cs_[1]; B_[2 * i2_] = a_ * cs_[1] + b_ * cs_[0];        \
      a_ = A_[2 * i2_ + 1]; b_ = B_[2 * i2_ + 1];                                              \
      A_[2 * i2_ + 1] = a_ * cs_[2] - b_ * cs_[3]; B_[2 * i2_ + 1] = a_ * cs_[3] + b_ * cs_[2]; \
    }                                                                                          \
  }
DI const float* xrow(const Params& p, int layer, size_t tok) {
  if (layer == 0) return tok < (size_t)NPROMPT ? p.x_prompt + tok * DM : p.x_sample + (tok - NPROMPT) * DM;
  return p.out + tok * DM;
}

DI int opaque_tid() { int t = threadIdx.x; asm volatile("" : "+v"(t)); return t; }
DI void wt_tile(const float* __restrict__ W, int K, int N, const float* __restrict__ g, u16* __restrict__ Wt, int k0, int n0, int mapmode, float* tile) {
  const int tid = opaque_tid();
  for (int i = tid; i < 4096; i += NTHR) {
    int kk = i >> 6, nn = i & 63, n = n0 + nn;
    float v = 0.f;
    if (n < N) { v = W[(size_t)(k0 + kk) * N + n]; if (g) v *= g[k0 + kk]; }
    tile[kk * 65 + nn] = v;
  }
  __syncthreads();
  for (int i = tid; i < 2048; i += NTHR) {
    int nn = i >> 5, kp = i & 31, n = n0 + nn;
    float cs = 1.f; int drow = n;
    if (mapmode == 1) { if (n < 256 || (n >= 1280 && n < 1536)) cs = QSCALE64; }
    else if (mapmode == 2) cs = QSCALE96;
    else if (mapmode == 3) drow = 32 * (n >> 4) + (n & 15);
    else if (mapmode == 4) drow = 32 * (n >> 4) + 16 + (n & 15);
    unsigned w = pack2(tile[(2 * kp) * 65 + nn] * cs, tile[(2 * kp + 1) * 65 + nn] * cs);
    *(unsigned*)(Wt + (size_t)drow * K + k0 + 2 * kp) = w;
  }
  __syncthreads();
}

constexpr int WJ_IN = 640, WJ_UQ = 32, WJ_UKV = 16, WJ_OUT = 256, WJ_G = 704, WJ_U = 704, WJ_D = 704;
constexpr int WJ_LAYER = WJ_IN + WJ_UQ + WJ_UKV + WJ_OUT + WJ_G + WJ_U + WJ_D;
constexpr int WJ_TOTAL = 2 * WJ_LAYER + 20;

DI void wprep_job(const Params& p, int job, char* smem) {
  float* tile = (float*)smem;
  u16* wtb = (u16*)(p.ws + OFF_WT);
  if (job >= 2 * WJ_LAYER) {
    int idx = (job - 2 * WJ_LAYER) * NTHR + opaque_tid();
    int head = idx / 2560, e = idx % 2560, d = e - 1280, n = d < 0 ? -d : d;
    int mult = (n <= 64 ? 1 : 0) + (((n & 3) == 0 && n <= 256) ? 1 : 0) + (((n & 15) == 0 && n <= 1024) ? 1 : 0);
    float v = NEGBIG;
    if (mult > 0) {
      int bk;
      if (n < 8) bk = n;
      else { float nf = (float)n; int lg = 8 + (int)(__logf(nf * 0.125f) / 4.852030263919617f * 8.0f); bk = lg < 15 ? lg : 15; }
      if (d > 0) bk += 16;
      v = (p.t5_bias[bk * 4 + head] + __logf((float)mult)) * LOG2E;
    }
    ((float*)(p.ws + OFF_TBLA))[idx] = v;
    return;
  }
  int layer = job / WJ_LAYER, j = job % WJ_LAYER;
  u16* wl = wtb + (size_t)layer * WT_LAYER;
  if (j < WJ_IN) { int kt = j & 15, nt = j >> 4; wt_tile(p.w_in + (size_t)layer * 1024 * DIN, 1024, DIN, p.norm_mix + layer * 1024, wl + WT_IN, kt * 64, nt * 64, 1, tile); return; }
  j -= WJ_IN;
  if (j < WJ_UQ) { int kt = j & 3, nt = j >> 2; wt_tile(p.d_w_uq + (size_t)layer * 256 * 384, 256, 384, p.d_q_gain + layer * 256, wl + WT_UQ, kt * 64, nt * 64, 2, tile); return; }
  j -= WJ_UQ;
  if (j < WJ_UKV) { int kt = j & 1, nt = j >> 1; wt_tile(p.d_w_ukv + (size_t)layer * 128 * 512, 128, 512, p.d_kv_gain + layer * 128, wl + WT_UKV, kt * 64, nt * 64, 0, tile); return; }
  j -= WJ_UKV;
  if (j < WJ_OUT) { int kt = j & 15, nt = j >> 4; wt_tile(p.w_out + (size_t)layer * 1024 * 1024, 1024, 1024, p.out_gain + layer * 1024, wl + WT_OUT, kt * 64, nt * 64, 0, tile); return; }
  j -= WJ_OUT;
  if (j < WJ_G) { int kt = j & 15, nt = j >> 4; wt_tile(p.w_gate + (size_t)layer * 1024 * DFF, 1024, DFF, p.norm_ffn + layer * 1024, wl + WT_GU, kt * 64, nt * 64, 3, tile); return; }
  j -= WJ_G;
  if (j < WJ_U) { int kt = j & 15, nt = j >> 4; wt_tile(p.w_up + (size_t)layer * 1024 * DFF, 1024, DFF, p.norm_ffn + layer * 1024, wl + WT_GU, kt * 64, nt * 64, 4, tile); return; }
  j -= WJ_U;
  { int kt = j % 44, nt = j / 44; wt_tile(p.w_down + (size_t)layer * DFF * 1024, DFF, 1024, nullptr, wl + WT_DN, kt * 64, nt * 64, 0, tile); }
}

constexpr int NRW = 4;
DI void norm_rows(const Params& p, int layer, int rb, int mode) {
  const int tid = opaque_tid();
  const int lane = tid & 63, wave = tid >> 6;
  const size_t rowb = (size_t)rb * (8 * NRW) + wave;
  f32x4 v[NRW][4];
#pragma unroll
  for (int rr = 0; rr < NRW; ++rr) {
    const float* src = xrow(p, layer, rowb + 8 * rr);
#pragma unroll
    for (int i = 0; i < 4; ++i) v[rr][i] = __builtin_nontemporal_load((const f32x4*)(src + lane * 4 + 256 * i));
  }
#pragma unroll
  for (int rr = 0; rr < NRW; ++rr) {
    float ss = 0.f;
#pragma unroll
    for (int i = 0; i < 4; ++i) ss += v[rr][i][0] * v[rr][i][0] + v[rr][i][1] * v[rr][i][1] + v[rr][i][2] * v[rr][i][2] + v[rr][i][3] * v[rr][i][3];
#pragma unroll
    for (int o = 1; o < 64; o <<= 1) ss += __shfl_xor(ss, o);
    const float rstd = rsqrtf(ss * (1.f / 1024.f) + EPS);
    const size_t row = rowb + 8 * rr;
    if (mode == 0) {
      u16* dst = (u16*)(p.ws + OFF_ACTB) + row * DM;
#pragma unroll
      for (int i = 0; i < 4; ++i) { u32x2 w = {pack2(v[rr][i][0] * rstd, v[rr][i][1] * rstd), pack2(v[rr][i][2] * rstd, v[rr][i][3] * rstd)}; *(u32x2*)(dst + lane * 4 + 256 * i) = w; }
    } else {
      float* dst = p.out + row * DM;
#pragma unroll
      for (int i = 0; i < 4; ++i) { f32x4 g = *(const f32x4*)(p.final_norm + lane * 4 + 256 * i); f32x4 o = {v[rr][i][0] * rstd * g[0], v[rr][i][1] * rstd * g[1], v[rr][i][2] * rstd * g[2], v[rr][i][3] * rstd * g[3]}; __builtin_nontemporal_store(o, (f32x4*)(dst + lane * 4 + 256 * i)); }
    }
  }
}

enum { EPI_PROJ = 0, EPI_UQ = 1, EPI_UKV = 2, EPI_RES = 3, EPI_SWIGLU = 4 };
constexpr int GS = 72;
constexpr int BM = 256;
constexpr int TMW = 4;

template <int EPI, bool ASCALE, bool ROWNORM>
DI void gemm_tile(const Params& p, int layer, const u16* __restrict__ A, int lda, const u16* __restrict__ Wt, int K, int m0, int n0, char* smem) {
  u16* As = (u16*)smem;
  u16* Bs = As + 2 * BM * GS;
  float* rowscale = (float*)(Bs + 2 * 256 * GS);
  const int tid = opaque_tid(), lane = tid & 63, wave = tid >> 6, r = lane & 31, h = lane >> 5;
  const int wm = wave >> 2, wn = wave & 3;
  const int lrow = tid >> 3, kc = tid & 7;
  const u16* At = A + (size_t)m0 * lda;
  const u16* Bt = Wt + (size_t)n0 * K;
  const unsigned aoff = (unsigned)lrow * lda + kc * 8, boff = (unsigned)lrow * K + kc * 8;
  const float* ssq = (const float*)(p.ws + OFF_SSQ);

  if (ROWNORM) {
    const int rr = tid >> 1, half = tid & 1;
    const u16* src = A + (size_t)(m0 + rr) * lda + half * (K / 2);
    float ss = 0.f;
    for (int i = 0; i < K / 16; ++i) {
      u32x4 w = *(const u32x4*)(src + i * 8);
#pragma unroll
      for (int e = 0; e < 4; ++e) { float a = bflo(w[e]), b = bfhi(w[e]); ss += a * a + b * b; }
    }
    ss += __shfl_xor(ss, 1);
    if (half == 0) rowscale[rr] = rsqrtf(ss / (float)K + EPS);
  }

  f32x16 acc[TMW][2];
#pragma unroll
  for (int a = 0; a < TMW; ++a)
#pragma unroll
    for (int b = 0; b < 2; ++b)
#pragma unroll
      for (int i = 0; i < 16; ++i) acc[a][b][i] = 0.f;

  u32x4 ra[4], rb[4];
  float sc[4] = {1.f, 1.f, 1.f, 1.f};
  const int KT = K / 64;
  auto gload = [&](int kt) {
#pragma unroll
    for (int pp = 0; pp < 4; ++pp) ra[pp] = *(const u32x4*)(At + (size_t)(64 * pp) * lda + (aoff + (unsigned)kt * 64));
#pragma unroll
    for (int pp = 0; pp < 4; ++pp) rb[pp] = *(const u32x4*)(Bt + (size_t)(64 * pp) * K + (boff + (unsigned)kt * 64));
  };
  auto lstore = [&](int buf, int kt) {
    if (ASCALE) {
      if ((kt & 3) == 0) {
        const int g = kt >> 2;
#pragma unroll
        for (int pp = 0; pp < 4; ++pp) {
          f32x4 s4 = *(const f32x4*)(ssq + (size_t)(m0 + lrow + 64 * pp) * 16 + 4 * g);
          sc[pp] = rsqrtf((s4[0] + s4[1] + s4[2] + s4[3]) * (1.f / 256.f) + EPS);
        }
      }
#pragma unroll
      for (int pp = 0; pp < 4; ++pp)
#pragma unroll
        for (int e = 0; e < 4; ++e) ra[pp][e] = pack2(bflo(ra[pp][e]) * sc[pp], bfhi(ra[pp][e]) * sc[pp]);
    }
#pragma unroll
    for (int pp = 0; pp < 4; ++pp) *(u32x4*)(As + (buf * BM + lrow + 64 * pp) * GS + kc * 8) = ra[pp];
#pragma unroll
    for (int pp = 0; pp < 4; ++pp) *(u32x4*)(Bs + (buf * 256 + lrow + 64 * pp) * GS + kc * 8) = rb[pp];
  };
  auto compute = [&](int buf) {
    const u16* Ab = As + (buf * BM + wm * 128 + r) * GS + 8 * h;
    const u16* Bb = Bs + (buf * 256 + wn * 64 + r) * GS + 8 * h;
#pragma unroll
    for (int ks = 0; ks < 4; ++ks) {
      bf16x8 b0 = *(const bf16x8*)(Bb + ks * 16);
      bf16x8 b1 = *(const bf16x8*)(Bb + 32 * GS + ks * 16);
#pragma unroll
      for (int tm = 0; tm < TMW; ++tm) {
        bf16x8 a = *(const bf16x8*)(Ab + tm * 32 * GS + ks * 16);
        acc[tm][0] = mfma(a, b0, acc[tm][0]);
        acc[tm][1] = mfma(a, b1, acc[tm][1]);
      }
    }
  };
  gload(0);
  lstore(0, 0);
  if (KT > 1) gload(1);
  __syncthreads();
  for (int kt = 0; kt < KT; ++kt) {
    compute(kt & 1);
    if (kt + 1 < KT) lstore((kt + 1) & 1, kt + 1);
    if (kt + 2 < KT) gload(kt + 2);
    __syncthreads();
  }

  const int wms = __builtin_amdgcn_readfirstlane(wm), wns = __builtin_amdgcn_readfirstlane(wn);
  const int mrow0 = m0 + wms * 128;
  const int nwb = n0 + wns * 64;
  if (ROWNORM) {
#pragma unroll
    for (int tm = 0; tm < TMW; ++tm) {
#pragma unroll
      for (int i = 0; i < 16; ++i) {
        const float rs = rowscale[wms * 128 + 4 * h + 32 * tm + (i & 3) + 8 * (i >> 2)];
        acc[tm][0][i] *= rs; acc[tm][1][i] *= rs;
      }
    }
  }
  if (EPI == EPI_SWIGLU) {
    u16* dw = (u16*)(p.ws + OFF_ACT) + (size_t)mrow0 * DFF + (nwb >> 1);
    const unsigned lo = (unsigned)(4 * h) * DFF + r;
#pragma unroll
    for (int tm = 0; tm < TMW; ++tm) {
#pragma unroll
      for (int i = 0; i < 16; ++i) {
        const float g = acc[tm][0][i], u = acc[tm][1][i];
        const float a = g * __builtin_amdgcn_rcpf(1.f + fexp2(-g * LOG2E)) * u;
        dw[lo + (unsigned)((32 * tm + (i & 3) + 8 * (i >> 2)) * DFF)] = (u16)(pack2(a, 0.f) & 0xffff);
      }
      __builtin_amdgcn_sched_barrier(0);
    }
  } else {
#pragma unroll
    for (int tn = 0; tn < 2; ++tn) {
      const int nb0 = nwb + 32 * tn;
      if (EPI == EPI_RES) {
        const float* xw = (layer == 0 ? (m0 < NPROMPT ? p.x_prompt + (size_t)mrow0 * DM : p.x_sample + (size_t)(mrow0 - NPROMPT) * DM) : p.out + (size_t)mrow0 * DM) + nb0;
        float* ow = p.out + (size_t)mrow0 * DM + nb0;
        const unsigned lo = (unsigned)(4 * h) * DM + r;
#pragma unroll
        for (int tm = 0; tm < TMW; ++tm) {
#pragma unroll
          for (int g4 = 0; g4 < 4; ++g4) {
            float xv[4];
#pragma unroll
            for (int e = 0; e < 4; ++e) xv[e] = xw[lo + (unsigned)((32 * tm + 8 * g4 + e) * DM)];
#pragma unroll
            for (int e = 0; e < 4; ++e) ow[lo + (unsigned)((32 * tm + 8 * g4 + e) * DM)] = xv[e] + acc[tm][tn][4 * g4 + e];
          }
          __builtin_amdgcn_sched_barrier(0);
        }
      } else {
        u16* dw; int ld; bool ok = true;
        if (EPI == EPI_PROJ) { dw = (u16*)(p.ws + OFF_PROJ) + (size_t)mrow0 * DIN + nb0; ld = DIN; ok = (nb0 + r) < DIN; }
        else if (EPI == EPI_UQ) { dw = (u16*)(p.ws + OFF_QD) + (size_t)mrow0 * 384 + nb0; ld = 384; ok = nb0 < 384; }
        else {
          const int head = nb0 >> 7, w = nb0 & 127;
          if (w < 64) { dw = (u16*)(p.ws + OFF_KD) + (size_t)mrow0 * 384 + head * 96 + w; ld = 384; }
          else { dw = (u16*)(p.ws + OFF_VD) + (size_t)mrow0 * 256 + head * 64 + (w - 64); ld = 256; }
        }
        const unsigned lo = (unsigned)(4 * h) * ld + r;
        if (ok) {
#pragma unroll
          for (int tm = 0; tm < TMW; ++tm) {
#pragma unroll
            for (int i = 0; i < 16; ++i) dw[lo + (unsigned)((32 * tm + (i & 3) + 8 * (i >> 2)) * ld)] = (u16)(pack2(acc[tm][tn][i], 0.f) & 0xffff);
            __builtin_amdgcn_sched_barrier(0);
          }
        }
      }
    }
  }
  if (ROWNORM) __syncthreads();
}


typedef float f32x4v __attribute__((ext_vector_type(4)));
constexpr int G8_HT = 128 * 64;
DI int lds_byte8(int r, int c) { const int st = (r >> 4) * 2 + (c >> 5), ob = (r & 15) * 64 + (c & 31) * 2; return st * 1024 + (ob ^ (((ob >> 9) & 1) << 5)); }
DI void stage_rc8(int b, int& R, int& C) { const int st = b >> 10, sb = b & 1023, swz = sb ^ (((sb >> 9) & 1) << 5); R = (st >> 1) * 16 + (swz >> 6); C = (st & 1) * 32 + ((swz & 63) >> 1); }

DI void gemm8_prestage(const u16* __restrict__ A, const u16* __restrict__ Bt, int K, int brow, int bcol, char* smem) {
  u16* shm = (u16*)smem;
  const int tid = opaque_tid();
  int sr0, sc0, sr1, sc1;
  stage_rc8(tid * 16, sr0, sc0);
  stage_rc8(tid * 16 + 8192, sr1, sc1);
  const unsigned go0 = (unsigned)sr0 * K + sc0, go1 = (unsigned)sr1 * K + sc1;
#define G8P_STAGE(P, BASE, br) do { const u16* g_ = (BASE) + (size_t)(br) * K; \
    __builtin_amdgcn_global_load_lds((const unsigned*)(g_ + go0), (__attribute__((address_space(3))) unsigned*)((char*)(P) + tid * 16), 16, 0, 0); \
    __builtin_amdgcn_global_load_lds((const unsigned*)(g_ + go1), (__attribute__((address_space(3))) unsigned*)((char*)(P) + tid * 16 + 8192), 16, 0, 0); } while (0)
  G8P_STAGE(shm + 4 * G8_HT, Bt, bcol); G8P_STAGE(shm, A, brow);
  G8P_STAGE(shm + 5 * G8_HT, Bt, bcol + 128); G8P_STAGE(shm + G8_HT, A, brow + 128);
#undef G8P_STAGE
}

template <int EPI, bool GSCALE = false>
DI void gemm8_tile(const Params& p, int layer, const u16* __restrict__ A, const u16* __restrict__ Bt, int K, int brow, int bcol, char* smem,
                   bool next_valid, int next_brow, int next_bcol) {
  u16* shm = (u16*)smem;
  const int tid = opaque_tid();
  float* gfac = (float*)(smem + 8 * G8_HT * 2);
  if (GSCALE) {
    if (tid < 256) {
      const float* sq = (const float*)(p.ws + OFF_SSQ) + (size_t)(brow + tid) * 16;
      float rs[4];
#pragma unroll
      for (int g = 0; g < 4; ++g) { const f32x4 s4 = *(const f32x4*)(sq + 4 * g); rs[g] = rsqrtf((s4[0] + s4[1] + s4[2] + s4[3]) * (1.f / 256.f) + EPS); }
      gfac[tid] = rs[0] / rs[1]; gfac[256 + tid] = rs[1] / rs[2]; gfac[512 + tid] = rs[2] / rs[3]; gfac[768 + tid] = rs[3];
    }
  }
  const int wid = tid >> 6, lane = tid & 63, wr = wid >> 2, wc = wid & 3, fr = lane & 15, fq = lane >> 4;
  int sr0, sc0, sr1, sc1;
  stage_rc8(tid * 16, sr0, sc0);
  stage_rc8(tid * 16 + 8192, sr1, sc1);
  const unsigned go0 = (unsigned)sr0 * K + sc0, go1 = (unsigned)sr1 * K + sc1;
#define G8_SA(b, hh) (shm + ((b) * 2 + (hh)) * G8_HT)
#define G8_SB(b, hh) (shm + (4 + (b) * 2 + (hh)) * G8_HT)
#define G8_STAGE(P, BASE, br, kt) do { const u16* g_ = (BASE) + (size_t)(br) * K + (size_t)(kt) * 64; \
    __builtin_amdgcn_global_load_lds((const unsigned*)(g_ + go0), (__attribute__((address_space(3))) unsigned*)((char*)(P) + tid * 16), 16, 0, 0); \
    __builtin_amdgcn_global_load_lds((const unsigned*)(g_ + go1), (__attribute__((address_space(3))) unsigned*)((char*)(P) + tid * 16 + 8192), 16, 0, 0); } while (0)
#define G8_LDA(dst, b, hh) _Pragma("unroll") for (int m = 0; m < 4; ++m) _Pragma("unroll") for (int k = 0; k < 2; ++k) \
    dst[m][k] = *reinterpret_cast<const bf16x8*>((char*)G8_SA(b, hh) + lds_byte8(wr * 64 + m * 16 + fr, k * 32 + fq * 8))
#define G8_LDB(dst, b, hh) _Pragma("unroll") for (int n = 0; n < 2; ++n) _Pragma("unroll") for (int k = 0; k < 2; ++k) \
    dst[n][k] = *reinterpret_cast<const bf16x8*>((char*)G8_SB(b, hh) + lds_byte8(wc * 32 + n * 16 + fr, k * 32 + fq * 8))
#define G8_MMA(ai, bj, At_, Bt_) do { __builtin_amdgcn_s_setprio(1); \
    _Pragma("unroll") for (int m = 0; m < 4; ++m) _Pragma("unroll") for (int n = 0; n < 2; ++n) _Pragma("unroll") for (int k = 0; k < 2; ++k) \
      acc[ai][bj][m][n] = __builtin_amdgcn_mfma_f32_16x16x32_bf16(At_[m][k], Bt_[n][k], acc[ai][bj][m][n], 0, 0, 0); \
    __builtin_amdgcn_s_setprio(0); } while (0)
#define G8_WAIT_V(n) asm volatile("s_waitcnt vmcnt(" #n ")" ::: "memory")
#define G8_WAIT_L(n) asm volatile("s_waitcnt lgkmcnt(" #n ")" ::: "memory")
#define G8_BAR __builtin_amdgcn_s_barrier()
#define G8_SCHED __builtin_amdgcn_sched_barrier(0)
  f32x4v acc[2][2][4][2];
#pragma unroll
  for (int a = 0; a < 2; ++a)
#pragma unroll
    for (int b = 0; b < 2; ++b)
#pragma unroll
      for (int m = 0; m < 4; ++m)
#pragma unroll
        for (int n = 0; n < 2; ++n) acc[a][b][m][n] = (f32x4v){0.f, 0.f, 0.f, 0.f};
  bf16x8 At[4][2], B0[2][2], B1[2][2];
  const int nt = K / 64;
  if (wr == 1) G8_BAR;
  G8_WAIT_V(4); G8_BAR;
  G8_STAGE(G8_SB(1, 0), Bt, bcol, 1); G8_STAGE(G8_SA(1, 0), A, brow, 1); G8_STAGE(G8_SB(1, 1), Bt, bcol + 128, 1);
  G8_WAIT_V(6); G8_BAR;
  for (int t = 0; t < nt - 2; t += 2) {
    G8_LDB(B0, 0, 0); G8_SCHED; G8_LDA(At, 0, 0); G8_STAGE(G8_SA(1, 1), A, brow + 128, t + 1);
    G8_WAIT_L(8); G8_BAR; G8_WAIT_L(0); G8_MMA(0, 0, At, B0); G8_BAR; G8_SCHED;
    G8_LDB(B1, 0, 1); G8_STAGE(G8_SB(0, 0), Bt, bcol, t + 2);
    G8_BAR; G8_WAIT_L(0); G8_MMA(0, 1, At, B1); G8_BAR;
    G8_LDA(At, 0, 1); G8_STAGE(G8_SA(0, 0), A, brow, t + 2);
    G8_BAR; G8_WAIT_L(0); G8_MMA(1, 0, At, B0); G8_BAR; G8_SCHED;
    G8_STAGE(G8_SB(0, 1), Bt, bcol + 128, t + 2);
    G8_WAIT_V(6); G8_BAR; G8_MMA(1, 1, At, B1); G8_BAR;
    G8_LDB(B0, 1, 0); G8_SCHED; G8_LDA(At, 1, 0); G8_STAGE(G8_SA(0, 1), A, brow + 128, t + 2);
    G8_WAIT_L(8); G8_BAR; G8_WAIT_L(0); G8_MMA(0, 0, At, B0); G8_BAR; G8_SCHED;
    G8_LDB(B1, 1, 1); G8_STAGE(G8_SB(1, 0), Bt, bcol, t + 3);
    G8_BAR; G8_WAIT_L(0); G8_MMA(0, 1, At, B1); G8_BAR;
    G8_LDA(At, 1, 1); G8_STAGE(G8_SA(1, 0), A, brow, t + 3);
    G8_BAR; G8_WAIT_L(0); G8_MMA(1, 0, At, B0); G8_BAR; G8_SCHED;
    G8_STAGE(G8_SB(1, 1), Bt, bcol + 128, t + 3);
    G8_WAIT_V(6); G8_BAR; G8_MMA(1, 1, At, B1); G8_BAR;
    if (GSCALE && (t & 3) == 2) {
      const float* gf = gfac + (t >> 2) * 256 + wr * 64 + fq * 4;
#pragma unroll
      for (int ai = 0; ai < 2; ++ai)
#pragma unroll
        for (int m = 0; m < 4; ++m) {
          const f32x4 f4 = *(const f32x4*)(gf + ai * 128 + m * 16);
#pragma unroll
          for (int bj = 0; bj < 2; ++bj)
#pragma unroll
            for (int n = 0; n < 2; ++n)
#pragma unroll
              for (int j = 0; j < 4; ++j) acc[ai][bj][m][n][j] *= f4[j];
        }
    }
  }
  { G8_LDB(B0, 0, 0); G8_LDA(At, 0, 0); G8_STAGE(G8_SA(1, 1), A, brow + 128, nt - 1);
    G8_BAR; G8_WAIT_L(0); G8_MMA(0, 0, At, B0); G8_BAR;
    G8_LDB(B1, 0, 1); G8_BAR; G8_WAIT_L(0); G8_MMA(0, 1, At, B1); G8_BAR;
    G8_LDA(At, 0, 1); G8_WAIT_V(4); G8_BAR; G8_WAIT_L(0); G8_MMA(1, 0, At, B0); G8_MMA(1, 1, At, B1); G8_BAR; }
  { G8_LDB(B0, 1, 0); G8_LDA(At, 1, 0); G8_WAIT_V(2); G8_BAR; G8_WAIT_L(0); G8_MMA(0, 0, At, B0); G8_BAR;
    G8_LDB(B1, 1, 1); G8_WAIT_V(0); G8_BAR; G8_WAIT_L(0); G8_MMA(0, 1, At, B1); G8_BAR;
    G8_LDA(At, 1, 1); G8_BAR; G8_WAIT_L(0); G8_MMA(1, 0, At, B0); G8_MMA(1, 1, At, B1); G8_BAR; }
  if (wr == 0) G8_BAR;
  if (GSCALE) {
    const float* gf = gfac + 768 + wr * 64 + fq * 4;
#pragma unroll
    for (int ai = 0; ai < 2; ++ai)
#pragma unroll
      for (int m = 0; m < 4; ++m) {
        const f32x4 f4 = *(const f32x4*)(gf + ai * 128 + m * 16);
#pragma unroll
        for (int bj = 0; bj < 2; ++bj)
#pragma unroll
          for (int n = 0; n < 2; ++n)
#pragma unroll
            for (int j = 0; j < 4; ++j) acc[ai][bj][m][n][j] *= f4[j];
      }
  }
  if (next_valid) gemm8_prestage(A, Bt, K, next_brow, next_bcol, smem);
  const int wrs = __builtin_amdgcn_readfirstlane(wr), wcs = __builtin_amdgcn_readfirstlane(wc);
  if (EPI == EPI_RES) {
#pragma unroll
    for (int ai = 0; ai < 2; ++ai) {
      const int mrow0 = brow + ai * 128 + wrs * 64;
      const float* xw = (layer == 0 ? (brow < NPROMPT ? p.x_prompt + (size_t)mrow0 * DM : p.x_sample + (size_t)(mrow0 - NPROMPT) * DM) : p.out + (size_t)mrow0 * DM) + bcol + wcs * 32;
      float* ow = p.out + (size_t)mrow0 * DM + bcol + wcs * 32;
      const unsigned lo = (unsigned)(fq * 4) * DM + fr;
      float xv[4][4][4];
#pragma unroll
      for (int m = 0; m < 4; ++m)
#pragma unroll
        for (int j = 0; j < 4; ++j) {
          const float* xr = xw + (lo + (unsigned)((m * 16 + j) * DM));
#pragma unroll
          for (int c = 0; c < 4; ++c) xv[m][j][c] = xr[(c >> 1) * 128 + (c & 1) * 16];
        }
      __builtin_amdgcn_sched_barrier(0);
#pragma unroll
      for (int m = 0; m < 4; ++m)
#pragma unroll
        for (int j = 0; j < 4; ++j) {
          float* orow = ow + (lo + (unsigned)((m * 16 + j) * DM));
#pragma unroll
          for (int c = 0; c < 4; ++c) orow[(c >> 1) * 128 + (c & 1) * 16] = xv[m][j][c] + acc[ai][c >> 1][m][c & 1][j];
        }
      __builtin_amdgcn_sched_barrier(0);
    }
  }
#pragma unroll
  for (int ai = 0; ai < 2 && EPI != EPI_RES; ++ai) {
    const int mrow0 = brow + ai * 128 + wrs * 64;
#pragma unroll
    for (int bj = 0; bj < 2; ++bj) {
      const int ncol0 = bcol + bj * 128 + wcs * 32;
      if (EPI == EPI_SWIGLU) {
        u16* dw = (u16*)(p.ws + OFF_ACT) + (size_t)mrow0 * DFF + (ncol0 >> 1);
        const unsigned lo = (unsigned)(fq * 4) * DFF + fr;
#pragma unroll
        for (int m = 0; m < 4; ++m) {
#pragma unroll
          for (int j = 0; j < 4; ++j) {
            const float g = acc[ai][bj][m][0][j], u = acc[ai][bj][m][1][j];
            const float a = g * __builtin_amdgcn_rcpf(1.f + fexp2(-g * LOG2E)) * u;
            dw[lo + (unsigned)((m * 16 + j) * DFF)] = (u16)(pack2(a, 0.f) & 0xffff);
          }
        }
        __builtin_amdgcn_sched_barrier(0);
      } else if (EPI == EPI_RES) {
      } else {
        u16* stg = (u16*)(smem + 32768) + wid * 640;
        u16* dw = (u16*)(p.ws + OFF_PROJ) + (size_t)mrow0 * DIN + ncol0;
        const int srow = lane >> 2, sch = lane & 3;
#pragma unroll
        for (int m = 0; m < 4; ++m) {
#pragma unroll
          for (int n = 0; n < 2; ++n)
#pragma unroll
            for (int j = 0; j < 4; ++j) stg[(fq * 4 + j) * 40 + n * 16 + fr] = (u16)(pack2(acc[ai][bj][m][n][j], 0.f) & 0xffff);
          asm volatile("s_waitcnt lgkmcnt(0)" ::: "memory");
          const u32x4 w = *(const u32x4*)(stg + srow * 40 + sch * 8);
          if (ncol0 + sch * 8 < DIN) *(u32x4*)(dw + (size_t)(m * 16 + srow) * DIN + sch * 8) = w;
          asm volatile("s_waitcnt lgkmcnt(0)" ::: "memory");
        }
        __builtin_amdgcn_sched_barrier(0);
      }
    }
  }
  G8_WAIT_V(0);
  __syncthreads();
}

DI void e1_chunk(const Params& p, int layer, int chunk) {
  const int j = chunk & 7;
  const size_t tok = (size_t)(chunk >> 3) * NTHR + opaque_tid();
  if (j == 7) return;
  u16* proj = (u16*)(p.ws + OFF_PROJ);
  const int t = (int)(tok & 4095);
  if (j < 6) {
    u16* ptr = proj + tok * DIN + (j < 4 ? 768 + 64 * j : 1024 + 64 * (j - 4));
    const float* gain = (j < 4 ? p.b_q_gain : p.b_k_gain) + layer * 64;
    const float post = j < 4 ? QSCALE64 : 1.f;
    float x[64];
    float ss = 0.f;
#pragma unroll
    for (int c = 0; c < 8; ++c) {
      u32x4 w = *(const u32x4*)(ptr + c * 8);
#pragma unroll
      for (int e = 0; e < 4; ++e) { x[c * 8 + 2 * e] = bflo(w[e]); x[c * 8 + 2 * e + 1] = bfhi(w[e]); }
    }
#pragma unroll
    for (int d = 0; d < 64; ++d) ss += x[d] * x[d];
    const float rstd = rsqrtf(ss * (1.f / 64.f) + EPS);
    __builtin_amdgcn_sched_barrier(0);
#pragma unroll
    for (int c = 0; c < 4; ++c) {
#pragma unroll
      for (int d = 0; d < 16; ++d) x[c * 16 + d] = x[c * 16 + d] * rstd * gain[c * 16 + d];
      __builtin_amdgcn_sched_barrier(0);
    }
    const int prow = t >> 6, pcol = t & 63;
    { float* xa = x; float* xb = x + 16; ROPE16(p.ws, prow, xa, xb); }
    __builtin_amdgcn_sched_barrier(0);
    { float* xa = x + 32; float* xb = x + 48; ROPE16(p.ws, pcol, xa, xb); }
    __builtin_amdgcn_sched_barrier(0);
#pragma unroll
    for (int c = 0; c < 8; ++c) {
      u32x4 w;
#pragma unroll
      for (int e = 0; e < 4; ++e) w[e] = pack2(x[c * 8 + 2 * e] * post, x[c * 8 + 2 * e + 1] * post);
      *(u32x4*)(ptr + c * 8) = w;
    }
  } else {
    const u16* src = proj + tok * DIN + 2432;
    float x[32];
#pragma unroll
    for (int c = 0; c < 4; ++c) {
      u32x4 w = *(const u32x4*)(src + c * 8);
#pragma unroll
      for (int e = 0; e < 4; ++e) { x[c * 8 + 2 * e] = bflo(w[e]); x[c * 8 + 2 * e + 1] = bfhi(w[e]); }
    }
    { float* xa = x; float* xb = x + 16; ROPE16(p.ws, t, xa, xb); }
    u16* kd = (u16*)(p.ws + OFF_KD) + tok * 384 + 64;
#pragma unroll
    for (int c = 0; c < 4; ++c) {
      u32x4 w;
#pragma unroll
      for (int e = 0; e < 4; ++e) w[e] = pack2(x[c * 8 + 2 * e], x[c * 8 + 2 * e + 1]);
#pragma unroll
      for (int hh = 0; hh < 4; ++hh) *(u32x4*)(kd + hh * 96 + c * 8) = w;
    }
  }
}

template <int MODE>
DI void attn_tile(const Params& p, int layer, int tile, char* smem) {
  constexpr int DQK = (MODE == 3) ? 96 : 64;
  constexpr int NKQ = DQK / 16;
  constexpr int KROW = DQK + 8;
  constexpr int VROW = 72;
  constexpr int KCH = DQK / 8;
  constexpr int KLD = (64 * KCH + NTHR - 1) / NTHR;
  u16* Ks = (u16*)smem;
  u16* Vs = (u16*)(smem + 26624);
  float* tbl = (float*)(smem + 26624 + 18432);

  const int tid = opaque_tid(), lane = tid & 63, wave = tid >> 6, r = lane & 31, h = lane >> 5;
  const int qb = tile & 15, head = (tile >> 4) & 3, seq = tile >> 6;
  const size_t tok0 = (size_t)seq * SEQ;
  const u16* proj = (const u16*)(p.ws + OFF_PROJ);
  const u16 *Qp, *Kp, *Vp;
  int ldq, ldk, ldv;
  if (MODE == 0) { Qp = proj + 64 * head; Kp = proj + 256 + 64 * head; Vp = proj + 512 + 64 * head; ldq = ldk = ldv = DIN; }
  else if (MODE == 1) { Qp = proj + 768 + 64 * head; Kp = proj + 1024 + 64 * (head >> 1); Vp = proj + 1152 + 64 * (head >> 1); ldq = ldk = ldv = DIN; }
  else if (MODE == 2) { Qp = proj + 1280 + 64 * head; Kp = proj + 1536 + 64 * head; Vp = proj + 1792 + 64 * head; ldq = ldk = ldv = DIN; }
  else { Qp = (const u16*)(p.ws + OFF_QD) + 96 * head; Kp = (const u16*)(p.ws + OFF_KD) + 96 * head; Vp = (const u16*)(p.ws + OFF_VD) + 64 * head; ldq = ldk = 384; ldv = 256; }

  int kt0 = 0, kt1 = 64;
  if (MODE == 0) { kt0 = 4 * qb - 16; if (kt0 < 0) kt0 = 0; kt1 = 4 * qb + 20; if (kt1 > 64) kt1 = 64; }
  if (MODE == 2) { int r0 = 4 * qb - 4; r0 = r0 < 0 ? 0 : (r0 > 56 ? 56 : r0); int r1 = 4 * qb + 3 - 4; r1 = r1 < 0 ? 0 : (r1 > 56 ? 56 : r1); kt0 = r0; kt1 = r1 + 8; }

  if (MODE == 0) { const float* src = (const float*)(p.ws + OFF_TBLA) + head * 2560; for (int i = tid; i < 2560; i += NTHR) tbl[i] = src[i]; }
  if (MODE == 2) { const float* src = p.c_rpb + (size_t)(layer * 4 + head) * 465; for (int i = tid; i < 465; i += NTHR) tbl[i] = src[i] * LOG2E; }

  const int qpos = qb * 256 + wave * 32 + r;
  bf16x8 qf[NKQ];
  {
    const u16* qrow = Qp + (tok0 + qpos) * ldq + 8 * h;
#pragma unroll
    for (int d0 = 0; d0 < NKQ; ++d0) qf[d0] = *(const bf16x8*)(qrow + d0 * 16);
  }
  if (MODE == 3) {
    bf16x8 x1 = qf[NKQ - 2], x2 = qf[NKQ - 1];
    const f32x4* rt = (const f32x4*)(p.ws + OFF_ROPE) + (size_t)qpos * 8 + 4 * h;
#pragma unroll
    for (int j2 = 0; j2 < 4; ++j2) {
      const f32x4 cs4 = rt[j2];
#pragma unroll
      for (int e = 0; e < 2; ++e) {
        const int j = 2 * j2 + e;
        const float c = cs4[2 * e], sn = cs4[2 * e + 1];
        float a = __uint_as_float(((unsigned)(u16)x1[j]) << 16), b = __uint_as_float(((unsigned)(u16)x2[j]) << 16);
        unsigned w = pack2(a * c - b * sn, a * sn + b * c);
        x1[j] = (short)(w & 0xffff); x2[j] = (short)(w >> 16);
      }
    }
    qf[NKQ - 2] = x1; qf[NKQ - 1] = x2;
  }

  u32x4 rk0[KLD], rv0, rk1[KLD], rv1;
  const u16* Kt = Kp + tok0 * ldk;
  const u16* Vt = Vp + tok0 * ldv;
  unsigned koff[KLD];
#pragma unroll
  for (int pp = 0; pp < KLD; ++pp) { int c = tid + NTHR * pp; if (c >= 64 * KCH) c = tid; const int row = c / KCH, col = c % KCH; koff[pp] = (unsigned)row * ldk + col * 8; }
  const unsigned voff = (unsigned)(tid >> 3) * ldv + (tid & 7) * 8;
  const int ktl = kt1 - 1;
  auto gload = [&](u32x4 (&rk)[KLD], u32x4& rv, int kt) {
    kt = kt < ktl ? kt : ktl;
#pragma unroll
    for (int pp = 0; pp < KLD; ++pp) rk[pp] = *(const u32x4*)(Kt + (koff[pp] + (unsigned)(kt * 64) * ldk));
    rv = *(const u32x4*)(Vt + (voff + (unsigned)(kt * 64) * ldv));
  };
  auto lstore = [&](u32x4 (&rk)[KLD], u32x4& rv, int buf) {
#pragma unroll
    for (int pp = 0; pp < KLD; ++pp) { const int c = tid + NTHR * pp; if (c < 64 * KCH) { const int row = c / KCH, col = c % KCH; *(u32x4*)(Ks + (buf * 64 + row) * KROW + col * 8) = rk[pp]; } }
    *(u32x4*)(Vs + (buf * 64 + (tid >> 3)) * VROW + (tid & 7) * 8) = rv;
  };

  f32x16 o0, o1, negm;
#pragma unroll
  for (int i = 0; i < 16; ++i) { o0[i] = 0.f; o1[i] = 0.f; negm[i] = 0.f; }
  float mref = 0.f, lsum = 0.f;
  bool started = false;
  int qr = 0, qc = 0, cs = 0, rs = 0;
  if (MODE == 2) { qr = qpos >> 6; qc = qpos & 63; cs = qc - 8; cs = cs < 0 ? 0 : (cs > 48 ? 48 : cs); rs = qr - 4; rs = rs < 0 ? 0 : (rs > 56 ? 56 : rs); }
  const int i16 = lane & 15, qq = i16 >> 2, pp4 = i16 & 3, g16 = (lane >> 4) & 1;

  auto compute = [&](int buf, int kt) {
    bool active = true;
    if (MODE == 2) active = (kt >= rs) && (kt < rs + 8);
    if (active) {
      const u16* Kb = Ks + buf * 64 * KROW + r * KROW + 8 * h;
      const u16* Vb = Vs + buf * 64 * VROW;
      bf16x8 vf[8];
#pragma unroll
      for (int cs2 = 0; cs2 < 4; ++cs2) {
        const u16* vp = Vb + (16 * cs2 + 4 * h + qq) * VROW + 16 * g16 + 4 * pp4;
        { s16x4 lo = tr_read(vp), hi = tr_read(vp + 8 * VROW); vf[2 * cs2] = __builtin_shufflevector(lo, hi, 0, 1, 2, 3, 4, 5, 6, 7); }
        { s16x4 lo = tr_read(vp + 32), hi = tr_read(vp + 8 * VROW + 32); vf[2 * cs2 + 1] = __builtin_shufflevector(lo, hi, 0, 1, 2, 3, 4, 5, 6, 7); }
      }
      f32x16 s0 = negm, s1 = negm;
#pragma unroll
      for (int d0 = 0; d0 < NKQ; ++d0) {
        bf16x8 k0 = *(const bf16x8*)(Kb + d0 * 16);
        bf16x8 k1 = *(const bf16x8*)(Kb + 32 * KROW + d0 * 16);
        s0 = mfma(k0, qf[d0], s0);
        s1 = mfma(k1, qf[d0], s1);
      }
      if (MODE == 0) {
        const float* tb = tbl + (kt * 64 + 4 * h - qpos + 1280);
#pragma unroll
        for (int i = 0; i < 16; ++i) { s0[i] += tb[(i & 3) + 8 * (i >> 2)]; s1[i] += tb[32 + (i & 3) + 8 * (i >> 2)]; }
      }
      if (MODE == 2) {
        const float* tb = tbl + (kt - qr + 7) * 31 + (15 - qc);
#pragma unroll
        for (int i = 0; i < 16; ++i) {
          const int kc0 = 4 * h + (i & 3) + 8 * (i >> 2), kc1 = kc0 + 32;
          const bool v0 = (kc0 >= cs) && (kc0 < cs + 16), v1 = (kc1 >= cs) && (kc1 < cs + 16);
          const float b0 = tb[v0 ? kc0 : qc], b1 = tb[v1 ? kc1 : qc];
          s0[i] = v0 ? s0[i] + b0 : NEGBIG;
          s1[i] = v1 ? s1[i] + b1 : NEGBIG;
        }
      }
      float ma = __builtin_fmaxf(__builtin_fmaxf(s0[0], s0[1]), s0[2]), mb = __builtin_fmaxf(__builtin_fmaxf(s1[0], s1[1]), s1[2]);
#pragma unroll
      for (int i = 3; i < 15; i += 2) { ma = __builtin_fmaxf(__builtin_fmaxf(ma, s0[i]), s0[i + 1]); mb = __builtin_fmaxf(__builtin_fmaxf(mb, s1[i]), s1[i + 1]); }
      float mt = __builtin_fmaxf(__builtin_fmaxf(ma, s0[15]), s1[15]);
      mt = hmax(__builtin_fmaxf(mt, mb));
      const bool fresh = !started && (mt > -1e29f);
      if (__any(fresh || (started && mt > 8.f))) {
        float delta = 0.f, al = 1.f;
        if (fresh) { delta = mt; started = true; }
        else if (started) { delta = __builtin_fmaxf(mt, 0.f); al = fexp2(-delta); }
        mref += delta;
        lsum *= al;
#pragma unroll
        for (int i = 0; i < 16; ++i) { o0[i] *= al; o1[i] *= al; s0[i] -= delta; s1[i] -= delta; negm[i] = -mref; }
      }
      float ps = 0.f;
#pragma unroll
      for (int i = 0; i < 16; ++i) { s0[i] = fexp2(s0[i]); s1[i] = fexp2(s1[i]); ps += s0[i] + s1[i]; }
      lsum += ps;
#pragma unroll
      for (int c = 0; c < 2; ++c) {
#pragma unroll
        for (int s = 0; s < 2; ++s) {
          u32x4 pw;
          if (c == 0) pw = (u32x4){pack2(s0[8 * s], s0[8 * s + 1]), pack2(s0[8 * s + 2], s0[8 * s + 3]), pack2(s0[8 * s + 4], s0[8 * s + 5]), pack2(s0[8 * s + 6], s0[8 * s + 7])};
          else pw = (u32x4){pack2(s1[8 * s], s1[8 * s + 1]), pack2(s1[8 * s + 2], s1[8 * s + 3]), pack2(s1[8 * s + 4], s1[8 * s + 5]), pack2(s1[8 * s + 6], s1[8 * s + 7])};
          const bf16x8 pf = __builtin_bit_cast(bf16x8, pw);
          o0 = mfma(vf[2 * (2 * c + s)], pf, o0);
          o1 = mfma(vf[2 * (2 * c + s) + 1], pf, o1);
        }
      }
    }
  };

  const int ntile = kt1 - kt0;
  gload(rk1, rv1, kt0);
  gload(rk0, rv0, kt0 + 1);
  lstore(rk1, rv1, 0);
  gload(rk1, rv1, kt0 + 2);
  __syncthreads();
  for (int j = 0; j < ntile; j += 2) {
    compute(0, kt0 + j);
    lstore(rk0, rv0, 1);
    gload(rk0, rv0, kt0 + j + 3);
    __syncthreads();
    if (j + 1 >= ntile) break;
    compute(1, kt0 + j + 1);
    lstore(rk1, rv1, 0);
    gload(rk1, rv1, kt0 + j + 4);
    __syncthreads();
  }
  lsum = hsum(lsum);
  const float inv = 1.f / lsum;
  float sq = 0.f;
#pragma unroll
  for (int i = 0; i < 16; ++i) { o0[i] *= inv; o1[i] *= inv; sq += o0[i] * o0[i] + o1[i] * o1[i]; }
  sq = hsum(sq);
  if (h == 0) ((float*)(p.ws + OFF_SSQ))[(tok0 + qpos) * 16 + MODE * 4 + head] = sq;
  u16* stg = (u16*)smem + wave * (32 * 72);
#pragma unroll
  for (int g4 = 0; g4 < 4; ++g4) {
    u32x2 w0 = {pack2(o0[4 * g4], o0[4 * g4 + 1]), pack2(o0[4 * g4 + 2], o0[4 * g4 + 3])};
    u32x2 w1 = {pack2(o1[4 * g4], o1[4 * g4 + 1]), pack2(o1[4 * g4 + 2], o1[4 * g4 + 3])};
    *(u32x2*)(stg + r * 72 + 8 * g4 + 4 * h) = w0;
    *(u32x2*)(stg + r * 72 + 32 + 8 * g4 + 4 * h) = w1;
  }
  asm volatile("s_waitcnt lgkmcnt(0)" ::: "memory");
  u16* Ow = (u16*)(p.ws + OFF_ACTB) + (tok0 + (size_t)(qb * 256 + wave * 32)) * DM + MODE * 256 + head * 64;
#pragma unroll
  for (int i = 0; i < 4; ++i) {
    const int row = i * 8 + (lane >> 3), ch = lane & 7;
    *(u32x4*)(Ow + (size_t)row * DM + ch * 8) = *(const u32x4*)(stg + row * 72 + ch * 8);
  }
  __syncthreads();
}


DI bool sb_tile(int bid, int nb, int it, int NT, int& mt, int& nt) {
  const int G = nb >> 3, x = bid & 7, l = bid >> 3;
  const int s = l + it * G;
  const int sb = (s >> 5) * 8 + x, w = s & 31;
  if (NT == 4) {
    if (sb >= 48) return false;
    mt = sb * 8 + (w >> 2); nt = w & 3;
    return true;
  }
  const int NG = NT >> 1;
  if (sb >= 24 * NG) return false;
  const int mg = sb / NG, ng = sb - mg * NG;
  mt = mg * 16 + (w >> 1); nt = ng * 2 + (w & 1);
  return true;
}

DI bool att_tile_index(int bid, int nb, int it, int& tile) {
  if (nb != 256) { tile = bid + it * nb; return tile < 1536; }
  const int x = bid & 7, l = bid >> 3;
  const int pair = 2 * (it * 8 + x) + (l >> 4);
  tile = pair * 16 + ((l + 3 * it) & 15);
  return pair < 96;
}

template <int EPI, bool GSCALE = false>
DI void gemm8_phase(const Params& p, int layer, const u16* A, const u16* Bt, int K, int NT, char* smem) {
  const int bid = blockIdx.x, nb = gridDim.x;
  int mt, nt;
  bool have = sb_tile(bid, nb, 0, NT, mt, nt);
  if (have) gemm8_prestage(A, Bt, K, mt * 256, nt * 256, smem);
  for (int it = 0; have; ++it) {
    int mt2 = 0, nt2 = 0;
    const bool have2 = sb_tile(bid, nb, it + 1, NT, mt2, nt2);
    gemm8_tile<EPI, GSCALE>(p, layer, A, Bt, K, mt * 256, nt * 256, smem, have2, mt2 * 256, nt2 * 256);
    have = have2; mt = mt2; nt = nt2;
  }
}

constexpr int NPHASE = 17;
constexpr int MT = T_TOK / 256;

DI void run_phase(const Params& p, int ph, char* smem) {
  const int bid = blockIdx.x, nb = gridDim.x;
  u16* wtb = (u16*)(p.ws + OFF_WT);
  const u16* actb = (const u16*)(p.ws + OFF_ACTB);
  if (ph == 0) {
    for (int j = bid; j < 128; j += nb) rope_tab_build(p.ws, j * NTHR + opaque_tid());
    for (int j = bid; j < WJ_TOTAL; j += nb) wprep_job(p, j, smem);
    for (int rb = bid; rb < T_TOK / (8 * NRW); rb += nb) norm_rows(p, 0, rb, 0);
    return;
  }
  if (ph == 16) { for (int rb = bid; rb < T_TOK / (8 * NRW); rb += nb) norm_rows(p, 1, rb, 1); return; }
  const int layer = (ph - 1) >> 3, sub = (ph - 1) & 7;
  const u16* wl = wtb + (size_t)layer * WT_LAYER;
  switch (sub) {
    case 0:
      gemm8_phase<EPI_PROJ>(p, layer, actb, wl + WT_IN, 1024, 10, smem);
      break;
    case 1:
      for (int c = bid; c < (T_TOK / NTHR) * 8; c += nb) e1_chunk(p, layer, c);
      for (int t = bid; t < MT * 2; t += nb) { const int nt = t & 1, mt = t >> 1; gemm_tile<EPI_UQ, false, true>(p, layer, (const u16*)(p.ws + OFF_PROJ) + 2048, DIN, wl + WT_UQ, 256, mt * 256, nt * 256, smem); }
      for (int t = bid; t < MT * 2; t += nb) { const int nt = t & 1, mt = t >> 1; gemm_tile<EPI_UKV, false, true>(p, layer, (const u16*)(p.ws + OFF_PROJ) + 2304, DIN, wl + WT_UKV, 128, mt * 256, nt * 256, smem); }
      break;
    case 2:
      for (int it = 0, t; att_tile_index(bid, nb, it, t); ++it) attn_tile<3>(p, layer, t, smem);
      for (int it = 0, t; att_tile_index(bid, nb, it, t); ++it) attn_tile<1>(p, layer, t, smem);
      for (int it = 0, t; att_tile_index(bid, nb, it, t); ++it) attn_tile<0>(p, layer, t, smem);
      for (int it = 0, t; att_tile_index(bid, nb, it, t); ++it) attn_tile<2>(p, layer, t, smem);
      break;
    case 3:
      gemm8_phase<EPI_RES, true>(p, layer, actb, wl + WT_OUT, 1024, 4, smem);
      break;
    case 4:
      for (int rb = bid; rb < T_TOK / (8 * NRW); rb += nb) norm_rows(p, 1, rb, 0);
      break;
    case 5:
      gemm8_phase<EPI_SWIGLU>(p, layer, actb, wl + WT_GU, 1024, 22, smem);
      break;
    case 6:
      gemm8_phase<EPI_RES>(p, 1, (const u16*)(p.ws + OFF_ACT), wl + WT_DN, DFF, 4, smem);
      break;
    case 7:
      for (int rb = bid; rb < T_TOK / (8 * NRW); rb += nb) norm_rows(p, 1, rb, 0);
      break;
  }
}

__global__ void __launch_bounds__(NTHR, 2) mega(Params p, int ph_lo, int ph_hi) {
  __shared__ __attribute__((aligned(16))) char smem[SMEM_BYTES];
  cg::grid_group grid = cg::this_grid();
  for (int ph = ph_lo; ph < ph_hi; ++ph) {
    if (ph > ph_lo) grid.sync();
    run_phase(p, ph, smem);
#ifdef DUPMASK
    if (ph >= 1 && ph < 16 && ((DUPMASK >> ((ph - 1) & 7)) & 1)) { grid.sync(); run_phase(p, ph, smem); }
#endif
  }
}

extern "C" void kernel_launch(void* const* d_in, const int* in_sizes, int n_in, void* d_out, int out_size, void* d_ws, size_t ws_size, hipStream_t stream) {
  Params p{};
  p.x_prompt = (const float*)d_in[0]; p.x_sample = (const float*)d_in[1]; p.t5_bias = (const float*)d_in[2]; p.norm_mix = (const float*)d_in[3];
  p.w_in = (const float*)d_in[4]; p.b_q_gain = (const float*)d_in[5]; p.b_k_gain = (const float*)d_in[6]; p.c_rpb = (const float*)d_in[7];
  p.d_q_gain = (const float*)d_in[8]; p.d_w_uq = (const float*)d_in[9]; p.d_kv_gain = (const float*)d_in[10]; p.d_w_ukv = (const float*)d_in[11];
  p.out_gain = (const float*)d_in[12]; p.w_out = (const float*)d_in[13]; p.norm_ffn = (const float*)d_in[14]; p.w_gate = (const float*)d_in[15];
  p.w_up = (const float*)d_in[16]; p.w_down = (const float*)d_in[17]; p.final_norm = (const float*)d_in[18];
  p.out = (float*)d_out; p.ws = (char*)d_ws;
  if (ws_size < WS_NEED) { fprintf(stderr, "workspace too small: %zu < %zu\n", ws_size, (size_t)WS_NEED); return; }
  static int grid_blocks = 0;
  if (!grid_blocks) {
    int dev = 0, cus = 0, per_cu = 0;
    hipGetDevice(&dev);
    hipDeviceGetAttribute(&cus, hipDeviceAttributeMultiprocessorCount, dev);
    hipOccupancyMaxActiveBlocksPerMultiprocessor(&per_cu, mega, NTHR, 0);
    if (per_cu < 1) per_cu = 1;
    if (per_cu > 1) per_cu = 1;
    grid_blocks = cus * per_cu;
  }
#if ONE_LAUNCH
  int lo = 0, hi = NPHASE;
  void* args[] = {&p, &lo, &hi};
  hipError_t e = hipLaunchCooperativeKernel((void*)mega, dim3(grid_blocks), dim3(NTHR), args, 0, stream);
  if (e != hipSuccess) fprintf(stderr, "cooperative launch failed: %s (grid %d)\n", hipGetErrorString(e), grid_blocks);
#else
  for (int ph = 0; ph < NPHASE; ++ph) hipLaunchKernelGGL(mega, dim3(grid_blocks), dim3(NTHR), 0, stream, p, ph, ph + 1);
#endif
}
```
